# Optimizing an MI355X kernel written in HIP

```python
import jax, jax.numpy as jnp
from jax import lax
import numpy as np

D_MODEL = 2048
BATCH = 4
SEQ = 8192
DEPTH = 1

CHUNK = 64
N_HEADS = 8
HEAD_DIM = 128
ATT_WIDTH = N_HEADS * HEAD_DIM
ROPE_THETA = 500000.0
ROT_DIM = HEAD_DIM // 4
IDX_HEADS = 16
IDX_DIM = 64
IDX_ROT_DIM = IDX_DIM // 4
TOPK_MAX = 256
Q_BLOCK = 128
SGU_LEN = 128
SGU_GROUPS = 8
SGU_GROUP_DIM = 128
SGU_WIDTH = SGU_GROUPS * SGU_GROUP_DIM
D_FF = 5632
EPS = 1e-6

IN_SIZES = [ATT_WIDTH, ATT_WIDTH, ATT_WIDTH,
            IDX_HEADS * IDX_DIM, IDX_DIM, IDX_HEADS,
            SGU_WIDTH, SGU_WIDTH,
            D_MODEL, D_MODEL]
IN_COLS = sum(IN_SIZES)
SPLIT_POINTS = [sum(IN_SIZES[:i + 1]) for i in range(len(IN_SIZES) - 1)]

kernel_name = "hybrid_dsa_gmlp_gated_macaron_block"


def rms_norm(t, g):
    tf = t.astype(jnp.float32)
    y = tf * lax.rsqrt(jnp.mean(tf * tf, axis=-1, keepdims=True) + EPS)
    return (y * g.astype(jnp.float32)).astype(t.dtype)


def rope_tables(positions, rot_dim):
    inv_freq = ROPE_THETA ** (-jnp.arange(0, rot_dim, 2, dtype=jnp.float32) / rot_dim)
    ang = positions.astype(jnp.float32)[..., None] * inv_freq
    return jnp.cos(ang), jnp.sin(ang)


def partial_rope(t, cos, sin):
    half = cos.shape[-1]
    cos = cos.astype(t.dtype)
    sin = sin.astype(t.dtype)
    x1 = t[..., :half]
    x2 = t[..., half:2 * half]
    return jnp.concatenate([x1 * cos - x2 * sin, x2 * cos + x1 * sin, t[..., 2 * half:]], axis=-1)


def swiglu(h, w_gate, w_up, w_down):
    return (jax.nn.silu(h @ w_gate) * (h @ w_up)) @ w_down


def dsa_attention(q, k, v, qi, ki, wi):
    b, s = q.shape[:2]
    topk = min(TOPK_MAX, s // 4)
    nb = s // Q_BLOCK
    key_chunk = jnp.arange(s) // CHUNK
    gather = jax.vmap(lambda t, i: t[i])

    def to_blocks(t):
        return jnp.swapaxes(t.reshape((b, nb, Q_BLOCK) + t.shape[2:]), 0, 1)

    def one_block(args):
        blk, qb, qib, wib = args
        q_chunk = (blk * Q_BLOCK + jnp.arange(Q_BLOCK)) // CHUNK
        admissible = key_chunk[None, :] <= q_chunk[:, None]
        dots = jnp.einsum('bqhd,bsd->bqhs', qib, ki)
        score = jnp.einsum('bqhs,bqh->bqs', jax.nn.relu(dots), wib).astype(jnp.float32)
        score = jnp.where(admissible[None], score, -jnp.inf)
        _, idx = lax.top_k(score, topk)
        valid = key_chunk[idx] <= q_chunk[None, :, None]
        kg = gather(k, idx)
        vg = gather(v, idx)
        logits = jnp.einsum('bqhd,bqkhd->bhqk', qb, kg).astype(jnp.float32) * (HEAD_DIM ** -0.5)
        logits = jnp.where(valid[:, None], logits, -jnp.inf)
        p = jax.nn.softmax(logits, axis=-1).astype(v.dtype)
        return jnp.einsum('bhqk,bqkhd->bqhd', p, vg)

    out = lax.map(one_block, (jnp.arange(nb), to_blocks(q), to_blocks(qi), to_blocks(wi)))
    return jnp.swapaxes(out, 0, 1).reshape(b, s, N_HEADS * HEAD_DIM)


def spatial_gating(u, v, g_v, w_s, b_s):
    b, s, _ = v.shape
    v = rms_norm(v, g_v)
    pos_chunk = jnp.arange(SGU_LEN) // CHUNK
    mask = pos_chunk[None, :] <= pos_chunk[:, None]
    w = jnp.where(mask[None], w_s, jnp.zeros_like(w_s))
    vb = v.reshape(b, s // SGU_LEN, SGU_LEN, SGU_GROUPS, SGU_GROUP_DIM)
    mixed = jnp.einsum('gts,bnsgc->bntgc', w, vb) + jnp.swapaxes(b_s, 0, 1)[:, :, None]
    return u * mixed.reshape(b, s, SGU_WIDTH)


def setup_inputs(seed: int = 0) -> dict:
    key = jax.random.key(seed)
    ks = jax.random.split(key, 24)
    f32 = jnp.float32

    def w(k, shape, fan_in):
        return jax.random.normal(k, shape, f32) * (fan_in ** -0.5)

    def gain(k, n):
        return 1.0 + 0.02 * jax.random.normal(k, (DEPTH, n), f32)

    x = jax.random.normal(ks[0], (BATCH, SEQ, D_MODEL), f32)
    offsets = jax.random.randint(ks[1], (BATCH, 1), 0, 100000, dtype=jnp.int32)
    positions = offsets + jnp.arange(SEQ, dtype=jnp.int32)[None, :]
    return {
        "x": x,
        "positions": positions,
        "norm_ffn1": gain(ks[2], D_MODEL),
        "ffn1_w_gate": w(ks[3], (DEPTH, D_MODEL, D_FF), D_MODEL),
        "ffn1_w_up": w(ks[4], (DEPTH, D_MODEL, D_FF), D_MODEL),
        "ffn1_w_down": w(ks[5], (DEPTH, D_FF, D_MODEL), D_FF),
        "norm_mix": gain(ks[6], D_MODEL),
        "w_in": w(ks[7], (DEPTH, D_MODEL, IN_COLS), D_MODEL),
        "q_norm": gain(ks[8], HEAD_DIM),
        "k_norm": gain(ks[9], HEAD_DIM),
        "idx_k_norm": gain(ks[10], IDX_DIM),
        "sgu_v_norm": gain(ks[11], SGU_WIDTH),
        "sgu_w_s": w(ks[12], (DEPTH, SGU_GROUPS, SGU_LEN, SGU_LEN), SGU_LEN),
        "sgu_b_s": 0.02 * jax.random.normal(ks[13], (DEPTH, SGU_GROUPS, SGU_LEN), f32),
        "w_up_attn": w(ks[14], (DEPTH, ATT_WIDTH, D_MODEL), ATT_WIDTH),
        "w_up_sgu": w(ks[15], (DEPTH, SGU_WIDTH, D_MODEL), SGU_WIDTH),
        "w_out": w(ks[16], (DEPTH, D_MODEL, D_MODEL), D_MODEL),
        "norm_ffn2": gain(ks[17], D_MODEL),
        "ffn2_w_gate": w(ks[18], (DEPTH, D_MODEL, D_FF), D_MODEL),
        "ffn2_w_up": w(ks[19], (DEPTH, D_MODEL, D_FF), D_MODEL),
        "ffn2_w_down": w(ks[20], (DEPTH, D_FF, D_MODEL), D_FF),
    }


def reference(x, positions, norm_ffn1, ffn1_w_gate, ffn1_w_up, ffn1_w_down, norm_mix, w_in,
              q_norm, k_norm, idx_k_norm, sgu_v_norm, sgu_w_s, sgu_b_s, w_up_attn, w_up_sgu,
              w_out, norm_ffn2, ffn2_w_gate, ffn2_w_up, ffn2_w_down):
    b, s, _ = x.shape
    cos_a, sin_a = rope_tables(positions, ROT_DIM)
    cos_i, sin_i = rope_tables(positions, IDX_ROT_DIM)
    idx_w_scale = (IDX_HEADS ** -0.5) * (IDX_DIM ** -0.5)
    for l in range(DEPTH):
        x = x + 0.5 * swiglu(rms_norm(x, norm_ffn1[l]), ffn1_w_gate[l], ffn1_w_up[l], ffn1_w_down[l])

        h = rms_norm(x, norm_mix[l])
        proj = h @ w_in[l]
        q, k, v, qi, ki, wi, u, vs, ga, gb = jnp.split(proj, SPLIT_POINTS, axis=-1)

        q = partial_rope(rms_norm(q.reshape(b, s, N_HEADS, HEAD_DIM), q_norm[l]),
                         cos_a[:, :, None], sin_a[:, :, None])
        k = partial_rope(rms_norm(k.reshape(b, s, N_HEADS, HEAD_DIM), k_norm[l]),
                         cos_a[:, :, None], sin_a[:, :, None])
        v = v.reshape(b, s, N_HEADS, HEAD_DIM)
        qi = partial_rope(qi.reshape(b, s, IDX_HEADS, IDX_DIM), cos_i[:, :, None], sin_i[:, :, None])
        ki = partial_rope(rms_norm(ki, idx_k_norm[l]), cos_i, sin_i)
        y_a = dsa_attention(q, k, v, qi, ki, wi * idx_w_scale)

        y_b = spatial_gating(jax.nn.gelu(u), jax.nn.gelu(vs), sgu_v_norm[l], sgu_w_s[l], sgu_b_s[l])

        merged = jax.nn.sigmoid(ga) * (y_a @ w_up_attn[l]) + jax.nn.sigmoid(gb) * (y_b @ w_up_sgu[l])
        x = x + merged @ w_out[l]

        x = x + 0.5 * swiglu(rms_norm(x, norm_ffn2[l]), ffn2_w_gate[l], ffn2_w_up[l], ffn2_w_down[l])
    return x
```

```cpp
#include <hip/hip_runtime.h>
#include <hip/hip_cooperative_groups.h>
#include <hip/hip_bf16.h>
#include <cstdio>
#include <cstdint>
#include <cmath>
namespace cg = cooperative_groups;

constexpr int BATCH = 4, SEQ = 8192, DM = 2048, MTOK = BATCH * SEQ, DFF = 5632;
constexpr int PP = 10496;
constexpr int C_Q = 0, C_K = 1024, C_V = 2048, C_QI = 3072, C_KI = 4096, C_WI = 4160, C_U = 4352, C_VS = 5376, C_GA = 6400, C_GB = 8448;
constexpr float EPS = 1e-6f;
constexpr int NWAVES = 8, NTHR = 512;
constexpr size_t MiB = 1u << 20;
constexpr size_t WS_CTL = 0, WS_SS1 = 256 * 1024  , WS_WSB = 1 * MiB, WS_KI = 2 * MiB, WS_WI = 6 * MiB, WS_WGU1 = 8 * MiB, WS_WD1 = 52 * MiB, WS_WGU2 = 74 * MiB, WS_WD2 = 118 * MiB,
                 WS_WIN = 140 * MiB, WS_WUA = 181 * MiB, WS_WUS = 185 * MiB, WS_WOUT = 189 * MiB, WS_MASK = 197 * MiB, WS_XN = 229 * MiB, WS_PROJ = 357 * MiB, WS_END = 1013 * MiB;
static_assert(WS_PROJ + (size_t)MTOK * PP * 2 <= WS_END && WS_XN + (size_t)MTOK * DM * 2 <= WS_PROJ && WS_MASK + (size_t)MTOK * 128 * 8 <= WS_XN, "ws map");
constexpr int LDS_BYTES = 147456;

typedef unsigned short bf16raw;
typedef unsigned u32x4_t __attribute__((ext_vector_type(4)));
typedef unsigned u32x2_t __attribute__((ext_vector_type(2)));
typedef float f32x4_t __attribute__((ext_vector_type(4)));
typedef float f32x16_t __attribute__((ext_vector_type(16)));
typedef short bf16x8_t __attribute__((ext_vector_type(8)));
#define LAS __attribute__((address_space(3)))

__device__ __forceinline__ float bf2f(unsigned short b) { return __uint_as_float((unsigned)b << 16); }
__device__ __forceinline__ float bflo(unsigned w) { return __uint_as_float(w << 16); }
__device__ __forceinline__ float bfhi(unsigned w) { return __uint_as_float(w & 0xffff0000u); }
__device__ __forceinline__ unsigned pkbf(float lo, float hi) { unsigned r; asm volatile("v_cvt_pk_bf16_f32 %0, %1, %2" : "=v"(r) : "v"(lo), "v"(hi)); return r; }
__device__ __forceinline__ float fast_sigmoid(float x) { return __builtin_amdgcn_rcpf(1.0f + __builtin_amdgcn_exp2f(-1.4426950408889634f * x)); }
__device__ __forceinline__ float silu_f(float x) { return x * fast_sigmoid(x); }
__device__ __forceinline__ float gelu_tanh_f(float x) { const float z2 = 1.5957691216057308f * (x + 0.044715f * x * x * x); return x * fast_sigmoid(z2); }
__device__ __forceinline__ float wave_sum(float v) {
#pragma unroll
    for (int o = 1; o < 64; o <<= 1) v += __shfl_xor(v, o);
    return v;
}
namespace pg8 {
#define PG8_LAS __attribute__((address_space(3)))
typedef unsigned short bf16_t;
typedef short bf16x8 __attribute__((ext_vector_type(8)));
typedef float f32x4 __attribute__((ext_vector_type(4)));
typedef unsigned u32x4 __attribute__((ext_vector_type(4)));
constexpr int BM = 256, BK = 64, HALF = 128, HTB = HALF * BK * 2  , STAGE_BYTES = 8 * HTB, NXCD = 8, WGM = 8;

__host__ __device__ __forceinline__ int lds_byte(int r, int c) { const int st = (r >> 4) * 2 + (c >> 5), rr = r & 15, cc = c & 31, ob = rr * 64 + cc * 2; return st * 1024 + (ob ^ (((ob >> 9) & 1) << 5)); }
__host__ __device__ __forceinline__ void stage_rc(int b, int& R, int& C) { const int st = b / 1024, sb = b % 1024, swz = sb ^ (((sb >> 9) & 1) << 5); R = (st >> 1) * 16 + swz / 64; C = (st & 1) * 32 + (swz % 64) / 2; }
__host__ __device__ __forceinline__ int perm32(int rho) { const int n = rho >> 4, i = rho & 15; return 8 * (i >> 2) + 4 * n + (i & 3); }

struct Unit { int pm, pn; };
struct Gemm { const bf16_t* A; const bf16_t* Bt; int M, N, K, lda, ldb; };

struct StaticOrder {
    int nM, nN, nwg, G, c;
    __host__ __device__ void init(int M, int N, int G_, int c_) { nM = M / BM; nN = N / BM; nwg = nM * nN; G = G_; c = c_; }
    __host__ __device__ bool next(int i, Unit& u) const {
        const long L = (long)i * G + c; if (L >= nwg) return false;
        int wgid = (int)L; { const int q = nwg / NXCD, r = nwg % NXCD, xcd = wgid % NXCD, off = wgid / NXCD; wgid = (xcd < r ? xcd * (q + 1) : r * (q + 1) + (xcd - r) * q) + off; }
        const int nig = WGM * nN, gid = wgid / nig, fm = gid * WGM, gsz = (nM - fm) < WGM ? (nM - fm) : WGM;
        u.pm = fm + ((wgid % nig) % gsz); u.pn = (wgid % nig) / gsz; return true;
    }
    __device__ __forceinline__ void a_ready(const Unit&) const {}
    __device__ __forceinline__ void done(const Unit&) const {}
};

__device__ __forceinline__ unsigned cvt_pk_bf16(float lo, float hi) { unsigned r; asm volatile("v_cvt_pk_bf16_f32 %0, %1, %2" : "=v"(r) : "v"(lo), "v"(hi)); return r; }
typedef float f32x2 __attribute__((ext_vector_type(2)));

__device__ __forceinline__ float sigm(float x) { return __builtin_amdgcn_rcpf(1.0f + __builtin_amdgcn_exp2f(-1.4426950408889634f * x)); }
struct EpiStore {
    static constexpr bool PERM = true, AFTER_DRAIN = false;
    bf16_t* O; int ldc; const float* ss;
    __device__ __forceinline__ void operator()(const f32x4 (&acc)[2][2][4][2], const Unit& u, int wr, int wc, int fr, int fq) const {
        const int row0 = u.pm * BM + wr * 64 + fr, col0 = u.pn * BM + wc * 32 + 8 * fq;
#pragma unroll
        for (int ai = 0; ai < 2; ++ai)
#pragma unroll
            for (int m = 0; m < 4; ++m) { bf16_t* rowp = O + (size_t)(row0 + ai * HALF + m * 16) * ldc + col0;
                const float rs = ss ? __builtin_amdgcn_rsqf(ss[row0 + ai * HALF + m * 16] * (1.0f / 2048.0f) + 1e-6f) : 1.0f;
#pragma unroll
                for (int bj = 0; bj < 2; ++bj) { const f32x4 v0 = acc[ai][bj][m][0] * rs, v1 = acc[ai][bj][m][1] * rs;
                    u32x4 w; w.x = cvt_pk_bf16(v0[0], v0[1]); w.y = cvt_pk_bf16(v0[2], v0[3]); w.z = cvt_pk_bf16(v1[0], v1[1]); w.w = cvt_pk_bf16(v1[2], v1[3]);
                    *(u32x4*)(rowp + bj * HALF) = w; } }
    }
};
struct EpiSwiglu {
    static constexpr bool PERM = true, AFTER_DRAIN = false;
    bf16_t* H; int ldc; const float* ss;
    __device__ __forceinline__ void operator()(const f32x4 (&acc)[2][2][4][2], const Unit& u, int wr, int wc, int fr, int fq) const {
        const int row0 = u.pm * BM + wr * 64 + fr, col0 = u.pn * HALF + wc * 32 + 8 * fq;
#pragma unroll
        for (int ai = 0; ai < 2; ++ai)
#pragma unroll
            for (int m = 0; m < 4; ++m) { bf16_t* rowp = H + (size_t)(row0 + ai * HALF + m * 16) * ldc + col0;
                const float rs = ss ? __builtin_amdgcn_rsqf(ss[row0 + ai * HALF + m * 16] * (1.0f / 2048.0f) + 1e-6f) : 1.0f;
                float h[8];
#pragma unroll
                for (int n = 0; n < 2; ++n)
#pragma unroll
                    for (int j = 0; j < 4; ++j) { const float g = acc[ai][0][m][n][j] * rs, up = acc[ai][1][m][n][j] * rs; h[n * 4 + j] = g * sigm(g) * up; }
                u32x4 w; w.x = cvt_pk_bf16(h[0], h[1]); w.y = cvt_pk_bf16(h[2], h[3]); w.z = cvt_pk_bf16(h[4], h[5]); w.w = cvt_pk_bf16(h[6], h[7]);
                *(u32x4*)rowp = w; }
    }
};
template <bool BASEBF, bool OUTF32, bool OUTBF> struct EpiResid {
    static constexpr bool PERM = true, AFTER_DRAIN = false;
    const void* base; float* out; int ldc; float alpha; bf16_t* xb; float* ss;
    __device__ __forceinline__ void operator()(const f32x4 (&acc)[2][2][4][2], const Unit& u, int wr, int wc, int fr, int fq) const {
        const int row0 = u.pm * BM + wr * 64 + fr, col0 = u.pn * BM + wc * 32 + 8 * fq;
#pragma unroll
        for (int ai = 0; ai < 2; ++ai)
#pragma unroll
            for (int m = 0; m < 4; ++m) { const size_t off = (size_t)(row0 + ai * HALF + m * 16) * ldc + col0; float sq = 0.f;
#pragma unroll
                for (int bj = 0; bj < 2; ++bj) { f32x4 b0, b1;
                    if (BASEBF) { const u32x4 w = *(const u32x4*)((const bf16_t*)base + off + bj * HALF);
                        b0 = (f32x4){__uint_as_float(w.x << 16), __uint_as_float(w.x & 0xffff0000u), __uint_as_float(w.y << 16), __uint_as_float(w.y & 0xffff0000u)};
                        b1 = (f32x4){__uint_as_float(w.z << 16), __uint_as_float(w.z & 0xffff0000u), __uint_as_float(w.w << 16), __uint_as_float(w.w & 0xffff0000u)}; }
                    else { b0 = *(const f32x4*)((const float*)base + off + bj * HALF); b1 = *(const f32x4*)((const float*)base + off + bj * HALF + 4); }
                    const f32x4 o0 = b0 + acc[ai][bj][m][0] * alpha, o1 = b1 + acc[ai][bj][m][1] * alpha;
                    if (OUTF32) { *(f32x4*)(out + off + bj * HALF) = o0; *(f32x4*)(out + off + bj * HALF + 4) = o1; }
                    if (OUTBF) { sq += ((o0[0] * o0[0] + o0[1] * o0[1]) + (o0[2] * o0[2] + o0[3] * o0[3])) + ((o1[0] * o1[0] + o1[1] * o1[1]) + (o1[2] * o1[2] + o1[3] * o1[3]));
                        u32x4 w; w.x = cvt_pk_bf16(o0[0], o0[1]); w.y = cvt_pk_bf16(o0[2], o0[3]); w.z = cvt_pk_bf16(o1[0], o1[1]); w.w = cvt_pk_bf16(o1[2], o1[3]); *(u32x4*)(xb + off + bj * HALF) = w; } }
                if (OUTBF) { sq += __shfl_xor(sq, 16); sq += __shfl_xor(sq, 32); if (fq == 0) atomicAdd(ss + row0 + ai * HALF + m * 16, sq); } }
    }
};
template <int MODE> struct EpiGate {
    static constexpr bool PERM = true, AFTER_DRAIN = false;
    const bf16_t* G; bf16_t* T; int ldc;
    __device__ __forceinline__ void operator()(const f32x4 (&acc)[2][2][4][2], const Unit& u, int wr, int wc, int fr, int fq) const {
        const int row0 = u.pm * BM + wr * 64 + fr, col0 = u.pn * BM + wc * 32 + 8 * fq;
#pragma unroll
        for (int ai = 0; ai < 2; ++ai)
#pragma unroll
            for (int m = 0; m < 4; ++m) { const size_t off = (size_t)(row0 + ai * HALF + m * 16) * ldc + col0;
#pragma unroll
                for (int bj = 0; bj < 2; ++bj) { const u32x4 gw = *(const u32x4*)(G + off + bj * HALF); u32x4 tw = {0u, 0u, 0u, 0u}; if (MODE == 2) tw = *(const u32x4*)(T + off + bj * HALF);
                    float o[8];
#pragma unroll
                    for (int e = 0; e < 4; ++e) { const unsigned g2 = gw[e], t2 = tw[e]; const int n = e >> 1, j = (e & 1) * 2;
                        float a0 = sigm(__uint_as_float(g2 << 16)) * acc[ai][bj][m][n][j], a1 = sigm(__uint_as_float(g2 & 0xffff0000u)) * acc[ai][bj][m][n][j + 1];
                        if (MODE == 2) { a0 += __uint_as_float(t2 << 16); a1 += __uint_as_float(t2 & 0xffff0000u); }
                        o[2 * e] = a0; o[2 * e + 1] = a1; }
                    u32x4 w; w.x = cvt_pk_bf16(o[0], o[1]); w.y = cvt_pk_bf16(o[2], o[3]); w.z = cvt_pk_bf16(o[4], o[5]); w.w = cvt_pk_bf16(o[6], o[7]);
                    *(u32x4*)(T + off + bj * HALF) = w; } }
    }
};
template <class Epi, class Sched, bool ALIGN_EPI = false, bool SP2 = false>
__device__ __forceinline__ void gemm_phase(PG8_LAS unsigned char* lds, const Gemm g, const Sched& S, const Epi& E) {
    int tid_o = threadIdx.x; asm volatile("" : "+v"(tid_o));
    const int tid = tid_o, wid = __builtin_amdgcn_readfirstlane(tid >> 6), lane = tid & 63, wr = wid >> 2, wc = wid & 3, fr = lane & 15, fq = lane >> 4;
    const int K = g.K, nt = K / BK;
    unsigned voffA[2], voffB[2];
#pragma unroll
    for (int i = 0; i < 2; ++i) { int R, C; stage_rc(tid * 16 + i * 8192, R, C); const int Rb = Epi::PERM ? ((R & ~31) + perm32(R & 31)) : R;
        voffA[i] = (unsigned)(R * g.lda + C) * 2u; voffB[i] = (unsigned)(Rb * g.ldb + C) * 2u; }
    const size_t kstep = (size_t)(BK * 2);
    const size_t hstepA = (size_t)HALF * g.lda * 2, hstepB = (size_t)HALF * g.ldb * 2;
    const size_t tstepA = 2 * hstepA, tstepB = 2 * hstepB;
    const unsigned ldsw = (unsigned)wid * 1024u;
    const int aoff = lds_byte(wr * 64 + fr, fq * 8), boff = lds_byte(wc * 32 + fr, fq * 8);
#define PG8_SA(b, h) (((b) * 2 + (h)) * HTB)
#define PG8_SB(b, h) ((4 + (b) * 2 + (h)) * HTB)
#define PG8_STAGE(bufoff, gbase, voff) do { _Pragma("unroll") for (int _i = 0; _i < 2; ++_i) \
        __builtin_amdgcn_global_load_lds((const unsigned*)((const char*)(gbase) + (voff)[_i]), (PG8_LAS unsigned*)(lds + (bufoff) + ldsw + _i * 8192), 16, 0, 0); } while (0)
#define PG8_LDA(dst, b, h) do { _Pragma("unroll") for (int m = 0; m < 4; ++m) _Pragma("unroll") for (int k = 0; k < 2; ++k) dst[m][k] = *(const PG8_LAS bf16x8*)(lds + PG8_SA(b, h) + aoff + m * 2048 + k * 1024); } while (0)
#define PG8_LDB(dst, b, h) do { _Pragma("unroll") for (int n = 0; n < 2; ++n) _Pragma("unroll") for (int k = 0; k < 2; ++k) dst[n][k] = *(const PG8_LAS bf16x8*)(lds + PG8_SB(b, h) + boff + n * 2048 + k * 1024); } while (0)
#define PG8_MMA(ai, bj, At, Bt) do { __builtin_amdgcn_s_setprio(1); _Pragma("unroll") for (int m = 0; m < 4; ++m) _Pragma("unroll") for (int n = 0; n < 2; ++n) _Pragma("unroll") for (int k = 0; k < 2; ++k) \
        acc[ai][bj][m][n] = __builtin_amdgcn_mfma_f32_16x16x32_bf16(Bt[n][k], At[m][k], acc[ai][bj][m][n], 0, 0, 0); __builtin_amdgcn_s_setprio(0); } while (0)
#define PG8_WAIT_V(n) asm volatile("s_waitcnt vmcnt(" #n ")" ::: "memory")
#define PG8_WAIT_L(n) asm volatile("s_waitcnt lgkmcnt(" #n ")" ::: "memory")
#define PG8_BAR __builtin_amdgcn_s_barrier()
#define PG8_SCHED __builtin_amdgcn_sched_barrier(0)
    Unit cur, nxt; int ui = 0;
    if (!S.next(0, cur)) return;
    f32x4 acc[2][2][4][2];
#pragma unroll
    for (int a = 0; a < 2; ++a)
#pragma unroll
        for (int b = 0; b < 2; ++b)
#pragma unroll
            for (int m = 0; m < 4; ++m)
#pragma unroll
                for (int n = 0; n < 2; ++n) acc[a][b][m][n] = (f32x4){0.f, 0.f, 0.f, 0.f};
    bf16x8 At[4][2], B0[2][2], B1[2][2];
    const char* cA = (const char*)g.A + (size_t)cur.pm * tstepA; const char* cB = (const char*)g.Bt + (size_t)cur.pn * tstepB;
    S.a_ready(cur);
    if constexpr (SP2) {
        PG8_STAGE(PG8_SB(0, 0), cB, voffB); PG8_STAGE(PG8_SB(0, 1), cB + hstepB, voffB); PG8_STAGE(PG8_SA(0, 0), cA, voffA); PG8_STAGE(PG8_SA(0, 1), cA + hstepA, voffA);
        if (wr == 1) PG8_BAR;
        PG8_WAIT_V(2); PG8_BAR;
        PG8_STAGE(PG8_SB(1, 0), cB + kstep, voffB); PG8_STAGE(PG8_SA(1, 0), cA + kstep, voffA); PG8_STAGE(PG8_SB(1, 1), cB + hstepB + kstep, voffB);
        PG8_WAIT_V(6); PG8_BAR;
    } else {
        PG8_STAGE(PG8_SB(0, 0), cB, voffB); PG8_STAGE(PG8_SA(0, 0), cA, voffA); PG8_STAGE(PG8_SB(0, 1), cB + hstepB, voffB); PG8_STAGE(PG8_SA(0, 1), cA + hstepA, voffA);
        if (wr == 1) PG8_BAR;
        PG8_WAIT_V(4); PG8_BAR;
        PG8_STAGE(PG8_SB(1, 0), cB + kstep, voffB); PG8_STAGE(PG8_SA(1, 0), cA + kstep, voffA); PG8_STAGE(PG8_SB(1, 1), cB + hstepB + kstep, voffB);
        PG8_WAIT_V(6); PG8_BAR;
    }
    for (;;) {
        const bool has_next = S.next(ui + 1, nxt);
        const char* nA = has_next ? (const char*)g.A + (size_t)nxt.pm * tstepA : cA; const char* nB = has_next ? (const char*)g.Bt + (size_t)nxt.pn * tstepB : cB;
        for (int t = 0; t < nt; t += 2) {
            const bool last = (t == nt - 2);
            const char* a1 = cA + (size_t)(t + 1) * kstep;
            const char* a2 = last ? nA : cA + (size_t)(t + 2) * kstep; const char* b2 = last ? nB : cB + (size_t)(t + 2) * kstep;
            const char* a3 = a2 + kstep; const char* b3 = b2 + kstep;
            if (last && has_next) S.a_ready(nxt);
            if constexpr (SP2) {
            PG8_LDB(B0, 0, 0); PG8_LDB(B1, 0, 1); PG8_SCHED; PG8_LDA(At, 0, 0); PG8_STAGE(PG8_SA(1, 1), a1 + hstepA, voffA);
            PG8_WAIT_V(8); PG8_WAIT_L(0); PG8_BAR; PG8_MMA(0, 0, At, B0); PG8_MMA(0, 1, At, B1); PG8_BAR; PG8_SCHED;
            PG8_LDA(At, 0, 1); PG8_STAGE(PG8_SB(0, 0), b2, voffB); PG8_STAGE(PG8_SB(0, 1), b2 + hstepB, voffB); PG8_STAGE(PG8_SA(0, 0), a2, voffA);
            PG8_WAIT_V(8); PG8_WAIT_L(0); PG8_BAR; PG8_MMA(1, 0, At, B0); PG8_MMA(1, 1, At, B1); PG8_BAR; PG8_SCHED;
            PG8_LDB(B0, 1, 0); PG8_LDB(B1, 1, 1); PG8_SCHED; PG8_LDA(At, 1, 0); PG8_STAGE(PG8_SA(0, 1), a2 + hstepA, voffA);
            PG8_WAIT_V(8); PG8_WAIT_L(0); PG8_BAR; PG8_MMA(0, 0, At, B0); PG8_MMA(0, 1, At, B1); PG8_BAR; PG8_SCHED;
            PG8_LDA(At, 1, 1); PG8_STAGE(PG8_SB(1, 0), b3, voffB); PG8_STAGE(PG8_SB(1, 1), b3 + hstepB, voffB); PG8_STAGE(PG8_SA(1, 0), a3, voffA);
            PG8_WAIT_V(8); PG8_WAIT_L(0); PG8_BAR; PG8_MMA(1, 0, At, B0); PG8_MMA(1, 1, At, B1); PG8_BAR; PG8_SCHED;
            } else {
            PG8_LDB(B0, 0, 0); PG8_SCHED; PG8_LDA(At, 0, 0); PG8_STAGE(PG8_SA(1, 1), a1 + hstepA, voffA);
            PG8_WAIT_L(8); PG8_BAR; PG8_WAIT_L(0); PG8_MMA(0, 0, At, B0); PG8_BAR; PG8_SCHED;
            PG8_LDB(B1, 0, 1); PG8_STAGE(PG8_SB(0, 0), b2, voffB);
            PG8_BAR; PG8_WAIT_L(0); PG8_MMA(0, 1, At, B1); PG8_BAR;
            PG8_LDA(At, 0, 1); PG8_STAGE(PG8_SA(0, 0), a2, voffA);
            PG8_BAR; PG8_WAIT_L(0); PG8_MMA(1, 0, At, B0); PG8_BAR; PG8_SCHED;
            PG8_STAGE(PG8_SB(0, 1), b2 + hstepB, voffB);
            PG8_WAIT_V(6); PG8_BAR; PG8_MMA(1, 1, At, B1); PG8_BAR;
            PG8_LDB(B0, 1, 0); PG8_SCHED; PG8_LDA(At, 1, 0); PG8_STAGE(PG8_SA(0, 1), a2 + hstepA, voffA);
            PG8_WAIT_L(8); PG8_BAR; PG8_WAIT_L(0); PG8_MMA(0, 0, At, B0); PG8_BAR; PG8_SCHED;
            PG8_LDB(B1, 1, 1); PG8_STAGE(PG8_SB(1, 0), b3, voffB);
            PG8_BAR; PG8_WAIT_L(0); PG8_MMA(0, 1, At, B1); PG8_BAR;
            PG8_LDA(At, 1, 1); PG8_STAGE(PG8_SA(1, 0), a3, voffA);
            PG8_BAR; PG8_WAIT_L(0); PG8_MMA(1, 0, At, B0); PG8_BAR; PG8_SCHED;
            PG8_STAGE(PG8_SB(1, 1), b3 + hstepB, voffB);
            PG8_WAIT_V(6); PG8_BAR; PG8_MMA(1, 1, At, B1); PG8_BAR;
            }
        }
        if constexpr (ALIGN_EPI) { if (wr == 0) PG8_BAR; }
        if constexpr (!Epi::AFTER_DRAIN) { E(acc, cur, wr, wc, fr, fq); S.done(cur); }
        if (!has_next) break;
#pragma unroll
        for (int a = 0; a < 2; ++a)
#pragma unroll
            for (int b = 0; b < 2; ++b)
#pragma unroll
                for (int m = 0; m < 4; ++m)
#pragma unroll
                    for (int n = 0; n < 2; ++n) acc[a][b][m][n] = (f32x4){0.f, 0.f, 0.f, 0.f};
        cur = nxt; cA = nA; cB = nB; ++ui;
        if constexpr (ALIGN_EPI) { if (wr == 1) PG8_BAR; }
    }
    PG8_WAIT_V(0);
    if constexpr (!ALIGN_EPI) { if (wr == 0) PG8_BAR; }
    PG8_BAR;
    if constexpr (Epi::AFTER_DRAIN) { E.fused(acc, cur, wr, wc, fr, fq, lds, wid, lane); S.done(cur); }
#undef PG8_SA
#undef PG8_SB
#undef PG8_STAGE
#undef PG8_LDA
#undef PG8_LDB
#undef PG8_MMA
#undef PG8_WAIT_V
#undef PG8_WAIT_L
#undef PG8_BAR
#undef PG8_SCHED
}
}
namespace attn {
using bf16 = __hip_bfloat16;
typedef short bf16x8 __attribute__((ext_vector_type(8)));
typedef short s16x4 __attribute__((ext_vector_type(4)));
typedef float f32x16 __attribute__((ext_vector_type(16)));
typedef float f32x4 __attribute__((ext_vector_type(4)));
typedef unsigned u32x4 __attribute__((ext_vector_type(4)));
template <class A, class Bt> struct same_t { static constexpr bool v = false; };
template <class A> struct same_t<A, A> { static constexpr bool v = true; };
constexpr int D = 128, PITCH = PP;
constexpr float THR = 8.f;
constexpr bool WSKIP = false;
constexpr float SCALE = 0.08838834764831845f;
constexpr int NW = 8, QBLK = 32, KVBLK = 64, QB = NW * QBLK;
constexpr int SHM_V = KVBLK * D * 2, SHM_K = KVBLK * D * 2;
constexpr int ATT_LDS_BYTES = 2 * SHM_V + 2 * SHM_K + NW * 64 * 4;
#define KSWZ(row, colB) ((row) * 256 + ((colB) ^ (((row) & 7) << 4)))
#define SBAR() __builtin_amdgcn_sched_barrier(0)
__device__ __forceinline__ int v_st(int k, int c) { const int kk = (k & ~0xC) | ((k & 4) << 1) | ((k & 8) >> 1); return ((kk >> 3) * 4 + (c >> 5)) * 512 + ((kk & 7) * 32 + (c & 31)) * 2; }
__device__ __forceinline__ int v_rd_base(int lane) { return ((lane & 3) << 3) | (((lane >> 2) & 3) << 6) | (((lane >> 4) & 1) << 5) | (((lane >> 5) & 1) << 8); }
constexpr int v_rd_off(int d0, int ks, int half) { return d0 * 512 + ks * 4096 + half * 2048; }
__device__ __forceinline__ int crow(int r, int hi) { return (r & 3) + 8 * (r >> 2) + 4 * hi; }
__device__ __forceinline__ unsigned cvtpk(float lo, float hi) {
    unsigned r; asm volatile("v_cvt_pk_bf16_f32 %0, %1, %2" : "=v"(r) : "v"(lo), "v"(hi)); return r;
}
__device__ __forceinline__ bf16x8 pack8(f32x4 a, f32x4 b) {
    u32x4 w = {cvtpk(a[0], a[1]), cvtpk(a[2], a[3]), cvtpk(b[0], b[1]), cvtpk(b[2], b[3])};
    return *reinterpret_cast<bf16x8*>(&w);
}
template <class T> __device__ __forceinline__ bf16x8 load8(const T* p) {
    if constexpr (same_t<T, float>::v) { return pack8(*(const f32x4*)p, *(const f32x4*)(p + 4)); }
    else { return *reinterpret_cast<const bf16x8*>(p); }
}
__device__ __forceinline__ void mask_bits(f32x16& p0, f32x16& p1, unsigned long long mw, int hi) {
    const float NEG = -__builtin_inff();
    const unsigned a = (unsigned)mw >> (4 * hi), b = (unsigned)(mw >> 32) >> (4 * hi);
#pragma unroll
    for (int r = 0; r < 16; ++r) {
        const int c = (r & 3) + 8 * (r >> 2);
        if (!((a >> c) & 1u)) p0[r] = NEG;
        if (!((b >> c) & 1u)) p1[r] = NEG;
    }
}
__device__ __forceinline__ void partialSM(f32x16& p0, f32x16& p1, float& m_reg, float& mn, float& alpha) {
    float pmax = p0[0]; for (int r = 1; r < 16; ++r) pmax = fmaxf(pmax, p0[r]); for (int r = 0; r < 16; ++r) pmax = fmaxf(pmax, p1[r]);
    { auto rr = __builtin_amdgcn_permlane32_swap(__float_as_uint(pmax), __float_as_uint(pmax), false, false);
      pmax = fmaxf(__uint_as_float(rr[0]), __uint_as_float(rr[1])); }
    constexpr float C2 = 1.4426950408889634f * SCALE;
    if (__builtin_expect(__all((pmax - m_reg) * SCALE <= THR), 1)) { mn = m_reg; alpha = 1.f; }
    else { mn = fmaxf(m_reg, pmax); alpha = __builtin_amdgcn_exp2f((m_reg - mn) * C2); m_reg = mn; }
    const float mnL = -mn * C2;
    for (int r = 0; r < 16; ++r) p0[r] = fmaf(p0[r], C2, mnL); for (int r = 0; r < 16; ++r) p1[r] = fmaf(p1[r], C2, mnL);
    for (int r = 0; r < 16; ++r) p0[r] = __builtin_amdgcn_exp2f(p0[r]);
}
__device__ __forceinline__ void finishSM(f32x16& p0, f32x16& p1, float alpha, float& l_reg, bf16x8& pa0, bf16x8& pa1, bf16x8& pa2, bf16x8& pa3) {
    for (int r = 0; r < 16; ++r) p1[r] = __builtin_amdgcn_exp2f(p1[r]);
    float ps = 0; for (int r = 0; r < 16; ++r) ps += p0[r]; for (int r = 0; r < 16; ++r) ps += p1[r];
    { auto rr = __builtin_amdgcn_permlane32_swap(__float_as_uint(ps), __float_as_uint(ps), false, false);
      ps = __uint_as_float(rr[0]) + __uint_as_float(rr[1]); }
    l_reg = l_reg * alpha + ps;
#define PK4(P, B_, OUT) do { unsigned a0 = cvtpk(P[B_+0], P[B_+1]), a1 = cvtpk(P[B_+2], P[B_+3]);                          \
        unsigned b0 = cvtpk(P[B_+4], P[B_+5]), b1 = cvtpk(P[B_+6], P[B_+7]);                                             \
        auto r0 = __builtin_amdgcn_permlane32_swap(a0, b0, false, false); auto r1 = __builtin_amdgcn_permlane32_swap(a1, b1, false, false); \
        u32x4 w = {r0[0], r1[0], r0[1], r1[1]}; OUT = *reinterpret_cast<bf16x8*>(&w); } while (0)
    PK4(p0, 0, pa0); PK4(p0, 8, pa1); PK4(p1, 0, pa2); PK4(p1, 8, pa3);
#undef PK4
}
template <int KB, bool SK>
__device__ __forceinline__ void qkt(f32x16& p0, f32x16& p1, const char* K_lds, int r32, int hi, const bf16x8* qr, bool act) {
    if (SK && !act) { const float NEG = -__builtin_inff();
#pragma unroll
        for (int r = 0; r < 16; ++r) { p0[r] = NEG; p1[r] = NEG; } return; }
    p0 = f32x16{}; p1 = f32x16{};
    const char* kb[4];
#pragma unroll
    for (int dd = 0; dd < 4; ++dd) kb[dd] = K_lds + KB * SHM_K + KSWZ(r32, (dd * 16 + hi * 8) * 2);
#pragma unroll
    for (int d0 = 0; d0 < 8; ++d0) { const char* a = kb[d0 & 3] + (d0 >> 2) * 128;
        bf16x8 b0 = *reinterpret_cast<const bf16x8*>(a);
        bf16x8 b1 = *reinterpret_cast<const bf16x8*>(a + 32 * 256);
        p0 = __builtin_amdgcn_mfma_f32_32x32x16_bf16(b0, qr[d0], p0, 0, 0, 0);
        p1 = __builtin_amdgcn_mfma_f32_32x32x16_bf16(b1, qr[d0], p1, 0, 0, 0); }
}
template <int VB, bool SK>
__device__ __forceinline__ void pv_tile(f32x16* o, int vb0, bf16x8 pa0, bf16x8 pa1, bf16x8 pa2, bf16x8 pa3, bool act) {
    if (SK && !act) return;
#define TRRD(dst, off) asm volatile("ds_read_b64_tr_b16 %0, %1 offset:%2" : "=&v"(dst) : "v"(vb0), "i"(off) : "memory")
#define PV_D0(d0) do { s16x4 l0, l1, l2, l3, h0, h1, h2, h3; constexpr int b_ = VB * SHM_V + v_rd_off(d0, 0, 0);     \
        TRRD(l0, b_); TRRD(h0, b_ + 2048); TRRD(l1, b_ + 4096); TRRD(h1, b_ + 6144); TRRD(l2, b_ + 8192); TRRD(h2, b_ + 10240); TRRD(l3, b_ + 12288); TRRD(h3, b_ + 14336); \
        asm volatile("s_waitcnt lgkmcnt(0)" ::: "memory"); SBAR();                 \
        o[d0] = __builtin_amdgcn_mfma_f32_32x32x16_bf16(pa0, (bf16x8){l0[0], l0[1], l0[2], l0[3], h0[0], h0[1], h0[2], h0[3]}, o[d0], 0, 0, 0);   \
        o[d0] = __builtin_amdgcn_mfma_f32_32x32x16_bf16(pa1, (bf16x8){l1[0], l1[1], l1[2], l1[3], h1[0], h1[1], h1[2], h1[3]}, o[d0], 0, 0, 0);   \
        o[d0] = __builtin_amdgcn_mfma_f32_32x32x16_bf16(pa2, (bf16x8){l2[0], l2[1], l2[2], l2[3], h2[0], h2[1], h2[2], h2[3]}, o[d0], 0, 0, 0);   \
        o[d0] = __builtin_amdgcn_mfma_f32_32x32x16_bf16(pa3, (bf16x8){l3[0], l3[1], l3[2], l3[3], h3[0], h3[1], h3[2], h3[3]}, o[d0], 0, 0, 0); } while (0)
    PV_D0(0); PV_D0(1); PV_D0(2); PV_D0(3);
#undef PV_D0
#undef TRRD
}
template <class TIn, class TOut> struct BlockRef { const TIn* Q; const TIn* K; const TIn* V; TOut* O; const unsigned long long* MK; int P0; };
template <class TIn> struct Seam {
    bf16x8 qr[8];
    bf16x8 st_v0, st_v1, st_k0, st_k1; f32x4 sf0, sf1, sf2, sf3;
    f32x4 tq[16];
};
__device__ __forceinline__ int swa_jlo(int P0, int W) { const int lowk = P0 - W + 1; return lowk > 0 ? lowk / KVBLK : 0; }
#define ROW(p, k0, rr) ((p) + (size_t)((k0) + (rr)) * PITCH + sc)
#define VMW() asm volatile("s_waitcnt vmcnt(0)" ::: "memory")
#define VMWN(n) asm volatile("s_waitcnt vmcnt(%0)" :: "i"(n) : "memory")
#define SLOAD_H(Kp, Vp, k0) do { S.st_v0 = load8<TIn>(ROW(Vp, k0, sr)); S.st_v1 = load8<TIn>(ROW(Vp, k0, 32 + sr));              \
                         S.st_k0 = load8<TIn>(ROW(Kp, k0, sr)); S.st_k1 = load8<TIn>(ROW(Kp, k0, 32 + sr)); } while (0)
#define SWRITE_HK(bf) do { *(bf16x8*)(K_lds + (bf) * SHM_K + kws) = S.st_k0; *(bf16x8*)(K_lds + (bf) * SHM_K + kws + 32 * 256) = S.st_k1; } while (0)
#define SWRITE_HV(bf) do { *(bf16x8*)(V_lds + (bf) * SHM_V + vst0) = S.st_v0; *(bf16x8*)(V_lds + (bf) * SHM_V + vst1) = S.st_v1; } while (0)
#define SWRITE_H(bf) do { SWRITE_HV(bf); SWRITE_HK(bf); } while (0)
#define SLOAD_F(p, k0) do { S.sf0 = *(const f32x4*)ROW(p, k0, sr); S.sf1 = *(const f32x4*)(ROW(p, k0, sr) + 4);                \
                            S.sf2 = *(const f32x4*)ROW(p, k0, 32 + sr); S.sf3 = *(const f32x4*)(ROW(p, k0, 32 + sr) + 4); } while (0)
#define SWRITE_KF(bf) do { *(bf16x8*)(K_lds + (bf) * SHM_K + kws) = pack8(S.sf0, S.sf1); *(bf16x8*)(K_lds + (bf) * SHM_K + kws + 32 * 256) = pack8(S.sf2, S.sf3); } while (0)
#define SWRITE_VF(bf) do { *(bf16x8*)(V_lds + (bf) * SHM_V + vst0) = pack8(S.sf0, S.sf1); *(bf16x8*)(V_lds + (bf) * SHM_V + vst1) = pack8(S.sf2, S.sf3); } while (0)
template <class TIn, class TOut>
__device__ __forceinline__ void causal_swa_prime(const BlockRef<TIn, TOut>& cur, int W, char* lds, Seam<TIn>& S) {
    constexpr bool F32 = same_t<TIn, float>::v;
    const int tid = threadIdx.x, wid = __builtin_amdgcn_readfirstlane(tid >> 6), lane = tid & 63, r32 = lane & 31, hi = lane >> 5;
    const int sr = tid >> 4, sc = (tid & 15) * 8, kws = KSWZ(sr, sc * 2); char* K_lds = lds + 2 * SHM_V;
    const int kb0 = swa_jlo(cur.P0, W) * KVBLK;
    for (int d0 = 0; d0 < 8; ++d0) S.qr[d0] = load8<TIn>(cur.Q + (size_t)(wid * QBLK + r32) * PITCH + d0 * 16 + hi * 8);
    if constexpr (F32) { SLOAD_F((const float*)cur.K, kb0); VMW(); SWRITE_KF(0); SBAR(); SLOAD_F((const float*)cur.V, kb0); }
    else { SLOAD_H(cur.K, cur.V, kb0); VMW(); SWRITE_HK(0); }
    __syncthreads();
}
template <class TIn, class TOut>
__device__ __forceinline__ void causal_swa_block(const BlockRef<TIn, TOut>& cur, const BlockRef<TIn, TOut>& nxt, int skv, int W, char* lds, Seam<TIn>& S) {
    constexpr bool F32 = same_t<TIn, float>::v;
    const int tid = threadIdx.x, wid = __builtin_amdgcn_readfirstlane(tid >> 6), lane = tid & 63, r32 = lane & 31, hi = lane >> 5;
    const int j_lo = swa_jlo(cur.P0, W);
    int j_hi = (cur.P0 + QB - 1) / KVBLK + 1; if (j_hi > skv / KVBLK) j_hi = skv / KVBLK;
    const int NT = j_hi - j_lo;
    const int kbn = swa_jlo(nxt.P0, W) * KVBLK;
    const int qlo = cur.P0 + wid * QBLK, qm = qlo + r32 - 4 * hi;
    char* V_lds = lds; char* K_lds = lds + 2 * SHM_V;
    float* ws = (float*)(lds + 2 * SHM_V + 2 * SHM_K) + wid * 64; float* li_l = ws, * al_l = ws + 32;
    float m_reg = -1e30f, l_reg = 0; f32x16 o[4] = {};
    const int sr = tid >> 4, sc = (tid & 15) * 8, vst0 = v_st(sr, sc), vst1 = v_st(32 + sr, sc), kws = KSWZ(sr, sc * 2);
    const int vb0 = (int)(uintptr_t)V_lds + v_rd_base(lane);
    const TIn* Kh = cur.K; const TIn* Vh = cur.V;
    const unsigned long long* mrow = cur.MK + (size_t)(wid * QBLK + r32) * 128; unsigned long long mwA, mwB = 0ull;
#define RESC(a) do { if (__any((a) < 1.f)) { if (hi == 0) al_l[r32] = (a); asm volatile("s_waitcnt lgkmcnt(0)" ::: "memory");              \
                     for (int d_ = 0; d_ < 4; ++d_) for (int r = 0; r < 16; ++r) o[d_][r] *= al_l[crow(r, hi)]; } } while (0)
#define KBASE(t) ((j_lo + (t)) * KVBLK)
#define ACT(t) (KBASE(t) <= qlo + QBLK - 1 && KBASE(t) + KVBLK - 1 >= qlo - W + 1)
#define MASKT(P0_, P1_, MW_) mask_bits(P0_, P1_, MW_, hi)
    constexpr int NQL = F32 ? 16 : 8;
    constexpr bool SK = WSKIP && !F32;
#define SEAM_K0() do { VMWN(NQL); if constexpr (F32) { SWRITE_KF(0); SBAR(); SLOAD_F((const float*)nxt.V, kbn); } else { SWRITE_HK(0); } SBAR(); } while (0)
    f32x16 pA0, pA1, pB0, pB1; float mnA, mnB, alA, alB; bf16x8 pa0, pa1, pa2, pa3;
    if constexpr (F32) { VMW(); SWRITE_VF(0); SBAR(); } else { SWRITE_HV(0); SBAR(); }
    if (NT > 1) { if constexpr (F32) SLOAD_F((const float*)Kh, KBASE(1)); else SLOAD_H(Kh, Vh, KBASE(1)); }
    mwA = mrow[0]; SBAR(); qkt<0, SK>(pA0, pA1, K_lds, r32, hi, S.qr, ACT(0));
    if constexpr (F32) { if (NT > 1) { VMW(); SWRITE_KF(1); SBAR(); SLOAD_F((const float*)Vh, KBASE(1)); } }
    MASKT(pA0, pA1, mwA); partialSM(pA0, pA1, m_reg, mnA, alA);
    if (NT > 1) { VMW(); if constexpr (F32) { SWRITE_VF(1); SBAR(); if (NT > 2) SLOAD_F((const float*)Kh, KBASE(2)); } else SWRITE_H(1); }
    __syncthreads();
#define HALF_STEP(PX0, PX1, mnX, alX, PY0, PY1, alY, t, KB, VB, SB, MWX) do {                                                      \
        MWX = mrow[(t)]; SBAR(); qkt<KB, SK>(PX0, PX1, K_lds, r32, hi, S.qr, ACT(t));                                             \
        finishSM(PY0, PY1, alY, l_reg, pa0, pa1, pa2, pa3); SBAR();                                                           \
        if ((t) + 1 < NT) { if constexpr (F32) { VMW(); SWRITE_KF(SB); SBAR(); SLOAD_F((const float*)Vh, KBASE((t) + 1)); }  \
                            else { SLOAD_H(Kh, Vh, KBASE((t) + 1)); } SBAR(); }                                               \
        pv_tile<VB, SK>(o, vb0, pa0, pa1, pa2, pa3, ACT((t) - 1)); MASKT(PX0, PX1, MWX); partialSM(PX0, PX1, m_reg, mnX, alX);                                        \
        __syncthreads();                                                                                                      \
        if ((t) + 1 < NT) { VMW(); if constexpr (F32) { SWRITE_VF(SB); SBAR(); if ((t) + 2 < NT) SLOAD_F((const float*)Kh, KBASE((t) + 2)); } \
                            else { SWRITE_H(SB); } }                                                                          \
        RESC(alX); __syncthreads(); } while (0)
    for (int t = 1; t + 1 < NT; t += 2) {
        HALF_STEP(pB0, pB1, mnB, alB, pA0, pA1, alA, t, 1, 0, 0, mwB);
        HALF_STEP(pA0, pA1, mnA, alA, pB0, pB1, alB, t + 1, 0, 1, 1, mwA);
    }
    const bool even = (NT & 1) == 0;
    if (even) { mwB = mrow[NT - 1]; SBAR(); qkt<1, SK>(pB0, pB1, K_lds, r32, hi, S.qr, ACT(NT - 1)); SBAR(); }
#define QROW(e) (nxt.Q + (size_t)(wid * QBLK + r32) * PITCH + ((e) >> 1) * 16 + hi * 8 + ((e) & 1) * 4)
    if constexpr (F32) { SLOAD_F((const float*)nxt.K, kbn); SBAR();
#pragma unroll
        for (int e = 0; e < 8; ++e) S.tq[e] = *(const f32x4*)QROW(e); }
    else { SLOAD_H(nxt.K, nxt.V, kbn); SBAR();
#pragma unroll
        for (int d0 = 0; d0 < 8; ++d0) S.qr[d0] = load8<TIn>(nxt.Q + (size_t)(wid * QBLK + r32) * PITCH + d0 * 16 + hi * 8); }
    SBAR();
    finishSM(pA0, pA1, alA, l_reg, pa0, pa1, pa2, pa3); SBAR();
    if constexpr (F32) {
#pragma unroll
        for (int e = 8; e < 16; ++e) S.tq[e] = *(const f32x4*)QROW(e); SBAR(); }
#undef QROW
    pv_tile<0, SK>(o, vb0, pa0, pa1, pa2, pa3, ACT(even ? NT - 2 : NT - 1));
    if (even) { MASKT(pB0, pB1, mwB); partialSM(pB0, pB1, m_reg, mnB, alB); __syncthreads(); RESC(alB);
        finishSM(pB0, pB1, alB, l_reg, pa0, pa1, pa2, pa3); SBAR(); pv_tile<1, SK>(o, vb0, pa0, pa1, pa2, pa3, ACT(NT - 1)); }
    SBAR(); SEAM_K0();
    if (hi == 0) li_l[r32] = l_reg; asm volatile("s_waitcnt lgkmcnt(0)" ::: "memory");
    float rli[16];
#pragma unroll
    for (int r = 0; r < 16; ++r) rli[r] = __builtin_amdgcn_rcpf(li_l[crow(r, hi)]);
    TOut* Ow = cur.O + (size_t)(wid * QBLK) * PITCH;
#pragma unroll
    for (int r = 0; r < 16; ++r) { const int orow = crow(r, hi);
#pragma unroll
        for (int d0 = 0; d0 < 4; ++d0) { const float v = o[d0][r] * rli[r];
            if constexpr (same_t<TOut, float>::v) { Ow[(size_t)orow * PITCH + d0 * 32 + r32] = v; }
            else { const float vn = __shfl_xor(v, 1);
                   if ((r32 & 1) == 0) *(unsigned*)(Ow + (size_t)orow * PITCH + d0 * 32 + r32) = cvtpk(v, vn); } } }
    if constexpr (F32) {
#pragma unroll
        for (int d0 = 0; d0 < 8; ++d0) S.qr[d0] = pack8(S.tq[2 * d0], S.tq[2 * d0 + 1]); }
    __syncthreads();
#undef RESC
#undef KBASE
#undef ACT
#undef MASKT
#undef SEAM_K0
#undef HALF_STEP
}
#undef ROW
#undef VMW
#undef VMWN
#undef SLOAD_H
#undef SWRITE_HK
#undef SWRITE_HV
#undef SWRITE_H
#undef SLOAD_F
#undef SWRITE_KF
#undef SWRITE_VF

#undef KSWZ
#undef SBAR
}

struct Params { const float* in[21]; float* out; unsigned char* ws; };
__constant__ float ROPE_INVF[24] = { 1.000000000e+00f, 4.403665960e-01f, 1.939227432e-01f, 8.539710194e-02f, 3.760603070e-02f, 1.656044088e-02f, 7.292664610e-03f, 3.211446106e-03f,
    1.414213562e-03f, 6.227724371e-04f, 2.742481884e-04f, 1.207697351e-04f, 5.318295734e-05f, 2.341999971e-05f, 1.031338525e-05f, 4.541670478e-06f,
    1.000000000e+00f, 1.939227432e-01f, 3.760603070e-02f, 7.292664610e-03f, 1.414213562e-03f, 2.742481884e-04f, 5.318295734e-05f, 1.031338525e-05f };
constexpr int CW_IDXQ = 64;
constexpr int CW_BAR = 4096;
#define XCD_BAR_WORDS 3456

#define LDS_WAIT() asm volatile("s_waitcnt lgkmcnt(0)" ::: "memory")

__device__ __forceinline__ int rowmap(int mode, int c) {
    if (mode == 1) return ((c >> 7) << 8) + (c & 127);
    if (mode == 2) return ((c >> 7) << 8) + 128 + (c & 127);
    if (mode == 3) return c < 4176 ? c : c + 176;
    return c;
}
__device__ __forceinline__ void transpose_item(const float* __restrict__ W, int K, int N, bf16raw* WT, int mode, LAS float* scr, int item, int lane, const float* __restrict__ gain = nullptr) {
    const int nblk = (N + 63) >> 6, kb = item / nblk, nb = item - kb * nblk, k0 = 64 * kb, n0 = 64 * nb;
    const int nn = n0 + (lane & 15) * 4; const bool ok = nn + 3 < N;
#pragma unroll 8
    for (int i = 0; i < 16; ++i) { const int kk = 4 * i + (lane >> 4); f32x4_t v = {0.f, 0.f, 0.f, 0.f}; if (ok) v = *(const f32x4_t*)(W + (size_t)(k0 + kk) * N + nn);
        if (gain) v = v * gain[k0 + kk];
        LAS float* d = scr + kk * 65 + (lane & 15) * 4; d[0] = v.x; d[1] = v.y; d[2] = v.z; d[3] = v.w; }
    LDS_WAIT();
    const int c = lane & 7;
#pragma unroll
    for (int j = 0; j < 8; ++j) { const int n = (lane >> 3) + 8 * j; const LAS float* s = scr + (8 * c) * 65 + n;
        u32x4_t o; o.x = pkbf(s[0 * 65], s[1 * 65]); o.y = pkbf(s[2 * 65], s[3 * 65]); o.z = pkbf(s[4 * 65], s[5 * 65]); o.w = pkbf(s[6 * 65], s[7 * 65]);
        if (n0 + n < N) *(u32x4_t*)(WT + (size_t)rowmap(mode, n0 + n) * K + k0 + 8 * c) = o; }
    LDS_WAIT();
}
__device__ __forceinline__ void rms_row(const float* __restrict__ xrow, const float* __restrict__ g, bf16raw* orow, int lane) {
    f32x4_t v[8]; float s = 0.f;
#pragma unroll
    for (int j = 0; j < 8; ++j) { v[j] = ((const f32x4_t*)xrow)[64 * j + lane]; s += (v[j].x * v[j].x + v[j].y * v[j].y) + (v[j].z * v[j].z + v[j].w * v[j].w); }
    const float r = 1.0f / sqrtf(wave_sum(s) * (1.0f / DM) + EPS);
#pragma unroll
    for (int j = 0; j < 8; ++j) { const f32x4_t gv = ((const f32x4_t*)g)[64 * j + lane]; u32x2_t o; o.x = pkbf(v[j].x * r * gv.x, v[j].y * r * gv.y); o.y = pkbf(v[j].z * r * gv.z, v[j].w * r * gv.w);
        ((u32x2_t*)orow)[64 * j + lane] = o; }
}
__device__ __forceinline__ void rms_phase(const float* x, const float* g, bf16raw* xn, int gw, int ngw, int lane) {
    for (int m = gw; m < MTOK; m += ngw) rms_row(x + (size_t)m * DM, g, xn + (size_t)m * DM, lane);
}
__device__ __forceinline__ void p0_prologue(const Params& P, LAS unsigned char* lds, int tid, int lane, int wave) {
    unsigned char* ws = P.ws;
    LAS float* scr = (LAS float*)(lds + wave * 16640);
    const int gw = blockIdx.x * NWAVES + wave, ngw = gridDim.x * NWAVES;
    constexpr int I_G = 32 * 88, I_D = 88 * 32, I_IN = 32 * 162, I_UA = 16 * 32, I_OUT = 32 * 32;
    constexpr int NITEMS = 4 * I_G + 2 * I_D + I_IN + 2 * I_UA + I_OUT;
    for (int it = gw; it < NITEMS; it += ngw) {
        int r = it;
        if (r < I_G) { transpose_item(P.in[3], DM, DFF, (bf16raw*)(ws + WS_WGU1), 1, scr, r, lane); continue; } r -= I_G;
        if (r < I_G) { transpose_item(P.in[4], DM, DFF, (bf16raw*)(ws + WS_WGU1), 2, scr, r, lane); continue; } r -= I_G;
        if (r < I_D) { transpose_item(P.in[5], DFF, DM, (bf16raw*)(ws + WS_WD1), 0, scr, r, lane); continue; } r -= I_D;
        if (r < I_G) { transpose_item(P.in[18], DM, DFF, (bf16raw*)(ws + WS_WGU2), 1, scr, r, lane, P.in[17]); continue; } r -= I_G;
        if (r < I_G) { transpose_item(P.in[19], DM, DFF, (bf16raw*)(ws + WS_WGU2), 2, scr, r, lane, P.in[17]); continue; } r -= I_G;
        if (r < I_D) { transpose_item(P.in[20], DFF, DM, (bf16raw*)(ws + WS_WD2), 0, scr, r, lane); continue; } r -= I_D;
        if (r < I_IN) { transpose_item(P.in[7], DM, 10320, (bf16raw*)(ws + WS_WIN), 3, scr, r, lane, P.in[6]); continue; } r -= I_IN;
        if (r < I_UA) { transpose_item(P.in[14], 1024, DM, (bf16raw*)(ws + WS_WUA), 0, scr, r, lane); continue; } r -= I_UA;
        if (r < I_UA) { transpose_item(P.in[15], 1024, DM, (bf16raw*)(ws + WS_WUS), 0, scr, r, lane); continue; } r -= I_UA;
        transpose_item(P.in[16], DM, DM, (bf16raw*)(ws + WS_WOUT), 0, scr, r, lane);
    }
    const int gt = blockIdx.x * NTHR + tid, ngt = gridDim.x * NTHR;
    { u32x4_t* padp = (u32x4_t*)((bf16raw*)(ws + WS_WIN) + (size_t)4176 * DM);
      for (int i = gt; i < 176 * DM / 8; i += ngt) padp[i] = (u32x4_t){0u, 0u, 0u, 0u}; }
    { const float* w_s = P.in[12]; bf16raw* wsb = (bf16raw*)(ws + WS_WSB);
      for (int i = gt; i < 8 * 128 * 128; i += ngt) { const int s = i & 127, t = (i >> 7) & 127; const float v = (t < 64 && s >= 64) ? 0.f : w_s[i]; wsb[i] = (bf16raw)(pkbf(v, 0.f) & 0xffffu); } }
    if (blockIdx.x == 0 && tid < 128) ((unsigned*)(ws + WS_CTL))[tid] = 0u;
    if (blockIdx.x == 0) { unsigned* bw = (unsigned*)(ws + WS_CTL) + CW_BAR; for (int i = tid; i < XCD_BAR_WORDS; i += NTHR) bw[i] = 0u; }
    { float* ssz = (float*)(ws + WS_SS1); for (int i = gt; i < 2 * MTOK; i += ngt) ssz[i] = 0.f; }
    rms_phase(P.in[0], P.in[2], (bf16raw*)(ws + WS_XN), gw, ngw, lane);
}

template <class Epi> __device__ __forceinline__ void run_gemm(LAS unsigned char* lds, const bf16raw* A, int lda, const bf16raw* Bt, int ldb, int N, int K, const Epi& E) {
    pg8::Gemm g{A, Bt, MTOK, N, K, lda, ldb}; pg8::StaticOrder S; S.init(MTOK, N, (int)gridDim.x, (int)blockIdx.x);
    pg8::gemm_phase<Epi, pg8::StaticOrder, true, true>(lds, g, S, E);
}

__device__ __forceinline__ void ld16(const bf16raw* p, float (&v)[16]) {
    const u32x4_t a = *(const u32x4_t*)p, b = *(const u32x4_t*)(p + 8);
#pragma unroll
    for (int e = 0; e < 4; ++e) { v[2 * e] = bflo(a[e]); v[2 * e + 1] = bfhi(a[e]); v[8 + 2 * e] = bflo(b[e]); v[8 + 2 * e + 1] = bfhi(b[e]); }
}
__device__ __forceinline__ void st16(bf16raw* p, const float (&v)[16]) {
    u32x4_t a, b;
#pragma unroll
    for (int e = 0; e < 4; ++e) { a[e] = pkbf(v[2 * e], v[2 * e + 1]); b[e] = pkbf(v[8 + 2 * e], v[8 + 2 * e + 1]); }
    *(u32x4_t*)p = a; *(u32x4_t*)(p + 8) = b;
}
__device__ __forceinline__ void prep_token(const Params& P, int m, int lane) {
    bf16raw* row = (bf16raw*)(P.ws + WS_PROJ) + (size_t)m * PP;
    const int pos = ((const int*)P.in[1])[m];
    float cs = 1.f, sn = 0.f;
    if (lane < 24) { const float ang = (float)pos * ROPE_INVF[lane]; double rev = (double)ang * 0.15915494309189535; rev -= rint(rev); const float fr = (float)rev;
        sn = __builtin_amdgcn_sinf(fr); cs = __builtin_amdgcn_cosf(fr); }
    float cA[16], sA[16];
#pragma unroll
    for (int i = 0; i < 16; ++i) { cA[i] = __shfl(cs, i); sA[i] = __shfl(sn, i); }
    const int sub = lane & 7;
#pragma unroll
    for (int which = 0; which < 2; ++which) {
        bf16raw* p = row + (which ? C_K : C_Q) + lane * 16; const float* g = (which ? P.in[9] : P.in[8]) + sub * 16;
        float v[16]; ld16(p, v); float ss = 0.f;
#pragma unroll
        for (int i = 0; i < 16; ++i) ss += v[i] * v[i];
        ss += __shfl_xor(ss, 1); ss += __shfl_xor(ss, 2); ss += __shfl_xor(ss, 4);
        const float r = 1.0f / sqrtf(ss * (1.0f / 128.0f) + EPS);
#pragma unroll
        for (int i = 0; i < 16; ++i) v[i] = v[i] * r * g[i];
#pragma unroll
        for (int i = 0; i < 16; ++i) { const float o = __shfl_xor(v[i], 1); if (sub == 0) v[i] = v[i] * cA[i] - o * sA[i]; else if (sub == 1) v[i] = v[i] * cA[i] + o * sA[i]; }
        st16(p, v);
    }
    { bf16raw* p = row + C_QI + lane * 16; float v[16]; ld16(p, v);
      float cI[8], sI[8];
#pragma unroll
      for (int i = 0; i < 8; ++i) { cI[i] = __shfl(cs, 16 + i); sI[i] = __shfl(sn, 16 + i); }
      if ((lane & 3) == 0) {
#pragma unroll
          for (int i = 0; i < 8; ++i) { const float x1 = v[i], x2 = v[8 + i]; v[i] = x1 * cI[i] - x2 * sI[i]; v[8 + i] = x2 * cI[i] + x1 * sI[i]; }
      }
      st16(p, v);
      float y = bf2f(row[C_KI + lane]); const float ss = wave_sum(y * y);
      y = y * (1.0f / sqrtf(ss * (1.0f / 64.0f) + EPS)) * P.in[10][lane];
      const float o = __shfl_xor(y, 8), cc = __shfl(cs, 16 + (lane & 7)), s2 = __shfl(sn, 16 + (lane & 7));
      if (lane < 8) y = y * cc - o * s2; else if (lane < 16) y = y * cc + o * s2;
      ((bf16raw*)(P.ws + WS_KI))[(size_t)m * 64 + lane] = (bf16raw)(pkbf(y, 0.f) & 0xffffu);
      if (lane < 16) ((float*)(P.ws + WS_WI))[(size_t)m * 16 + lane] = bf2f(row[C_WI + lane]);
    }
    { bf16raw* p = row + C_U + lane * 16; float v[16]; ld16(p, v);
#pragma unroll
      for (int i = 0; i < 16; ++i) v[i] = gelu_tanh_f(v[i]);
      st16(p, v); }
    { bf16raw* p = row + C_VS + lane * 16; float v[16]; ld16(p, v); float ss = 0.f;
#pragma unroll
      for (int i = 0; i < 16; ++i) { v[i] = gelu_tanh_f(v[i]); ss += v[i] * v[i]; }
      const float r = 1.0f / sqrtf(wave_sum(ss) * (1.0f / 1024.0f) + EPS); const float* g = P.in[11] + lane * 16;
#pragma unroll
      for (int i = 0; i < 16; ++i) v[i] = v[i] * r * g[i];
      st16(p, v); }
}

__device__ __forceinline__ void sgu_phase(const Params& P, LAS unsigned char* lds, int tid, int lane, int wave) {
    bf16raw* proj = (bf16raw*)(P.ws + WS_PROJ); const bf16raw* wsb = (const bf16raw*)(P.ws + WS_WSB); const float* bs = P.in[13];
    LAS bf16raw* VT = (LAS bf16raw*)lds;
    const int r32 = lane & 31, hi = lane >> 5, tr = wave & 3, ch = wave >> 2;
    for (int item = blockIdx.x; item < 2048; item += gridDim.x) {
        const int g = item & 7, tok0 = (item >> 3) * 128;
#pragma unroll
        for (int i = 0; i < 4; ++i) { const int id = tid + 512 * i, s = id & 127, cc = (id >> 7) * 8;
            const u32x4_t w = *(const u32x4_t*)(proj + (size_t)(tok0 + s) * PP + C_VS + g * 128 + cc);
#pragma unroll
            for (int e = 0; e < 4; ++e) { VT[(cc + 2 * e) * 136 + s] = (bf16raw)(w[e] & 0xffffu); VT[(cc + 2 * e + 1) * 136 + s] = (bf16raw)(w[e] >> 16); } }
        __syncthreads();
        f32x16_t acc[2]; acc[0] = f32x16_t{}; acc[1] = f32x16_t{};
#pragma unroll
        for (int ks = 0; ks < 8; ++ks) {
            const bf16x8_t a = *(const bf16x8_t*)(wsb + (size_t)g * 16384 + (32 * tr + r32) * 128 + 16 * ks + 8 * hi);
#pragma unroll
            for (int nt = 0; nt < 2; ++nt) { const bf16x8_t b = *(const LAS bf16x8_t*)(VT + (64 * ch + 32 * nt + r32) * 136 + 16 * ks + 8 * hi);
                acc[nt] = __builtin_amdgcn_mfma_f32_32x32x16_bf16(a, b, acc[nt], 0, 0, 0); }
        }
#pragma unroll
        for (int nt = 0; nt < 2; ++nt)
#pragma unroll
            for (int r = 0; r < 16; ++r) { const int t = 32 * tr + (r & 3) + 8 * (r >> 2) + 4 * hi; bf16raw* up = proj + (size_t)(tok0 + t) * PP + C_U + g * 128 + 64 * ch + 32 * nt + r32;
                const float y = bf2f(*up) * (acc[nt][r] + bs[g * 128 + t]); *up = (bf16raw)(pkbf(y, 0.f) & 0xffffu); }
        __syncthreads();
    }
}

__device__ __forceinline__ bool radix_pick(const LAS unsigned* h, int k, int lane, int& d, int& kn, int& cnt) {
    const u32x4_t c = *(const LAS u32x4_t*)(h + 4 * lane);
    const unsigned t = c.x + c.y + c.z + c.w;
    int pv = (int)t;
    pv += __builtin_amdgcn_update_dpp(0, pv, 0x111, 0xf, 0xf, false);
    pv += __builtin_amdgcn_update_dpp(0, pv, 0x112, 0xf, 0xf, false);
    pv += __builtin_amdgcn_update_dpp(0, pv, 0x114, 0xf, 0xf, false);
    pv += __builtin_amdgcn_update_dpp(0, pv, 0x118, 0xf, 0xf, false);
    pv += __builtin_amdgcn_update_dpp(0, pv, 0x142, 0xa, 0xf, false);
    pv += __builtin_amdgcn_update_dpp(0, pv, 0x143, 0xc, 0xf, false);
    const unsigned total = (unsigned)__builtin_amdgcn_readlane(pv, 63);
    unsigned gt = total - (unsigned)pv; int dsel = -1; unsigned knn = 0u, cc = 0u; const unsigned kr = (unsigned)k;
    { const unsigned ge = gt + c.w; if (gt < kr && kr <= ge) { dsel = 4 * lane + 3; knn = kr - gt; cc = c.w; } gt = ge; }
    { const unsigned ge = gt + c.z; if (gt < kr && kr <= ge) { dsel = 4 * lane + 2; knn = kr - gt; cc = c.z; } gt = ge; }
    { const unsigned ge = gt + c.y; if (gt < kr && kr <= ge) { dsel = 4 * lane + 1; knn = kr - gt; cc = c.y; } gt = ge; }
    { const unsigned ge = gt + c.x; if (gt < kr && kr <= ge) { dsel = 4 * lane + 0; knn = kr - gt; cc = c.x; } gt = ge; }
    const unsigned long long bal = __ballot(dsel >= 0);
    if (bal == 0ull) return false;
    const int src = __builtin_amdgcn_readfirstlane(__ffsll((long long)bal) - 1);
    d = __builtin_amdgcn_readlane(dsel, src); kn = __builtin_amdgcn_readlane((int)knn, src); cnt = __builtin_amdgcn_readlane((int)cc, src);
    return true;
}
constexpr int IDX_LCAP = 2048;
template <int NJ> __device__ __forceinline__ void idx_select(const unsigned* __restrict__ sc, int nj, int wend, unsigned long long* mrow, LAS unsigned* hist, LAS unsigned* list, int lane) {
    unsigned u[NJ];
#pragma unroll
    for (int j = 0; j < NJ; ++j) u[j] = sc[j * 64 + lane];
#pragma unroll
    for (int j = 0; j < NJ; ++j) u[j] = (j < nj) ? u[j] : 0u;
    unsigned prefix = 0u; int krem = 256, d = 0, kn = 0, cnt = 0;
    hist[lane] = 0u; hist[lane + 64] = 0u; hist[lane + 128] = 0u; hist[lane + 192] = 0u;
    LDS_WAIT();
    { int njp = nj; asm volatile("" : "+s"(njp));
#pragma unroll
      for (int j = 0; j < NJ; ++j) { if (j < njp) __hip_atomic_fetch_add(hist + (u[j] >> 24), 1u, __ATOMIC_RELAXED, __HIP_MEMORY_SCOPE_WORKGROUP); } }
    LDS_WAIT();
    if (!radix_pick(hist, krem, lane, d, kn, cnt)) return;
    prefix = (unsigned)d << 24; krem = kn;
    if (cnt <= IDX_LCAP) {
        int base = 0;
        { int njp = nj; asm volatile("" : "+s"(njp));
#pragma unroll
          for (int j = 0; j < NJ; ++j) { if (j < njp) { const bool m = (u[j] >> 24) == (unsigned)d; const unsigned long long bal = __ballot(m);
                if (bal != 0ull) { if (m) list[base + (int)__builtin_amdgcn_mbcnt_hi((unsigned)(bal >> 32), __builtin_amdgcn_mbcnt_lo((unsigned)bal, 0u))] = u[j]; base += __popcll(bal); } } } }
        LDS_WAIT();
#pragma unroll 1
        for (int pass = 1; pass < 4; ++pass) {
            const int shift = 24 - 8 * pass; const unsigned himask = 0xffffffffu << (shift + 8);
            hist[lane] = 0u; hist[lane + 64] = 0u; hist[lane + 128] = 0u; hist[lane + 192] = 0u;
            LDS_WAIT();
            for (int i0 = lane; i0 < base; i0 += 256) {
                unsigned v[4]; bool ok[4];
#pragma unroll
                for (int q4 = 0; q4 < 4; ++q4) { const int i = i0 + 64 * q4; ok[q4] = i < base; v[q4] = list[ok[q4] ? i : 0]; }
#pragma unroll
                for (int q4 = 0; q4 < 4; ++q4) { if (ok[q4] && ((v[q4] ^ prefix) & himask) == 0u) __hip_atomic_fetch_add(hist + ((v[q4] >> shift) & 255u), 1u, __ATOMIC_RELAXED, __HIP_MEMORY_SCOPE_WORKGROUP); }
            }
            LDS_WAIT();
            if (!radix_pick(hist, krem, lane, d, kn, cnt)) break;
            prefix |= (unsigned)d << shift; krem = kn;
        }
    } else {
#pragma unroll 1
        for (int pass = 1; pass < 4; ++pass) {
            const int shift = 24 - 8 * pass; const unsigned himask = 0xffffffffu << (shift + 8);
            int njp = nj; asm volatile("" : "+s"(njp));
            hist[lane] = 0u; hist[lane + 64] = 0u; hist[lane + 128] = 0u; hist[lane + 192] = 0u;
            LDS_WAIT();
#pragma unroll
            for (int j = 0; j < NJ; ++j) { if (j < njp) { if (((u[j] ^ prefix) & himask) == 0u) __hip_atomic_fetch_add(hist + ((u[j] >> shift) & 255u), 1u, __ATOMIC_RELAXED, __HIP_MEMORY_SCOPE_WORKGROUP); } }
            LDS_WAIT();
            if (!radix_pick(hist, krem, lane, d, kn, cnt)) break;
            prefix |= (unsigned)d << shift; krem = kn;
        }
    }
    const unsigned thr = prefix; unsigned wl0 = 0u, wh0 = 0u, wl1 = 0u, wh1 = 0u; int total = 0;
#pragma unroll
    for (int j = 0; j < NJ; ++j) {
        const unsigned long long word = __ballot(u[j] >= thr);
        total += __popcll(word);
        { const unsigned wlo_ = (unsigned)__builtin_amdgcn_readfirstlane((int)(unsigned)word), whi_ = (unsigned)__builtin_amdgcn_readfirstlane((int)(unsigned)(word >> 32));
          if (j < 64) { asm volatile("v_writelane_b32 %0, %1, %2" : "+v"(wl0) : "s"(wlo_), "n"(j & 63)); asm volatile("v_writelane_b32 %0, %1, %2" : "+v"(wh0) : "s"(whi_), "n"(j & 63)); }
          else { asm volatile("v_writelane_b32 %0, %1, %2" : "+v"(wl1) : "s"(wlo_), "n"(j & 63)); asm volatile("v_writelane_b32 %0, %1, %2" : "+v"(wh1) : "s"(whi_), "n"(j & 63)); } }
    }
    if (__builtin_amdgcn_readfirstlane(total) != 256) {
        int taken = 0;
#pragma unroll
        for (int j = 0; j < NJ; ++j) {
            unsigned long long word = __ballot(u[j] > thr);
            unsigned long long e = __ballot(u[j] == thr);
            if (e != 0ull) { const int need = krem - taken;
                if (need > 0) { int n = __popcll(e); unsigned long long sel = e;
                    if (n > need) { sel = 0ull; for (int t2 = 0; t2 < need; ++t2) { const unsigned long long b = e & (~e + 1ull); sel |= b; e ^= b; } n = need; }
                    word |= sel; taken += n; } }
            { const unsigned wlo_ = (unsigned)__builtin_amdgcn_readfirstlane((int)(unsigned)word), whi_ = (unsigned)__builtin_amdgcn_readfirstlane((int)(unsigned)(word >> 32));
              if (j < 64) { asm volatile("v_writelane_b32 %0, %1, %2" : "+v"(wl0) : "s"(wlo_), "n"(j & 63)); asm volatile("v_writelane_b32 %0, %1, %2" : "+v"(wh0) : "s"(whi_), "n"(j & 63)); }
              else { asm volatile("v_writelane_b32 %0, %1, %2" : "+v"(wl1) : "s"(wlo_), "n"(j & 63)); asm volatile("v_writelane_b32 %0, %1, %2" : "+v"(wh1) : "s"(whi_), "n"(j & 63)); } }
        }
    }
    if (lane < wend) mrow[lane] = ((unsigned long long)wh0 << 32) | wl0;
    if (NJ > 64) { if (lane + 64 < wend) mrow[lane + 64] = ((unsigned long long)wh1 << 32) | wl1; }
}

__device__ __forceinline__ float relu_i(float x) { const int b = __float_as_int(x); return __int_as_float(b > 0 ? b : 0); }
__device__ __forceinline__ f32x16_t idx_chain(const bf16x8_t (&Af)[4], const bf16x8_t (&B4)[4]) {
    f32x16_t acc = f32x16_t{};
#pragma unroll
    for (int s = 0; s < 4; ++s) acc = __builtin_amdgcn_mfma_f32_32x32x16_bf16(Af[s], B4[s], acc, 0, 0, 0);
    return acc;
}
__device__ __forceinline__ unsigned idx_score_key(const f32x16_t& acc, const f32x4_t (&wv)[4]) {
    float sc0 = 0.f, sc1 = 0.f;
#pragma unroll
    for (int i = 0; i < 16; i += 2) { sc0 += relu_i(acc[i]) * wv[i >> 2][i & 3]; sc1 += relu_i(acc[i + 1]) * wv[(i + 1) >> 2][(i + 1) & 3]; }
    const unsigned bts = __float_as_uint(sc0 + sc1);
    return bts ^ ((unsigned)((int)bts >> 31) | 0x80000000u);
}
template <bool FULL> __device__ __forceinline__ void idx_rt_block(const bf16x8_t (&Bf)[8][4], const bf16x8_t (&Af)[4], const f32x4_t (&wv)[4], unsigned* srow, int tile0, int ntile) {
    if (FULL) {
        f32x16_t accA = idx_chain(Af, Bf[0]), accB;
#pragma unroll
        for (int kt = 0; kt < 8; ++kt) {
            if (kt + 1 < 8) accB = idx_chain(Af, Bf[kt + 1]);
            srow[(tile0 + kt * 8) * 32] = idx_score_key(accA, wv);
            if (kt + 1 < 8) {
#pragma unroll
                for (int s = 0; s < 4; ++s) { __builtin_amdgcn_sched_group_barrier(0x008, 1, 0); __builtin_amdgcn_sched_group_barrier(0x002, 10, 0); }
            }
            accA = accB;
        }
    } else {
#pragma unroll
        for (int kt = 0; kt < 8; ++kt) { const int tile = tile0 + kt * 8;
            if (tile < ntile) { const f32x16_t acc = idx_chain(Af, Bf[kt]); srow[tile * 32] = idx_score_key(acc, wv); } }
    }
}
__device__ __forceinline__ void indexer_phase(const Params& P, LAS unsigned char* lds, int tid, int lane, int wave) {
    unsigned char* ws = P.ws;
    const bf16raw* proj = (const bf16raw*)(ws + WS_PROJ); const bf16raw* KI = (const bf16raw*)(ws + WS_KI); const float* WIf = (const float*)(ws + WS_WI);
    unsigned long long* MASK = (unsigned long long*)(ws + WS_MASK); unsigned* ctl = (unsigned*)(ws + WS_CTL);
    float* scratch = P.out + (size_t)blockIdx.x * (16 * 8192);
    LAS unsigned* list = (LAS unsigned*)(lds + 45056) + wave * IDX_LCAP;
    LAS float* WL = (LAS float*)(lds + 32768); LAS unsigned* hist = (LAS unsigned*)(lds + 33792) + wave * 256; volatile LAS int* itemw = (volatile LAS int*)(lds + 41984);
    const int r32 = lane & 31, hi = lane >> 5;
    if (blockIdx.x >= 256) return;
    for (;;) {
        if (tid == 0) *itemw = (int)atomicAdd(ctl + CW_IDXQ, 1u);
        __syncthreads();
        const int it = *itemw;
        __syncthreads();
        if (it >= 2048) break;
        const int qt = 511 - (it >> 2), b = it & 3, q0 = qt * 16, n_adm = ((q0 >> 6) + 1) * 64, wend = ((q0 >> 8) + 1) * 4, tok0 = b * SEQ + q0;
        if (n_adm <= 256) {
            if (tid < 64) { const int q = tid >> 2, j = tid & 3; MASK[(size_t)(tok0 + q) * 128 + j] = (j < (n_adm >> 6)) ? ~0ull : 0ull; }
            continue;
        }
        for (int c = tid; c < 2048; c += NTHR) { const int l = c & 63, s = (c >> 6) & 3, rt = c >> 8, rho = l & 31, hf = l >> 5, par = (rho >> 2) & 1, head = (rho & 3) + 4 * (rho >> 3);
            *(LAS u32x4_t*)(lds + c * 16) = *(const u32x4_t*)(proj + (size_t)(tok0 + 2 * rt + par) * PP + C_QI + head * 64 + 16 * s + 8 * hf); }
        if (tid < 256) WL[tid] = WIf[(size_t)tok0 * 16 + tid];
        __syncthreads();
        const int ntile = n_adm >> 5, npass = (ntile + 63) >> 6;
        for (int p = 0; p < npass; ++p) {
            bf16x8_t Bf[8][4];
#pragma unroll
            for (int kt = 0; kt < 8; ++kt) { const int tile = p * 64 + kt * 8 + wave;
                const int tcl = tile < ntile ? tile : ntile - 1;
                const bf16raw* kp = KI + (size_t)(b * SEQ + tcl * 32 + r32) * 64 + 8 * hi;
#pragma unroll
                for (int s = 0; s < 4; ++s) Bf[kt][s] = *(const bf16x8_t*)(kp + 16 * s); }
            const int tile0 = p * 64 + wave; const bool full = tile0 + 56 < ntile;
#pragma unroll 1
            for (int rt = 0; rt < 8; ++rt) {
                bf16x8_t Af[4];
#pragma unroll
                for (int s = 0; s < 4; ++s) Af[s] = *(const LAS bf16x8_t*)(lds + ((rt * 4 + s) * 64 + lane) * 16);
                f32x4_t wv[4];
#pragma unroll
                for (int e = 0; e < 4; ++e) wv[e] = *(const LAS f32x4_t*)(WL + (2 * rt + hi) * 16 + 4 * e);
                unsigned* srow = (unsigned*)scratch + (2 * rt + hi) * 8192 + r32;
                if (full) idx_rt_block<true>(Bf, Af, wv, srow, tile0, ntile); else idx_rt_block<false>(Bf, Af, wv, srow, tile0, ntile);
            }
        }
        __syncthreads();
        const int nj = n_adm >> 6;
#pragma unroll 1
        for (int qq = 2 * wave; qq < 2 * wave + 2; ++qq) {
            const unsigned* sc = (const unsigned*)scratch + qq * 8192; unsigned long long* mrow = MASK + (size_t)(tok0 + qq) * 128;
            int njq = nj; asm volatile("" : "+s"(njq));
            if (njq <= 16) idx_select<16>(sc, njq, wend, mrow, hist, list, lane);
            else if (njq <= 32) idx_select<32>(sc, njq, wend, mrow, hist, list, lane);
            else if (njq <= 64) idx_select<64>(sc, njq, wend, mrow, hist, list, lane);
            else idx_select<128>(sc, njq, wend, mrow, hist, list, lane);
        }
        __syncthreads();
    }
}

__device__ __forceinline__ attn::BlockRef<attn::bf16, attn::bf16> att_ref(unsigned char* ws, int bi) {
    const int G_ = (int)gridDim.x, bx_ = (int)blockIdx.x, vg = (G_ % 8 == 0) ? (bx_ & 7) * (G_ >> 3) + (bx_ >> 3) : bx_;
    const int item = vg + (bi >> 1) * G_, bh = item >> 4, pr = item & 15, qb = (bi & 1) ? 31 - pr : pr, b = bh >> 3, h = bh & 7;
    attn::bf16* proj = (attn::bf16*)(ws + WS_PROJ); const size_t tokb = (size_t)b * SEQ;
    attn::BlockRef<attn::bf16, attn::bf16> r;
    r.Q = proj + (tokb + qb * 256) * PP + C_Q + h * 128; r.K = proj + tokb * PP + C_K + h * 128; r.V = proj + tokb * PP + C_V + h * 128;
    r.O = proj + (tokb + qb * 256) * PP + C_Q + h * 128; r.MK = (const unsigned long long*)(ws + WS_MASK) + (tokb + qb * 256) * 128; r.P0 = qb * 256;
    return r;
}
__device__ __forceinline__ void attn_phase(unsigned char* ws, char* lds) {
    const int nitems = (int)blockIdx.x < 512 ? (512 - (int)blockIdx.x + (int)gridDim.x - 1) / (int)gridDim.x : 0, nb = 2 * nitems;
    if (nb == 0) return;
    attn::Seam<attn::bf16> S;
    { const auto r0 = att_ref(ws, 0); attn::causal_swa_prime<attn::bf16, attn::bf16>(r0, SEQ, lds, S); }
    for (int bi = 0; bi < nb; ++bi) {
        const auto cur = att_ref(ws, bi); const auto nxt = att_ref(ws, bi + 1 < nb ? bi + 1 : bi);
        attn::causal_swa_block<attn::bf16, attn::bf16>(cur, nxt, SEQ, SEQ, lds, S);
    }
}

#define XB_TMO      128
#define XB_XCNT(j)  (256  + 64 * (j))
#define XB_XSUB(j)  (1280 + 64 * (j))
#define XB_XGEN(j)  (2304 + 64 * (j))
#define XB_TOP      3328
#define XB_TOPGEN   3392
#define XB_SPIN_CAP (1u << 18)

__device__ __forceinline__ unsigned xb_ld(unsigned* p)              { return __hip_atomic_load(p, __ATOMIC_RELAXED, __HIP_MEMORY_SCOPE_AGENT); }
__device__ __forceinline__ unsigned xb_add(unsigned* p, unsigned v) { return __hip_atomic_fetch_add(p, v, __ATOMIC_RELAXED, __HIP_MEMORY_SCOPE_AGENT); }
__device__ __forceinline__ unsigned xb_xcc_id() { return (unsigned)__builtin_amdgcn_s_getreg((3 << 11) | 20) & 0xFu; }
#define XB_SPIN(cond, bar) do { unsigned _sp = 0; while (cond) { __builtin_amdgcn_s_sleep(1); \
    if ((++_sp & 255u) == 0u) { if (xb_ld(&(bar)[XB_TMO])) break; if (_sp > XB_SPIN_CAP) { atomicAdd(&(bar)[XB_TMO], 1u); break; } } } } while (0)

struct XcdBarrier {
    unsigned* bar; unsigned x;
    volatile LAS unsigned* st;
};

__device__ __forceinline__ XcdBarrier xcd_barrier_post(unsigned* bar, volatile LAS unsigned* st) {
    XcdBarrier b; b.bar = bar; b.x = xb_xcc_id(); b.st = st;
    if (threadIdx.x == 0) (void)xb_add(&bar[XB_XCNT(b.x)], 1u);
    return b;
}
__device__ __forceinline__ void xcd_barrier_complete(unsigned* bar, unsigned x, unsigned& nloc, unsigned& nx) {
    const unsigned G = gridDim.x * gridDim.y * gridDim.z;
    unsigned sum, cnt, mine, sp = 0u;
    for (;;) {
        sum = 0u; cnt = 0u; mine = 0u;
#pragma unroll
        for (unsigned j = 0; j < 16; ++j) { const unsigned c = xb_ld(&bar[XB_XCNT(j)]); sum += c; cnt += (c > 0u) ? 1u : 0u; mine = (j == x) ? c : mine; }
        if (sum == G) break;
        __builtin_amdgcn_s_sleep(1);
        if ((++sp & 255u) == 0u) { if (xb_ld(&bar[XB_TMO])) break; if (sp > XB_SPIN_CAP) { atomicAdd(&bar[XB_TMO], 1u); break; } }
    }
    nloc = mine > 0u ? mine : 1u; nx = cnt > 0u ? cnt : 1u;
}

__device__ __forceinline__ void xcd_barrier(const XcdBarrier& b) {
    asm volatile("s_waitcnt vmcnt(0)" ::: "memory");
    __syncthreads();
    if (threadIdx.x == 0) {
        unsigned* bar = b.bar;
        __builtin_amdgcn_s_waitcnt(0);
        unsigned nloc = b.st[0], nx = b.st[1];
        if (nloc == 0u) { xcd_barrier_complete(bar, b.x, nloc, nx); b.st[0] = nloc; b.st[1] = nx; }
        const unsigned old = xb_add(&bar[XB_XSUB(b.x)], 1u);
        const unsigned gen = old / nloc;
        if (old + 1u == (gen + 1u) * nloc) {
            __builtin_amdgcn_fence(__ATOMIC_RELEASE, "agent");
            asm volatile("s_waitcnt vmcnt(0)" ::: "memory");
            const unsigned og = xb_add(&bar[XB_TOP], 1u);
            const unsigned tg = og / nx;
            if (og + 1u == (tg + 1u) * nx) xb_add(&bar[XB_TOPGEN], 1u);
            else XB_SPIN(xb_ld(&bar[XB_TOPGEN]) == tg, bar);
            __builtin_amdgcn_fence(__ATOMIC_ACQUIRE, "agent");
            xb_add(&bar[XB_XGEN(b.x)], 1u);
            asm volatile("s_waitcnt vmcnt(0)" ::: "memory");
        } else {
            XB_SPIN(xb_ld(&bar[XB_XGEN(b.x)]) == gen, bar);
            __builtin_amdgcn_fence(__ATOMIC_ACQUIRE, "agent");
            asm volatile("s_waitcnt vmcnt(0)" ::: "memory");
        }
    }
    __syncthreads();
}

__global__ void __launch_bounds__(NTHR, 2) fwd_kernel(Params P) {
    extern __shared__ __attribute__((aligned(16))) unsigned char lds_raw[];
    cg::grid_group grid = cg::this_grid();
    LAS unsigned char* lds = (LAS unsigned char*)lds_raw;
    const int tid = threadIdx.x, lane = tid & 63, wave = __builtin_amdgcn_readfirstlane(tid >> 6);
    const int gw = blockIdx.x * NWAVES + wave, ngw = gridDim.x * NWAVES;
    unsigned char* ws = P.ws;
    bf16raw* XN = (bf16raw*)(ws + WS_XN); bf16raw* PROJ = (bf16raw*)(ws + WS_PROJ); bf16raw* HB = PROJ;
    float* out = P.out; float* SS1 = (float*)(ws + WS_SS1); float* SS2 = SS1 + MTOK;

    volatile LAS unsigned* bst = (volatile LAS unsigned*)(lds + LDS_BYTES - 64);
    if (tid == 0) { bst[0] = 0u; bst[1] = 0u; }
    __syncthreads();
    p0_prologue(P, lds, tid, lane, wave);
    grid.sync();
    const XcdBarrier xbar = xcd_barrier_post((unsigned*)(ws + WS_CTL) + CW_BAR, bst);
#define GSYNC() xcd_barrier(xbar)
    { pg8::EpiSwiglu E{HB, DFF, nullptr}; run_gemm(lds, XN, DM, (const bf16raw*)(ws + WS_WGU1), DM, 2 * DFF, DM, E); }
    GSYNC();
    { pg8::EpiResid<false, false, true> E{P.in[0], nullptr, DM, 0.5f, XN, SS1}; run_gemm(lds, HB, DFF, (const bf16raw*)(ws + WS_WD1), DFF, DM, DFF, E); }
    GSYNC();
    { pg8::EpiStore E{PROJ, PP, SS1}; run_gemm(lds, XN, DM, (const bf16raw*)(ws + WS_WIN), DM, PP, DM, E); }
    GSYNC();
    for (int m = gw; m < MTOK; m += ngw) prep_token(P, m, lane);
    GSYNC();
    sgu_phase(P, lds, tid, lane, wave);
    indexer_phase(P, lds, tid, lane, wave);
    GSYNC();
    attn_phase(ws, (char*)lds_raw);
    GSYNC();
    { pg8::EpiGate<1> E{PROJ + C_GA, PROJ + C_GA, PP}; run_gemm(lds, PROJ + C_Q, PP, (const bf16raw*)(ws + WS_WUA), 1024, DM, 1024, E); }
    { pg8::EpiGate<2> E{PROJ + C_GB, PROJ + C_GA, PP}; run_gemm(lds, PROJ + C_U, PP, (const bf16raw*)(ws + WS_WUS), 1024, DM, 1024, E); }
    GSYNC();
    { pg8::EpiResid<true, false, true> E{XN, nullptr, DM, 1.0f, XN, SS2}; run_gemm(lds, PROJ + C_GA, PP, (const bf16raw*)(ws + WS_WOUT), DM, DM, DM, E); }
    GSYNC();
    { pg8::EpiSwiglu E{HB, DFF, SS2}; run_gemm(lds, XN, DM, (const bf16raw*)(ws + WS_WGU2), DM, 2 * DFF, DM, E); }
    GSYNC();
    { pg8::EpiResid<true, true, false> E{XN, out, DM, 0.5f, nullptr, nullptr}; run_gemm(lds, HB, DFF, (const bf16raw*)(ws + WS_WD2), DFF, DM, DFF, E); }
}

extern "C" void kernel_launch(void* const* d_in, const int* in_sizes, int n_in, void* d_out, int out_size, void* d_ws, size_t ws_size, hipStream_t stream) {
    static int grid = 0;
    if (grid == 0) {
        if (n_in != 21 || ws_size < WS_END) { fprintf(stderr, "kernel_launch: unexpected n_in %d / ws %zu\n", n_in, ws_size); grid = -1; return; }
        int dev = 0, cus = 0, per_cu = 0;
        (void)hipGetDevice(&dev); (void)hipDeviceGetAttribute(&cus, hipDeviceAttributeMultiprocessorCount, dev);
        if (hipFuncSetAttribute((const void*)fwd_kernel, hipFuncAttributeMaxDynamicSharedMemorySize, LDS_BYTES) != hipSuccess) fprintf(stderr, "kernel_launch: hipFuncSetAttribute failed\n");
        if (hipOccupancyMaxActiveBlocksPerMultiprocessor(&per_cu, (const void*)fwd_kernel, NTHR, LDS_BYTES) != hipSuccess || per_cu < 1) fprintf(stderr, "kernel_launch: occupancy query says %d\n", per_cu);
        (void)hipGetLastError();
        grid = cus > 256 ? 256 : cus; if (grid < 1) grid = 256;
    }
    if (grid < 0) return;
    Params p{};
    for (int i = 0; i < 21; ++i) p.in[i] = (const float*)d_in[i];
    p.out = (float*)d_out; p.ws = (unsigned char*)d_ws;
    void* args[] = {&p};
    const hipError_t e = hipLaunchCooperativeKernel((const void*)fwd_kernel, dim3(grid), dim3(NTHR), args, LDS_BYTES, stream);
    if (e != hipSuccess) fprintf(stderr, "cooperative launch failed: %s (grid %d)\n", hipGetErrorString(e), grid);
}
```

```cpp
#include <hip/hip_runtime.h>
#include <hip/hip_cooperative_groups.h>
#include <hip/hip_bf16.h>
#include <cstdio>
#include <cstdint>
#include <cmath>
namespace cg = cooperative_groups;

constexpr int BATCH = 4, SEQ = 8192, DM = 2048, MTOK = BATCH * SEQ, DFF = 5632;
constexpr int PP = 10496;
constexpr int C_Q = 0, C_K = 1024, C_V = 2048, C_QI = 3072, C_KI = 4096, C_WI = 4160, C_U = 4352, C_VS = 5376, C_GA = 6400, C_GB = 8448;
constexpr float EPS = 1e-6f;
constexpr int NWAVES = 8, NTHR = 512;
constexpr size_t MiB = 1u << 20;
constexpr size_t WS_CTL = 0, WS_SS1 = 256 * 1024  , WS_WSB = 1 * MiB, WS_KI = 2 * MiB, WS_WI = 6 * MiB, WS_WGU1 = 8 * MiB, WS_WD1 = 52 * MiB, WS_WGU2 = 74 * MiB, WS_WD2 = 118 * MiB,
                 WS_WIN = 140 * MiB, WS_WUA = 181 * MiB, WS_WUS = 185 * MiB, WS_WOUT = 189 * MiB, WS_MASK = 197 * MiB, WS_XN = 229 * MiB, WS_PROJ = 357 * MiB, WS_END = 1013 * MiB;
static_assert(WS_PROJ + (size_t)MTOK * PP * 2 <= WS_END && WS_XN + (size_t)MTOK * DM * 2 <= WS_PROJ && WS_MASK + (size_t)MTOK * 128 * 8 <= WS_XN, "ws map");
constexpr int LDS_BYTES = 147456;

typedef unsigned short bf16raw;
typedef unsigned u32x4_t __attribute__((ext_vector_type(4)));
typedef unsigned u32x2_t __attribute__((ext_vector_type(2)));
typedef float f32x4_t __attribute__((ext_vector_type(4)));
typedef float f32x16_t __attribute__((ext_vector_type(16)));
typedef short bf16x8_t __attribute__((ext_vector_type(8)));
#define LAS __attribute__((address_space(3)))

__device__ __forceinline__ float bf2f(unsigned short b) { return __uint_as_float((unsigned)b << 16); }
__device__ __forceinline__ float bflo(unsigned w) { return __uint_as_float(w << 16); }
__device__ __forceinline__ float bfhi(unsigned w) { return __uint_as_float(w & 0xffff0000u); }
__device__ __forceinline__ unsigned pkbf(float lo, float hi) { unsigned r; asm volatile("v_cvt_pk_bf16_f32 %0, %1, %2" : "=v"(r) : "v"(lo), "v"(hi)); return r; }
__device__ __forceinline__ float fast_sigmoid(float x) { return __builtin_amdgcn_rcpf(1.0f + __builtin_amdgcn_exp2f(-1.4426950408889634f * x)); }
__device__ __forceinline__ float silu_f(float x) { return x * fast_sigmoid(x); }
__device__ __forceinline__ float gelu_tanh_f(float x) { const float z2 = 1.5957691216057308f * (x + 0.044715f * x * x * x); return x * fast_sigmoid(z2); }
__device__ __forceinline__ float wave_sum(float v) {
#pragma unroll
    for (int o = 1; o < 64; o <<= 1) v += __shfl_xor(v, o);
    return v;
}
namespace pg8 {
#define PG8_LAS __attribute__((address_space(3)))
typedef unsigned short bf16_t;
typedef short bf16x8 __attribute__((ext_vector_type(8)));
typedef float f32x4 __attribute__((ext_vector_type(4)));
typedef unsigned u32x4 __attribute__((ext_vector_type(4)));
constexpr int BM = 256, BK = 64, HALF = 128, HTB = HALF * BK * 2  , STAGE_BYTES = 8 * HTB, NXCD = 8, WGM = 8;

__host__ __device__ __forceinline__ int lds_byte(int r, int c) { const int st = (r >> 4) * 2 + (c >> 5), rr = r & 15, cc = c & 31, ob = rr * 64 + cc * 2; return st * 1024 + (ob ^ (((ob >> 9) & 1) << 5)); }
__host__ __device__ __forceinline__ void stage_rc(int b, int& R, int& C) { const int st = b / 1024, sb = b % 1024, swz = sb ^ (((sb >> 9) & 1) << 5); R = (st >> 1) * 16 + swz / 64; C = (st & 1) * 32 + (swz % 64) / 2; }
__host__ __device__ __forceinline__ int perm32(int rho) { const int n = rho >> 4, i = rho & 15; return 8 * (i >> 2) + 4 * n + (i & 3); }

struct Unit { int pm, pn; };
struct Gemm { const bf16_t* A; const bf16_t* Bt; int M, N, K, lda, ldb; };

struct StaticOrder {
    int nM, nN, nwg, G, c, wgm;
    __host__ __device__ void init(int M, int N, int G_, int c_) { nM = M / BM; nN = N / BM; nwg = nM * nN; G = G_; c = c_; wgm = nN <= 8 ? 4 : WGM; }
    __host__ __device__ bool next(int i, Unit& u) const {
        const long L = (long)i * G + c; if (L >= nwg) return false;
        int wgid = (int)L; { const int q = nwg / NXCD, r = nwg % NXCD, xcd = wgid % NXCD, off = wgid / NXCD; wgid = (xcd < r ? xcd * (q + 1) : r * (q + 1) + (xcd - r) * q) + off; }
        const int nig = wgm * nN, gid = wgid / nig, fm = gid * wgm, gsz = (nM - fm) < wgm ? (nM - fm) : wgm;
        u.pm = fm + ((wgid % nig) % gsz); u.pn = (wgid % nig) / gsz; return true;
    }
    __device__ __forceinline__ void a_ready(const Unit&) const {}
    __device__ __forceinline__ void done(const Unit&) const {}
};

__device__ __forceinline__ unsigned cvt_pk_bf16(float lo, float hi) { unsigned r; asm volatile("v_cvt_pk_bf16_f32 %0, %1, %2" : "=v"(r) : "v"(lo), "v"(hi)); return r; }
typedef float f32x2 __attribute__((ext_vector_type(2)));

__device__ __forceinline__ float sigm(float x) { return __builtin_amdgcn_rcpf(1.0f + __builtin_amdgcn_exp2f(-1.4426950408889634f * x)); }
struct EpiStore {
    static constexpr bool PERM = true, AFTER_DRAIN = false;
    bf16_t* O; int ldc; const float* ss;
    __device__ __forceinline__ void operator()(const f32x4 (&acc)[2][2][4][2], const Unit& u, int wr, int wc, int fr, int fq) const {
        const int row0 = u.pm * BM + wr * 64 + fr, col0 = u.pn * BM + wc * 32 + 8 * fq;
#pragma unroll
        for (int ai = 0; ai < 2; ++ai)
#pragma unroll
            for (int m = 0; m < 4; ++m) { bf16_t* rowp = O + (size_t)(row0 + ai * HALF + m * 16) * ldc + col0;
                const float rs = ss ? __builtin_amdgcn_rsqf(ss[row0 + ai * HALF + m * 16] * (1.0f / 2048.0f) + 1e-6f) : 1.0f;
#pragma unroll
                for (int bj = 0; bj < 2; ++bj) { const f32x4 v0 = acc[ai][bj][m][0] * rs, v1 = acc[ai][bj][m][1] * rs;
                    u32x4 w; w.x = cvt_pk_bf16(v0[0], v0[1]); w.y = cvt_pk_bf16(v0[2], v0[3]); w.z = cvt_pk_bf16(v1[0], v1[1]); w.w = cvt_pk_bf16(v1[2], v1[3]);
                    *(u32x4*)(rowp + bj * HALF) = w; } }
    }
};
struct EpiSwiglu {
    static constexpr bool PERM = true, AFTER_DRAIN = false;
    bf16_t* H; int ldc; const float* ss;
    __device__ __forceinline__ void operator()(const f32x4 (&acc)[2][2][4][2], const Unit& u, int wr, int wc, int fr, int fq) const {
        const int row0 = u.pm * BM + wr * 64 + fr, col0 = u.pn * HALF + wc * 32 + 8 * fq;
#pragma unroll
        for (int ai = 0; ai < 2; ++ai)
#pragma unroll
            for (int m = 0; m < 4; ++m) { bf16_t* rowp = H + (size_t)(row0 + ai * HALF + m * 16) * ldc + col0;
                const float rs = ss ? __builtin_amdgcn_rsqf(ss[row0 + ai * HALF + m * 16] * (1.0f / 2048.0f) + 1e-6f) : 1.0f;
                float h[8];
#pragma unroll
                for (int n = 0; n < 2; ++n)
#pragma unroll
                    for (int j = 0; j < 4; ++j) { const float g = acc[ai][0][m][n][j] * rs, up = acc[ai][1][m][n][j] * rs; h[n * 4 + j] = g * sigm(g) * up; }
                u32x4 w; w.x = cvt_pk_bf16(h[0], h[1]); w.y = cvt_pk_bf16(h[2], h[3]); w.z = cvt_pk_bf16(h[4], h[5]); w.w = cvt_pk_bf16(h[6], h[7]);
                *(u32x4*)rowp = w; }
    }
};
template <bool BASEBF, bool OUTF32, bool OUTBF> struct EpiResid {
    static constexpr bool PERM = true, AFTER_DRAIN = false;
    const void* base; float* out; int ldc; float alpha; bf16_t* xb; float* ss;
    __device__ __forceinline__ void operator()(const f32x4 (&acc)[2][2][4][2], const Unit& u, int wr, int wc, int fr, int fq) const {
        const int row0 = u.pm * BM + wr * 64 + fr, col0 = u.pn * BM + wc * 32 + 8 * fq;
#pragma unroll
        for (int ai = 0; ai < 2; ++ai)
#pragma unroll
            for (int m = 0; m < 4; ++m) { const size_t off = (size_t)(row0 + ai * HALF + m * 16) * ldc + col0; float sq = 0.f;
#pragma unroll
                for (int bj = 0; bj < 2; ++bj) { f32x4 b0, b1;
                    if (BASEBF) { const u32x4 w = *(const u32x4*)((const bf16_t*)base + off + bj * HALF);
                        b0 = (f32x4){__uint_as_float(w.x << 16), __uint_as_float(w.x & 0xffff0000u), __uint_as_float(w.y << 16), __uint_as_float(w.y & 0xffff0000u)};
                        b1 = (f32x4){__uint_as_float(w.z << 16), __uint_as_float(w.z & 0xffff0000u), __uint_as_float(w.w << 16), __uint_as_float(w.w & 0xffff0000u)}; }
                    else { b0 = *(const f32x4*)((const float*)base + off + bj * HALF); b1 = *(const f32x4*)((const float*)base + off + bj * HALF + 4); }
                    const f32x4 o0 = b0 + acc[ai][bj][m][0] * alpha, o1 = b1 + acc[ai][bj][m][1] * alpha;
                    if (OUTF32) { *(f32x4*)(out + off + bj * HALF) = o0; *(f32x4*)(out + off + bj * HALF + 4) = o1; }
                    if (OUTBF) { sq += ((o0[0] * o0[0] + o0[1] * o0[1]) + (o0[2] * o0[2] + o0[3] * o0[3])) + ((o1[0] * o1[0] + o1[1] * o1[1]) + (o1[2] * o1[2] + o1[3] * o1[3]));
                        u32x4 w; w.x = cvt_pk_bf16(o0[0], o0[1]); w.y = cvt_pk_bf16(o0[2], o0[3]); w.z = cvt_pk_bf16(o1[0], o1[1]); w.w = cvt_pk_bf16(o1[2], o1[3]); *(u32x4*)(xb + off + bj * HALF) = w; } }
                if (OUTBF) { sq += __shfl_xor(sq, 16); sq += __shfl_xor(sq, 32); if (fq == 0) atomicAdd(ss + row0 + ai * HALF + m * 16, sq); } }
    }
};
template <int MODE> struct EpiGate {
    static constexpr bool PERM = true, AFTER_DRAIN = false;
    const bf16_t* G; bf16_t* T; int ldc;
    __device__ __forceinline__ void operator()(const f32x4 (&acc)[2][2][4][2], const Unit& u, int wr, int wc, int fr, int fq) const {
        const int row0 = u.pm * BM + wr * 64 + fr, col0 = u.pn * BM + wc * 32 + 8 * fq;
#pragma unroll
        for (int ai = 0; ai < 2; ++ai)
#pragma unroll
            for (int m = 0; m < 4; ++m) { const size_t off = (size_t)(row0 + ai * HALF + m * 16) * ldc + col0;
#pragma unroll
                for (int bj = 0; bj < 2; ++bj) { const u32x4 gw = *(const u32x4*)(G + off + bj * HALF); u32x4 tw = {0u, 0u, 0u, 0u}; if (MODE == 2) tw = *(const u32x4*)(T + off + bj * HALF);
                    float o[8];
#pragma unroll
                    for (int e = 0; e < 4; ++e) { const unsigned g2 = gw[e], t2 = tw[e]; const int n = e >> 1, j = (e & 1) * 2;
                        float a0 = sigm(__uint_as_float(g2 << 16)) * acc[ai][bj][m][n][j], a1 = sigm(__uint_as_float(g2 & 0xffff0000u)) * acc[ai][bj][m][n][j + 1];
                        if (MODE == 2) { a0 += __uint_as_float(t2 << 16); a1 += __uint_as_float(t2 & 0xffff0000u); }
                        o[2 * e] = a0; o[2 * e + 1] = a1; }
                    u32x4 w; w.x = cvt_pk_bf16(o[0], o[1]); w.y = cvt_pk_bf16(o[2], o[3]); w.z = cvt_pk_bf16(o[4], o[5]); w.w = cvt_pk_bf16(o[6], o[7]);
                    *(u32x4*)(T + off + bj * HALF) = w; } }
    }
};
template <class Epi, class Sched, bool ALIGN_EPI = false, bool SP2 = false>
__device__ __forceinline__ void gemm_phase(PG8_LAS unsigned char* lds, const Gemm g, const Sched& S, const Epi& E) {
    int tid_o = threadIdx.x; asm volatile("" : "+v"(tid_o));
    const int tid = tid_o, wid = __builtin_amdgcn_readfirstlane(tid >> 6), lane = tid & 63, wr = wid >> 2, wc = wid & 3, fr = lane & 15, fq = lane >> 4;
    const int K = g.K, nt = K / BK;
    unsigned voffA[2], voffB[2];
#pragma unroll
    for (int i = 0; i < 2; ++i) { int R, C; stage_rc(tid * 16 + i * 8192, R, C); const int Rb = Epi::PERM ? ((R & ~31) + perm32(R & 31)) : R;
        voffA[i] = (unsigned)(R * g.lda + C) * 2u; voffB[i] = (unsigned)(Rb * g.ldb + C) * 2u; }
    const size_t kstep = (size_t)(BK * 2);
    const size_t hstepA = (size_t)HALF * g.lda * 2, hstepB = (size_t)HALF * g.ldb * 2;
    const size_t tstepA = 2 * hstepA, tstepB = 2 * hstepB;
    const unsigned ldsw = (unsigned)wid * 1024u;
    const int aoff = lds_byte(wr * 64 + fr, fq * 8), boff = lds_byte(wc * 32 + fr, fq * 8);
#define PG8_SA(b, h) (((b) * 2 + (h)) * HTB)
#define PG8_SB(b, h) ((4 + (b) * 2 + (h)) * HTB)
#define PG8_STAGE(bufoff, gbase, voff) do { _Pragma("unroll") for (int _i = 0; _i < 2; ++_i) \
        __builtin_amdgcn_global_load_lds((const unsigned*)((const char*)(gbase) + (voff)[_i]), (PG8_LAS unsigned*)(lds + (bufoff) + ldsw + _i * 8192), 16, 0, 0); } while (0)
#define PG8_LDA(dst, b, h) do { _Pragma("unroll") for (int m = 0; m < 4; ++m) _Pragma("unroll") for (int k = 0; k < 2; ++k) dst[m][k] = *(const PG8_LAS bf16x8*)(lds + PG8_SA(b, h) + aoff + m * 2048 + k * 1024); } while (0)
#define PG8_LDB(dst, b, h) do { _Pragma("unroll") for (int n = 0; n < 2; ++n) _Pragma("unroll") for (int k = 0; k < 2; ++k) dst[n][k] = *(const PG8_LAS bf16x8*)(lds + PG8_SB(b, h) + boff + n * 2048 + k * 1024); } while (0)
#define PG8_MMA(ai, bj, At, Bt) do { __builtin_amdgcn_s_setprio(1); _Pragma("unroll") for (int m = 0; m < 4; ++m) _Pragma("unroll") for (int n = 0; n < 2; ++n) _Pragma("unroll") for (int k = 0; k < 2; ++k) \
        acc[ai][bj][m][n] = __builtin_amdgcn_mfma_f32_16x16x32_bf16(Bt[n][k], At[m][k], acc[ai][bj][m][n], 0, 0, 0); __builtin_amdgcn_s_setprio(0); } while (0)
#define PG8_WAIT_V(n) asm volatile("s_waitcnt vmcnt(" #n ")" ::: "memory")
#define PG8_WAIT_L(n) asm volatile("s_waitcnt lgkmcnt(" #n ")" ::: "memory")
#define PG8_BAR __builtin_amdgcn_s_barrier()
#define PG8_SCHED __builtin_amdgcn_sched_barrier(0)
    Unit cur, nxt; int ui = 0;
    if (!S.next(0, cur)) return;
    f32x4 acc[2][2][4][2];
#pragma unroll
    for (int a = 0; a < 2; ++a)
#pragma unroll
        for (int b = 0; b < 2; ++b)
#pragma unroll
            for (int m = 0; m < 4; ++m)
#pragma unroll
                for (int n = 0; n < 2; ++n) acc[a][b][m][n] = (f32x4){0.f, 0.f, 0.f, 0.f};
    bf16x8 At[4][2], B0[2][2], B1[2][2];
    const char* cA = (const char*)g.A + (size_t)cur.pm * tstepA; const char* cB = (const char*)g.Bt + (size_t)cur.pn * tstepB;
    S.a_ready(cur);
    if constexpr (SP2) {
        PG8_STAGE(PG8_SB(0, 0), cB, voffB); PG8_STAGE(PG8_SB(0, 1), cB + hstepB, voffB); PG8_STAGE(PG8_SA(0, 0), cA, voffA); PG8_STAGE(PG8_SA(0, 1), cA + hstepA, voffA);
        if (wr == 1) PG8_BAR;
        PG8_WAIT_V(2); PG8_BAR;
        PG8_STAGE(PG8_SB(1, 0), cB + kstep, voffB); PG8_STAGE(PG8_SA(1, 0), cA + kstep, voffA); PG8_STAGE(PG8_SB(1, 1), cB + hstepB + kstep, voffB);
        PG8_WAIT_V(6); PG8_BAR;
    } else {
        PG8_STAGE(PG8_SB(0, 0), cB, voffB); PG8_STAGE(PG8_SA(0, 0), cA, voffA); PG8_STAGE(PG8_SB(0, 1), cB + hstepB, voffB); PG8_STAGE(PG8_SA(0, 1), cA + hstepA, voffA);
        if (wr == 1) PG8_BAR;
        PG8_WAIT_V(4); PG8_BAR;
        PG8_STAGE(PG8_SB(1, 0), cB + kstep, voffB); PG8_STAGE(PG8_SA(1, 0), cA + kstep, voffA); PG8_STAGE(PG8_SB(1, 1), cB + hstepB + kstep, voffB);
        PG8_WAIT_V(6); PG8_BAR;
    }
    for (;;) {
        const bool has_next = S.next(ui + 1, nxt);
        const char* nA = has_next ? (const char*)g.A + (size_t)nxt.pm * tstepA : cA; const char* nB = has_next ? (const char*)g.Bt + (size_t)nxt.pn * tstepB : cB;
        for (int t = 0; t < nt; t += 2) {
            const bool last = (t == nt - 2);
            const char* a1 = cA + (size_t)(t + 1) * kstep;
            const char* a2 = last ? nA : cA + (size_t)(t + 2) * kstep; const char* b2 = last ? nB : cB + (size_t)(t + 2) * kstep;
            const char* a3 = a2 + kstep; const char* b3 = b2 + kstep;
            if (last && has_next) S.a_ready(nxt);
            if constexpr (SP2) {
            PG8_LDB(B0, 0, 0); PG8_LDB(B1, 0, 1); PG8_SCHED; PG8_LDA(At, 0, 0); PG8_STAGE(PG8_SA(1, 1), a1 + hstepA, voffA);
            PG8_WAIT_V(8); PG8_WAIT_L(0); PG8_BAR; PG8_MMA(0, 0, At, B0); PG8_MMA(0, 1, At, B1); PG8_BAR; PG8_SCHED;
            PG8_LDA(At, 0, 1); PG8_STAGE(PG8_SB(0, 0), b2, voffB); PG8_STAGE(PG8_SB(0, 1), b2 + hstepB, voffB); PG8_STAGE(PG8_SA(0, 0), a2, voffA);
            PG8_WAIT_V(8); PG8_WAIT_L(0); PG8_BAR; PG8_MMA(1, 0, At, B0); PG8_MMA(1, 1, At, B1); PG8_BAR; PG8_SCHED;
            PG8_LDB(B0, 1, 0); PG8_LDB(B1, 1, 1); PG8_SCHED; PG8_LDA(At, 1, 0); PG8_STAGE(PG8_SA(0, 1), a2 + hstepA, voffA);
            PG8_WAIT_V(8); PG8_WAIT_L(0); PG8_BAR; PG8_MMA(0, 0, At, B0); PG8_MMA(0, 1, At, B1); PG8_BAR; PG8_SCHED;
            PG8_LDA(At, 1, 1); PG8_STAGE(PG8_SB(1, 0), b3, voffB); PG8_STAGE(PG8_SB(1, 1), b3 + hstepB, voffB); PG8_STAGE(PG8_SA(1, 0), a3, voffA);
            PG8_WAIT_V(8); PG8_WAIT_L(0); PG8_BAR; PG8_MMA(1, 0, At, B0); PG8_MMA(1, 1, At, B1); PG8_BAR; PG8_SCHED;
            } else {
            PG8_LDB(B0, 0, 0); PG8_SCHED; PG8_LDA(At, 0, 0); PG8_STAGE(PG8_SA(1, 1), a1 + hstepA, voffA);
            PG8_WAIT_L(8); PG8_BAR; PG8_WAIT_L(0); PG8_MMA(0, 0, At, B0); PG8_BAR; PG8_SCHED;
            PG8_LDB(B1, 0, 1); PG8_STAGE(PG8_SB(0, 0), b2, voffB);
            PG8_BAR; PG8_WAIT_L(0); PG8_MMA(0, 1, At, B1); PG8_BAR;
            PG8_LDA(At, 0, 1); PG8_STAGE(PG8_SA(0, 0), a2, voffA);
            PG8_BAR; PG8_WAIT_L(0); PG8_MMA(1, 0, At, B0); PG8_BAR; PG8_SCHED;
            PG8_STAGE(PG8_SB(0, 1), b2 + hstepB, voffB);
            PG8_WAIT_V(6); PG8_BAR; PG8_MMA(1, 1, At, B1); PG8_BAR;
            PG8_LDB(B0, 1, 0); PG8_SCHED; PG8_LDA(At, 1, 0); PG8_STAGE(PG8_SA(0, 1), a2 + hstepA, voffA);
            PG8_WAIT_L(8); PG8_BAR; PG8_WAIT_L(0); PG8_MMA(0, 0, At, B0); PG8_BAR; PG8_SCHED;
            PG8_LDB(B1, 1, 1); PG8_STAGE(PG8_SB(1, 0), b3, voffB);
            PG8_BAR; PG8_WAIT_L(0); PG8_MMA(0, 1, At, B1); PG8_BAR;
            PG8_LDA(At, 1, 1); PG8_STAGE(PG8_SA(1, 0), a3, voffA);
            PG8_BAR; PG8_WAIT_L(0); PG8_MMA(1, 0, At, B0); PG8_BAR; PG8_SCHED;
            PG8_STAGE(PG8_SB(1, 1), b3 + hstepB, voffB);
            PG8_WAIT_V(6); PG8_BAR; PG8_MMA(1, 1, At, B1); PG8_BAR;
            }
        }
        if constexpr (ALIGN_EPI) { if (wr == 0) PG8_BAR; }
        if constexpr (!Epi::AFTER_DRAIN) { E(acc, cur, wr, wc, fr, fq); S.done(cur); }
        if (!has_next) break;
#pragma unroll
        for (int a = 0; a < 2; ++a)
#pragma unroll
            for (int b = 0; b < 2; ++b)
#pragma unroll
                for (int m = 0; m < 4; ++m)
#pragma unroll
                    for (int n = 0; n < 2; ++n) acc[a][b][m][n] = (f32x4){0.f, 0.f, 0.f, 0.f};
        cur = nxt; cA = nA; cB = nB; ++ui;
        if constexpr (ALIGN_EPI) { if (wr == 1) PG8_BAR; }
    }
    PG8_WAIT_V(0);
    if constexpr (!ALIGN_EPI) { if (wr == 0) PG8_BAR; }
    PG8_BAR;
    if constexpr (Epi::AFTER_DRAIN) { E.fused(acc, cur, wr, wc, fr, fq, lds, wid, lane); S.done(cur); }
#undef PG8_SA
#undef PG8_SB
#undef PG8_STAGE
#undef PG8_LDA
#undef PG8_LDB
#undef PG8_MMA
#undef PG8_WAIT_V
#undef PG8_WAIT_L
#undef PG8_BAR
#undef PG8_SCHED
}
}
namespace attn {
using bf16 = __hip_bfloat16;
typedef short bf16x8 __attribute__((ext_vector_type(8)));
typedef short s16x4 __attribute__((ext_vector_type(4)));
typedef float f32x16 __attribute__((ext_vector_type(16)));
typedef float f32x4 __attribute__((ext_vector_type(4)));
typedef unsigned u32x4 __attribute__((ext_vector_type(4)));
template <class A, class Bt> struct same_t { static constexpr bool v = false; };
template <class A> struct same_t<A, A> { static constexpr bool v = true; };
constexpr int D = 128, PITCH = PP;
constexpr float THR = 8.f;
constexpr bool WSKIP = false;
constexpr float SCALE = 0.08838834764831845f;
constexpr int NW = 8, QBLK = 32, KVBLK = 64, QB = NW * QBLK;
constexpr int SHM_V = KVBLK * D * 2, SHM_K = KVBLK * D * 2;
constexpr int ATT_LDS_BYTES = 2 * SHM_V + 2 * SHM_K + NW * 64 * 4;
#define KSWZ(row, colB) ((row) * 256 + ((colB) ^ (((row) & 7) << 4)))
#define SBAR() __builtin_amdgcn_sched_barrier(0)
__device__ __forceinline__ int v_st(int k, int c) { const int kk = (k & ~0xC) | ((k & 4) << 1) | ((k & 8) >> 1); return ((kk >> 3) * 4 + (c >> 5)) * 512 + ((kk & 7) * 32 + (c & 31)) * 2; }
__device__ __forceinline__ int v_rd_base(int lane) { return ((lane & 3) << 3) | (((lane >> 2) & 3) << 6) | (((lane >> 4) & 1) << 5) | (((lane >> 5) & 1) << 8); }
constexpr int v_rd_off(int d0, int ks, int half) { return d0 * 512 + ks * 4096 + half * 2048; }
__device__ __forceinline__ int crow(int r, int hi) { return (r & 3) + 8 * (r >> 2) + 4 * hi; }
__device__ __forceinline__ unsigned cvtpk(float lo, float hi) {
    unsigned r; asm volatile("v_cvt_pk_bf16_f32 %0, %1, %2" : "=v"(r) : "v"(lo), "v"(hi)); return r;
}
__device__ __forceinline__ bf16x8 pack8(f32x4 a, f32x4 b) {
    u32x4 w = {cvtpk(a[0], a[1]), cvtpk(a[2], a[3]), cvtpk(b[0], b[1]), cvtpk(b[2], b[3])};
    return *reinterpret_cast<bf16x8*>(&w);
}
template <class T> __device__ __forceinline__ bf16x8 load8(const T* p) {
    if constexpr (same_t<T, float>::v) { return pack8(*(const f32x4*)p, *(const f32x4*)(p + 4)); }
    else { return *reinterpret_cast<const bf16x8*>(p); }
}
__device__ __forceinline__ void mask_bits(f32x16& p0, f32x16& p1, unsigned long long mw, int hi) {
    const float NEG = -__builtin_inff();
    const unsigned a = (unsigned)mw >> (4 * hi), b = (unsigned)(mw >> 32) >> (4 * hi);
#pragma unroll
    for (int r = 0; r < 16; ++r) {
        const int c = (r & 3) + 8 * (r >> 2);
        if (!((a >> c) & 1u)) p0[r] = NEG;
        if (!((b >> c) & 1u)) p1[r] = NEG;
    }
}
__device__ __forceinline__ void partialSM(f32x16& p0, f32x16& p1, float& m_reg, float& mn, float& alpha) {
    float pmax = p0[0]; for (int r = 1; r < 16; ++r) pmax = fmaxf(pmax, p0[r]); for (int r = 0; r < 16; ++r) pmax = fmaxf(pmax, p1[r]);
    { auto rr = __builtin_amdgcn_permlane32_swap(__float_as_uint(pmax), __float_as_uint(pmax), false, false);
      pmax = fmaxf(__uint_as_float(rr[0]), __uint_as_float(rr[1])); }
    constexpr float C2 = 1.4426950408889634f * SCALE;
    if (__builtin_expect(__all((pmax - m_reg) * SCALE <= THR), 1)) { mn = m_reg; alpha = 1.f; }
    else { mn = fmaxf(m_reg, pmax); alpha = __builtin_amdgcn_exp2f((m_reg - mn) * C2); m_reg = mn; }
    const float mnL = -mn * C2;
    for (int r = 0; r < 16; ++r) p0[r] = fmaf(p0[r], C2, mnL); for (int r = 0; r < 16; ++r) p1[r] = fmaf(p1[r], C2, mnL);
    for (int r = 0; r < 16; ++r) p0[r] = __builtin_amdgcn_exp2f(p0[r]);
}
__device__ __forceinline__ void finishSM(f32x16& p0, f32x16& p1, float alpha, float& l_reg, bf16x8& pa0, bf16x8& pa1, bf16x8& pa2, bf16x8& pa3) {
    for (int r = 0; r < 16; ++r) p1[r] = __builtin_amdgcn_exp2f(p1[r]);
    float ps = 0; for (int r = 0; r < 16; ++r) ps += p0[r]; for (int r = 0; r < 16; ++r) ps += p1[r];
    { auto rr = __builtin_amdgcn_permlane32_swap(__float_as_uint(ps), __float_as_uint(ps), false, false);
      ps = __uint_as_float(rr[0]) + __uint_as_float(rr[1]); }
    l_reg = l_reg * alpha + ps;
#define PK4(P, B_, OUT) do { unsigned a0 = cvtpk(P[B_+0], P[B_+1]), a1 = cvtpk(P[B_+2], P[B_+3]);                          \
        unsigned b0 = cvtpk(P[B_+4], P[B_+5]), b1 = cvtpk(P[B_+6], P[B_+7]);                                             \
        auto r0 = __builtin_amdgcn_permlane32_swap(a0, b0, false, false); auto r1 = __builtin_amdgcn_permlane32_swap(a1, b1, false, false); \
        u32x4 w = {r0[0], r1[0], r0[1], r1[1]}; OUT = *reinterpret_cast<bf16x8*>(&w); } while (0)
    PK4(p0, 0, pa0); PK4(p0, 8, pa1); PK4(p1, 0, pa2); PK4(p1, 8, pa3);
#undef PK4
}
template <int KB, bool SK>
__device__ __forceinline__ void qkt(f32x16& p0, f32x16& p1, const char* K_lds, int r32, int hi, const bf16x8* qr, bool act) {
    if (SK && !act) { const float NEG = -__builtin_inff();
#pragma unroll
        for (int r = 0; r < 16; ++r) { p0[r] = NEG; p1[r] = NEG; } return; }
    p0 = f32x16{}; p1 = f32x16{};
    const char* kb[4];
#pragma unroll
    for (int dd = 0; dd < 4; ++dd) kb[dd] = K_lds + KB * SHM_K + KSWZ(r32, (dd * 16 + hi * 8) * 2);
#pragma unroll
    for (int d0 = 0; d0 < 8; ++d0) { const char* a = kb[d0 & 3] + (d0 >> 2) * 128;
        bf16x8 b0 = *reinterpret_cast<const bf16x8*>(a);
        bf16x8 b1 = *reinterpret_cast<const bf16x8*>(a + 32 * 256);
        p0 = __builtin_amdgcn_mfma_f32_32x32x16_bf16(b0, qr[d0], p0, 0, 0, 0);
        p1 = __builtin_amdgcn_mfma_f32_32x32x16_bf16(b1, qr[d0], p1, 0, 0, 0); }
}
template <int VB, bool SK>
__device__ __forceinline__ void pv_tile(f32x16* o, int vb0, bf16x8 pa0, bf16x8 pa1, bf16x8 pa2, bf16x8 pa3, bool act) {
    if (SK && !act) return;
#define TRRD(dst, off) asm volatile("ds_read_b64_tr_b16 %0, %1 offset:%2" : "=&v"(dst) : "v"(vb0), "i"(off) : "memory")
#define PV_D0(d0) do { s16x4 l0, l1, l2, l3, h0, h1, h2, h3; constexpr int b_ = VB * SHM_V + v_rd_off(d0, 0, 0);     \
        TRRD(l0, b_); TRRD(h0, b_ + 2048); TRRD(l1, b_ + 4096); TRRD(h1, b_ + 6144); TRRD(l2, b_ + 8192); TRRD(h2, b_ + 10240); TRRD(l3, b_ + 12288); TRRD(h3, b_ + 14336); \
        asm volatile("s_waitcnt lgkmcnt(0)" ::: "memory"); SBAR();                 \
        o[d0] = __builtin_amdgcn_mfma_f32_32x32x16_bf16(pa0, (bf16x8){l0[0], l0[1], l0[2], l0[3], h0[0], h0[1], h0[2], h0[3]}, o[d0], 0, 0, 0);   \
        o[d0] = __builtin_amdgcn_mfma_f32_32x32x16_bf16(pa1, (bf16x8){l1[0], l1[1], l1[2], l1[3], h1[0], h1[1], h1[2], h1[3]}, o[d0], 0, 0, 0);   \
        o[d0] = __builtin_amdgcn_mfma_f32_32x32x16_bf16(pa2, (bf16x8){l2[0], l2[1], l2[2], l2[3], h2[0], h2[1], h2[2], h2[3]}, o[d0], 0, 0, 0);   \
        o[d0] = __builtin_amdgcn_mfma_f32_32x32x16_bf16(pa3, (bf16x8){l3[0], l3[1], l3[2], l3[3], h3[0], h3[1], h3[2], h3[3]}, o[d0], 0, 0, 0); } while (0)
    PV_D0(0); PV_D0(1); PV_D0(2); PV_D0(3);
#undef PV_D0
#undef TRRD
}
template <class TIn, class TOut> struct BlockRef { const TIn* Q; const TIn* K; const TIn* V; TOut* O; const unsigned long long* MK; int P0; };
template <class TIn> struct Seam {
    bf16x8 qr[8];
    bf16x8 st_v0, st_v1, st_k0, st_k1; f32x4 sf0, sf1, sf2, sf3;
    f32x4 tq[16];
};
__device__ __forceinline__ int swa_jlo(int P0, int W) { const int lowk = P0 - W + 1; return lowk > 0 ? lowk / KVBLK : 0; }
#define ROW(p, k0, rr) ((p) + (size_t)((k0) + (rr)) * PITCH + sc)
#define VMW() asm volatile("s_waitcnt vmcnt(0)" ::: "memory")
#define VMWN(n) asm volatile("s_waitcnt vmcnt(%0)" :: "i"(n) : "memory")
#define SLOAD_H(Kp, Vp, k0) do { S.st_v0 = load8<TIn>(ROW(Vp, k0, sr)); S.st_v1 = load8<TIn>(ROW(Vp, k0, 32 + sr));              \
                         S.st_k0 = load8<TIn>(ROW(Kp, k0, sr)); S.st_k1 = load8<TIn>(ROW(Kp, k0, 32 + sr)); } while (0)
#define SWRITE_HK(bf) do { *(bf16x8*)(K_lds + (bf) * SHM_K + kws) = S.st_k0; *(bf16x8*)(K_lds + (bf) * SHM_K + kws + 32 * 256) = S.st_k1; } while (0)
#define SWRITE_HV(bf) do { *(bf16x8*)(V_lds + (bf) * SHM_V + vst0) = S.st_v0; *(bf16x8*)(V_lds + (bf) * SHM_V + vst1) = S.st_v1; } while (0)
#define SWRITE_H(bf) do { SWRITE_HV(bf); SWRITE_HK(bf); } while (0)
#define SLOAD_F(p, k0) do { S.sf0 = *(const f32x4*)ROW(p, k0, sr); S.sf1 = *(const f32x4*)(ROW(p, k0, sr) + 4);                \
                            S.sf2 = *(const f32x4*)ROW(p, k0, 32 + sr); S.sf3 = *(const f32x4*)(ROW(p, k0, 32 + sr) + 4); } while (0)
#define SWRITE_KF(bf) do { *(bf16x8*)(K_lds + (bf) * SHM_K + kws) = pack8(S.sf0, S.sf1); *(bf16x8*)(K_lds + (bf) * SHM_K + kws + 32 * 256) = pack8(S.sf2, S.sf3); } while (0)
#define SWRITE_VF(bf) do { *(bf16x8*)(V_lds + (bf) * SHM_V + vst0) = pack8(S.sf0, S.sf1); *(bf16x8*)(V_lds + (bf) * SHM_V + vst1) = pack8(S.sf2, S.sf3); } while (0)
template <class TIn, class TOut>
__device__ __forceinline__ void causal_swa_prime(const BlockRef<TIn, TOut>& cur, int W, char* lds, Seam<TIn>& S) {
    constexpr bool F32 = same_t<TIn, float>::v;
    const int tid = threadIdx.x, wid = __builtin_amdgcn_readfirstlane(tid >> 6), lane = tid & 63, r32 = lane & 31, hi = lane >> 5;
    const int sr = tid >> 4, sc = (tid & 15) * 8, kws = KSWZ(sr, sc * 2); char* K_lds = lds + 2 * SHM_V;
    const int kb0 = swa_jlo(cur.P0, W) * KVBLK;
    for (int d0 = 0; d0 < 8; ++d0) S.qr[d0] = load8<TIn>(cur.Q + (size_t)(wid * QBLK + r32) * PITCH + d0 * 16 + hi * 8);
    if constexpr (F32) { SLOAD_F((const float*)cur.K, kb0); VMW(); SWRITE_KF(0); SBAR(); SLOAD_F((const float*)cur.V, kb0); }
    else { SLOAD_H(cur.K, cur.V, kb0); VMW(); SWRITE_HK(0); }
    __syncthreads();
}
template <class TIn, class TOut>
__device__ __forceinline__ void causal_swa_block(const BlockRef<TIn, TOut>& cur, const BlockRef<TIn, TOut>& nxt, int skv, int W, char* lds, Seam<TIn>& S) {
    constexpr bool F32 = same_t<TIn, float>::v;
    const int tid = threadIdx.x, wid = __builtin_amdgcn_readfirstlane(tid >> 6), lane = tid & 63, r32 = lane & 31, hi = lane >> 5;
    const int j_lo = swa_jlo(cur.P0, W);
    int j_hi = (cur.P0 + QB - 1) / KVBLK + 1; if (j_hi > skv / KVBLK) j_hi = skv / KVBLK;
    const int NT = j_hi - j_lo;
    const int kbn = swa_jlo(nxt.P0, W) * KVBLK;
    const int qlo = cur.P0 + wid * QBLK, qm = qlo + r32 - 4 * hi;
    char* V_lds = lds; char* K_lds = lds + 2 * SHM_V;
    float* ws = (float*)(lds + 2 * SHM_V + 2 * SHM_K) + wid * 64; float* li_l = ws, * al_l = ws + 32;
    float m_reg = -1e30f, l_reg = 0; f32x16 o[4] = {};
    const int sr = tid >> 4, sc = (tid & 15) * 8, vst0 = v_st(sr, sc), vst1 = v_st(32 + sr, sc), kws = KSWZ(sr, sc * 2);
    const int vb0 = (int)(uintptr_t)V_lds + v_rd_base(lane);
    const TIn* Kh = cur.K; const TIn* Vh = cur.V;
    const unsigned long long* mrow = cur.MK + (size_t)(wid * QBLK + r32) * 128; unsigned long long mwA, mwB = 0ull;
#define RESC(a) do { if (__any((a) < 1.f)) { if (hi == 0) al_l[r32] = (a); asm volatile("s_waitcnt lgkmcnt(0)" ::: "memory");              \
                     for (int d_ = 0; d_ < 4; ++d_) for (int r = 0; r < 16; ++r) o[d_][r] *= al_l[crow(r, hi)]; } } while (0)
#define KBASE(t) ((j_lo + (t)) * KVBLK)
#define ACT(t) (KBASE(t) <= qlo + QBLK - 1 && KBASE(t) + KVBLK - 1 >= qlo - W + 1)
#define MASKT(P0_, P1_, MW_) mask_bits(P0_, P1_, MW_, hi)
    constexpr int NQL = F32 ? 16 : 8;
    constexpr bool SK = WSKIP && !F32;
#define SEAM_K0() do { VMWN(NQL); if constexpr (F32) { SWRITE_KF(0); SBAR(); SLOAD_F((const float*)nxt.V, kbn); } else { SWRITE_HK(0); } SBAR(); } while (0)
    f32x16 pA0, pA1, pB0, pB1; float mnA, mnB, alA, alB; bf16x8 pa0, pa1, pa2, pa3;
    if constexpr (F32) { VMW(); SWRITE_VF(0); SBAR(); } else { SWRITE_HV(0); SBAR(); }
    if (NT > 1) { if constexpr (F32) SLOAD_F((const float*)Kh, KBASE(1)); else SLOAD_H(Kh, Vh, KBASE(1)); }
    mwA = mrow[0]; SBAR(); qkt<0, SK>(pA0, pA1, K_lds, r32, hi, S.qr, ACT(0));
    if constexpr (F32) { if (NT > 1) { VMW(); SWRITE_KF(1); SBAR(); SLOAD_F((const float*)Vh, KBASE(1)); } }
    MASKT(pA0, pA1, mwA); partialSM(pA0, pA1, m_reg, mnA, alA);
    if (NT > 1) { VMW(); if constexpr (F32) { SWRITE_VF(1); SBAR(); if (NT > 2) SLOAD_F((const float*)Kh, KBASE(2)); } else SWRITE_H(1); }
    __syncthreads();
#define HALF_STEP(PX0, PX1, mnX, alX, PY0, PY1, alY, t, KB, VB, SB, MWX) do {                                                      \
        MWX = mrow[(t)]; SBAR(); qkt<KB, SK>(PX0, PX1, K_lds, r32, hi, S.qr, ACT(t));                                             \
        finishSM(PY0, PY1, alY, l_reg, pa0, pa1, pa2, pa3); SBAR();                                                           \
        if ((t) + 1 < NT) { if constexpr (F32) { VMW(); SWRITE_KF(SB); SBAR(); SLOAD_F((const float*)Vh, KBASE((t) + 1)); }  \
                            else { SLOAD_H(Kh, Vh, KBASE((t) + 1)); } SBAR(); }                                               \
        pv_tile<VB, SK>(o, vb0, pa0, pa1, pa2, pa3, ACT((t) - 1)); MASKT(PX0, PX1, MWX); partialSM(PX0, PX1, m_reg, mnX, alX);                                        \
        __syncthreads();                                                                                                      \
        if ((t) + 1 < NT) { VMW(); if constexpr (F32) { SWRITE_VF(SB); SBAR(); if ((t) + 2 < NT) SLOAD_F((const float*)Kh, KBASE((t) + 2)); } \
                            else { SWRITE_H(SB); } }                                                                          \
        RESC(alX); __syncthreads(); } while (0)
    for (int t = 1; t + 1 < NT; t += 2) {
        HALF_STEP(pB0, pB1, mnB, alB, pA0, pA1, alA, t, 1, 0, 0, mwB);
        HALF_STEP(pA0, pA1, mnA, alA, pB0, pB1, alB, t + 1, 0, 1, 1, mwA);
    }
    const bool even = (NT & 1) == 0;
    if (even) { mwB = mrow[NT - 1]; SBAR(); qkt<1, SK>(pB0, pB1, K_lds, r32, hi, S.qr, ACT(NT - 1)); SBAR(); }
#define QROW(e) (nxt.Q + (size_t)(wid * QBLK + r32) * PITCH + ((e) >> 1) * 16 + hi * 8 + ((e) & 1) * 4)
    if constexpr (F32) { SLOAD_F((const float*)nxt.K, kbn); SBAR();
#pragma unroll
        for (int e = 0; e < 8; ++e) S.tq[e] = *(const f32x4*)QROW(e); }
    else { SLOAD_H(nxt.K, nxt.V, kbn); SBAR();
#pragma unroll
        for (int d0 = 0; d0 < 8; ++d0) S.qr[d0] = load8<TIn>(nxt.Q + (size_t)(wid * QBLK + r32) * PITCH + d0 * 16 + hi * 8); }
    SBAR();
    finishSM(pA0, pA1, alA, l_reg, pa0, pa1, pa2, pa3); SBAR();
    if constexpr (F32) {
#pragma unroll
        for (int e = 8; e < 16; ++e) S.tq[e] = *(const f32x4*)QROW(e); SBAR(); }
#undef QROW
    pv_tile<0, SK>(o, vb0, pa0, pa1, pa2, pa3, ACT(even ? NT - 2 : NT - 1));
    if (even) { MASKT(pB0, pB1, mwB); partialSM(pB0, pB1, m_reg, mnB, alB); __syncthreads(); RESC(alB);
        finishSM(pB0, pB1, alB, l_reg, pa0, pa1, pa2, pa3); SBAR(); pv_tile<1, SK>(o, vb0, pa0, pa1, pa2, pa3, ACT(NT - 1)); }
    SBAR(); SEAM_K0();
    if (hi == 0) li_l[r32] = l_reg; asm volatile("s_waitcnt lgkmcnt(0)" ::: "memory");
    float rli[16];
#pragma unroll
    for (int r = 0; r < 16; ++r) rli[r] = __builtin_amdgcn_rcpf(li_l[crow(r, hi)]);
    TOut* Ow = cur.O + (size_t)(wid * QBLK) * PITCH;
#pragma unroll
    for (int r = 0; r < 16; ++r) { const int orow = crow(r, hi);
#pragma unroll
        for (int d0 = 0; d0 < 4; ++d0) { const float v = o[d0][r] * rli[r];
            if constexpr (same_t<TOut, float>::v) { Ow[(size_t)orow * PITCH + d0 * 32 + r32] = v; }
            else { const float vn = __shfl_xor(v, 1);
                   if ((r32 & 1) == 0) *(unsigned*)(Ow + (size_t)orow * PITCH + d0 * 32 + r32) = cvtpk(v, vn); } } }
    if constexpr (F32) {
#pragma unroll
        for (int d0 = 0; d0 < 8; ++d0) S.qr[d0] = pack8(S.tq[2 * d0], S.tq[2 * d0 + 1]); }
    __syncthreads();
#undef RESC
#undef KBASE
#undef ACT
#undef MASKT
#undef SEAM_K0
#undef HALF_STEP
}
#undef ROW
#undef VMW
#undef VMWN
#undef SLOAD_H
#undef SWRITE_HK
#undef SWRITE_HV
#undef SWRITE_H
#undef SLOAD_F
#undef SWRITE_KF
#undef SWRITE_VF

#undef KSWZ
#undef SBAR
}

struct Params { const float* in[21]; float* out; unsigned char* ws; };
__constant__ float ROPE_INVF[24] = { 1.000000000e+00f, 4.403665960e-01f, 1.939227432e-01f, 8.539710194e-02f, 3.760603070e-02f, 1.656044088e-02f, 7.292664610e-03f, 3.211446106e-03f,
    1.414213562e-03f, 6.227724371e-04f, 2.742481884e-04f, 1.207697351e-04f, 5.318295734e-05f, 2.341999971e-05f, 1.031338525e-05f, 4.541670478e-06f,
    1.000000000e+00f, 1.939227432e-01f, 3.760603070e-02f, 7.292664610e-03f, 1.414213562e-03f, 2.742481884e-04f, 5.318295734e-05f, 1.031338525e-05f };
constexpr int CW_IDXQ = 64;
constexpr int CW_BAR = 4096;
#define XCD_BAR_WORDS 3456

#define LDS_WAIT() asm volatile("s_waitcnt lgkmcnt(0)" ::: "memory")

__device__ __forceinline__ int rowmap(int mode, int c) {
    if (mode == 1) return ((c >> 7) << 8) + (c & 127);
    if (mode == 2) return ((c >> 7) << 8) + 128 + (c & 127);
    if (mode == 3) return c < 4176 ? c : c + 176;
    return c;
}
__device__ __forceinline__ void transpose_item(const float* __restrict__ W, int K, int N, bf16raw* WT, int mode, LAS float* scr, int item, int lane, const float* __restrict__ gain = nullptr) {
    const int nblk = (N + 63) >> 6, kb = item / nblk, nb = item - kb * nblk, k0 = 64 * kb, n0 = 64 * nb;
    const int nn = n0 + (lane & 15) * 4; const bool ok = nn + 3 < N;
#pragma unroll 8
    for (int i = 0; i < 16; ++i) { const int kk = 4 * i + (lane >> 4); f32x4_t v = {0.f, 0.f, 0.f, 0.f}; if (ok) v = *(const f32x4_t*)(W + (size_t)(k0 + kk) * N + nn);
        if (gain) v = v * gain[k0 + kk];
        LAS float* d = scr + kk * 65 + (lane & 15) * 4; d[0] = v.x; d[1] = v.y; d[2] = v.z; d[3] = v.w; }
    LDS_WAIT();
    const int c = lane & 7;
#pragma unroll
    for (int j = 0; j < 8; ++j) { const int n = (lane >> 3) + 8 * j; const LAS float* s = scr + (8 * c) * 65 + n;
        u32x4_t o; o.x = pkbf(s[0 * 65], s[1 * 65]); o.y = pkbf(s[2 * 65], s[3 * 65]); o.z = pkbf(s[4 * 65], s[5 * 65]); o.w = pkbf(s[6 * 65], s[7 * 65]);
        if (n0 + n < N) *(u32x4_t*)(WT + (size_t)rowmap(mode, n0 + n) * K + k0 + 8 * c) = o; }
    LDS_WAIT();
}
__device__ __forceinline__ void rms_row(const float* __restrict__ xrow, const float* __restrict__ g, bf16raw* orow, int lane) {
    f32x4_t v[8]; float s = 0.f;
#pragma unroll
    for (int j = 0; j < 8; ++j) { v[j] = ((const f32x4_t*)xrow)[64 * j + lane]; s += (v[j].x * v[j].x + v[j].y * v[j].y) + (v[j].z * v[j].z + v[j].w * v[j].w); }
    const float r = 1.0f / sqrtf(wave_sum(s) * (1.0f / DM) + EPS);
#pragma unroll
    for (int j = 0; j < 8; ++j) { const f32x4_t gv = ((const f32x4_t*)g)[64 * j + lane]; u32x2_t o; o.x = pkbf(v[j].x * r * gv.x, v[j].y * r * gv.y); o.y = pkbf(v[j].z * r * gv.z, v[j].w * r * gv.w);
        ((u32x2_t*)orow)[64 * j + lane] = o; }
}
__device__ __forceinline__ void rms_phase(const float* x, const float* g, bf16raw* xn, int gw, int ngw, int lane) {
    for (int m = gw; m < MTOK; m += ngw) rms_row(x + (size_t)m * DM, g, xn + (size_t)m * DM, lane);
}
__device__ __forceinline__ void p0_prologue(const Params& P, LAS unsigned char* lds, int tid, int lane, int wave) {
    unsigned char* ws = P.ws;
    LAS float* scr = (LAS float*)(lds + wave * 16640);
    const int gw = blockIdx.x * NWAVES + wave, ngw = gridDim.x * NWAVES;
    constexpr int I_G = 32 * 88, I_D = 88 * 32, I_IN = 32 * 162, I_UA = 16 * 32, I_OUT = 32 * 32;
    constexpr int NITEMS = 4 * I_G + 2 * I_D + I_IN + 2 * I_UA + I_OUT;
    for (int it = gw; it < NITEMS; it += ngw) {
        int r = it;
        if (r < I_G) { transpose_item(P.in[3], DM, DFF, (bf16raw*)(ws + WS_WGU1), 1, scr, r, lane); continue; } r -= I_G;
        if (r < I_G) { transpose_item(P.in[4], DM, DFF, (bf16raw*)(ws + WS_WGU1), 2, scr, r, lane); continue; } r -= I_G;
        if (r < I_D) { transpose_item(P.in[5], DFF, DM, (bf16raw*)(ws + WS_WD1), 0, scr, r, lane); continue; } r -= I_D;
        if (r < I_G) { transpose_item(P.in[18], DM, DFF, (bf16raw*)(ws + WS_WGU2), 1, scr, r, lane, P.in[17]); continue; } r -= I_G;
        if (r < I_G) { transpose_item(P.in[19], DM, DFF, (bf16raw*)(ws + WS_WGU2), 2, scr, r, lane, P.in[17]); continue; } r -= I_G;
        if (r < I_D) { transpose_item(P.in[20], DFF, DM, (bf16raw*)(ws + WS_WD2), 0, scr, r, lane); continue; } r -= I_D;
        if (r < I_IN) { transpose_item(P.in[7], DM, 10320, (bf16raw*)(ws + WS_WIN), 3, scr, r, lane, P.in[6]); continue; } r -= I_IN;
        if (r < I_UA) { transpose_item(P.in[14], 1024, DM, (bf16raw*)(ws + WS_WUA), 0, scr, r, lane); continue; } r -= I_UA;
        if (r < I_UA) { transpose_item(P.in[15], 1024, DM, (bf16raw*)(ws + WS_WUS), 0, scr, r, lane); continue; } r -= I_UA;
        transpose_item(P.in[16], DM, DM, (bf16raw*)(ws + WS_WOUT), 0, scr, r, lane);
    }
    const int gt = blockIdx.x * NTHR + tid, ngt = gridDim.x * NTHR;
    { u32x4_t* padp = (u32x4_t*)((bf16raw*)(ws + WS_WIN) + (size_t)4176 * DM);
      for (int i = gt; i < 176 * DM / 8; i += ngt) padp[i] = (u32x4_t){0u, 0u, 0u, 0u}; }
    { const float* w_s = P.in[12]; bf16raw* wsb = (bf16raw*)(ws + WS_WSB);
      for (int i = gt; i < 8 * 128 * 128; i += ngt) { const int s = i & 127, t = (i >> 7) & 127; const float v = (t < 64 && s >= 64) ? 0.f : w_s[i]; wsb[i] = (bf16raw)(pkbf(v, 0.f) & 0xffffu); } }
    if (blockIdx.x == 0 && tid < 128) ((unsigned*)(ws + WS_CTL))[tid] = 0u;
    if (blockIdx.x == 0) { unsigned* bw = (unsigned*)(ws + WS_CTL) + CW_BAR; for (int i = tid; i < XCD_BAR_WORDS; i += NTHR) bw[i] = 0u; }
    { float* ssz = (float*)(ws + WS_SS1); for (int i = gt; i < 2 * MTOK; i += ngt) ssz[i] = 0.f; }
    rms_phase(P.in[0], P.in[2], (bf16raw*)(ws + WS_XN), gw, ngw, lane);
}

template <class Epi> __device__ __forceinline__ void run_gemm(LAS unsigned char* lds, const bf16raw* A, int lda, const bf16raw* Bt, int ldb, int N, int K, const Epi& E) {
    pg8::Gemm g{A, Bt, MTOK, N, K, lda, ldb}; pg8::StaticOrder S; S.init(MTOK, N, (int)gridDim.x, (int)blockIdx.x);
    pg8::gemm_phase<Epi, pg8::StaticOrder, true, true>(lds, g, S, E);
}

__device__ __forceinline__ void ld16(const bf16raw* p, float (&v)[16]) {
    const u32x4_t a = *(const u32x4_t*)p, b = *(const u32x4_t*)(p + 8);
#pragma unroll
    for (int e = 0; e < 4; ++e) { v[2 * e] = bflo(a[e]); v[2 * e + 1] = bfhi(a[e]); v[8 + 2 * e] = bflo(b[e]); v[8 + 2 * e + 1] = bfhi(b[e]); }
}
__device__ __forceinline__ void st16(bf16raw* p, const float (&v)[16]) {
    u32x4_t a, b;
#pragma unroll
    for (int e = 0; e < 4; ++e) { a[e] = pkbf(v[2 * e], v[2 * e + 1]); b[e] = pkbf(v[8 + 2 * e], v[8 + 2 * e + 1]); }
    *(u32x4_t*)p = a; *(u32x4_t*)(p + 8) = b;
}
__device__ __forceinline__ void prep_token(const Params& P, int m, int lane) {
    bf16raw* row = (bf16raw*)(P.ws + WS_PROJ) + (size_t)m * PP;
    const int pos = ((const int*)P.in[1])[m];
    float cs = 1.f, sn = 0.f;
    if (lane < 24) { const float ang = (float)pos * ROPE_INVF[lane]; double rev = (double)ang * 0.15915494309189535; rev -= rint(rev); const float fr = (float)rev;
        sn = __builtin_amdgcn_sinf(fr); cs = __builtin_amdgcn_cosf(fr); }
    float cA[16], sA[16];
#pragma unroll
    for (int i = 0; i < 16; ++i) { cA[i] = __shfl(cs, i); sA[i] = __shfl(sn, i); }
    const int sub = lane & 7;
#pragma unroll
    for (int which = 0; which < 2; ++which) {
        bf16raw* p = row + (which ? C_K : C_Q) + lane * 16; const float* g = (which ? P.in[9] : P.in[8]) + sub * 16;
        float v[16]; ld16(p, v); float ss = 0.f;
#pragma unroll
        for (int i = 0; i < 16; ++i) ss += v[i] * v[i];
        ss += __shfl_xor(ss, 1); ss += __shfl_xor(ss, 2); ss += __shfl_xor(ss, 4);
        const float r = 1.0f / sqrtf(ss * (1.0f / 128.0f) + EPS);
#pragma unroll
        for (int i = 0; i < 16; ++i) v[i] = v[i] * r * g[i];
#pragma unroll
        for (int i = 0; i < 16; ++i) { const float o = __shfl_xor(v[i], 1); if (sub == 0) v[i] = v[i] * cA[i] - o * sA[i]; else if (sub == 1) v[i] = v[i] * cA[i] + o * sA[i]; }
        st16(p, v);
    }
    { bf16raw* p = row + C_QI + lane * 16; float v[16]; ld16(p, v);
      float cI[8], sI[8];
#pragma unroll
      for (int i = 0; i < 8; ++i) { cI[i] = __shfl(cs, 16 + i); sI[i] = __shfl(sn, 16 + i); }
      if ((lane & 3) == 0) {
#pragma unroll
          for (int i = 0; i < 8; ++i) { const float x1 = v[i], x2 = v[8 + i]; v[i] = x1 * cI[i] - x2 * sI[i]; v[8 + i] = x2 * cI[i] + x1 * sI[i]; }
      }
      st16(p, v);
      float y = bf2f(row[C_KI + lane]); const float ss = wave_sum(y * y);
      y = y * (1.0f / sqrtf(ss * (1.0f / 64.0f) + EPS)) * P.in[10][lane];
      const float o = __shfl_xor(y, 8), cc = __shfl(cs, 16 + (lane & 7)), s2 = __shfl(sn, 16 + (lane & 7));
      if (lane < 8) y = y * cc - o * s2; else if (lane < 16) y = y * cc + o * s2;
      ((bf16raw*)(P.ws + WS_KI))[(size_t)m * 64 + lane] = (bf16raw)(pkbf(y, 0.f) & 0xffffu);
      if (lane < 16) ((float*)(P.ws + WS_WI))[(size_t)m * 16 + lane] = bf2f(row[C_WI + lane]);
    }
    { bf16raw* p = row + C_U + lane * 16; float v[16]; ld16(p, v);
#pragma unroll
      for (int i = 0; i < 16; ++i) v[i] = gelu_tanh_f(v[i]);
      st16(p, v); }
    { bf16raw* p = row + C_VS + lane * 16; float v[16]; ld16(p, v); float ss = 0.f;
#pragma unroll
      for (int i = 0; i < 16; ++i) { v[i] = gelu_tanh_f(v[i]); ss += v[i] * v[i]; }
      const float r = 1.0f / sqrtf(wave_sum(ss) * (1.0f / 1024.0f) + EPS); const float* g = P.in[11] + lane * 16;
#pragma unroll
      for (int i = 0; i < 16; ++i) v[i] = v[i] * r * g[i];
      st16(p, v); }
}

__device__ __forceinline__ void sgu_phase(const Params& P, LAS unsigned char* lds, int tid, int lane, int wave) {
    bf16raw* proj = (bf16raw*)(P.ws + WS_PROJ); const bf16raw* wsb = (const bf16raw*)(P.ws + WS_WSB); const float* bs = P.in[13];
    LAS bf16raw* VT = (LAS bf16raw*)lds;
    const int r32 = lane & 31, hi = lane >> 5, tr = wave & 3, ch = wave >> 2;
    for (int item = blockIdx.x; item < 2048; item += gridDim.x) {
        const int g = item & 7, tok0 = (item >> 3) * 128;
#pragma unroll
        for (int i = 0; i < 4; ++i) { const int id = tid + 512 * i, s = id & 127, cc = (id >> 7) * 8;
            const u32x4_t w = *(const u32x4_t*)(proj + (size_t)(tok0 + s) * PP + C_VS + g * 128 + cc);
#pragma unroll
            for (int e = 0; e < 4; ++e) { VT[(cc + 2 * e) * 136 + s] = (bf16raw)(w[e] & 0xffffu); VT[(cc + 2 * e + 1) * 136 + s] = (bf16raw)(w[e] >> 16); } }
        __syncthreads();
        f32x16_t acc[2]; acc[0] = f32x16_t{}; acc[1] = f32x16_t{};
#pragma unroll
        for (int ks = 0; ks < 8; ++ks) {
            const bf16x8_t a = *(const bf16x8_t*)(wsb + (size_t)g * 16384 + (32 * tr + r32) * 128 + 16 * ks + 8 * hi);
#pragma unroll
            for (int nt = 0; nt < 2; ++nt) { const bf16x8_t b = *(const LAS bf16x8_t*)(VT + (64 * ch + 32 * nt + r32) * 136 + 16 * ks + 8 * hi);
                acc[nt] = __builtin_amdgcn_mfma_f32_32x32x16_bf16(a, b, acc[nt], 0, 0, 0); }
        }
#pragma unroll
        for (int nt = 0; nt < 2; ++nt)
#pragma unroll
            for (int r = 0; r < 16; ++r) { const int t = 32 * tr + (r & 3) + 8 * (r >> 2) + 4 * hi; bf16raw* up = proj + (size_t)(tok0 + t) * PP + C_U + g * 128 + 64 * ch + 32 * nt + r32;
                const float y = bf2f(*up) * (acc[nt][r] + bs[g * 128 + t]); *up = (bf16raw)(pkbf(y, 0.f) & 0xffffu); }
        __syncthreads();
    }
}

__device__ __forceinline__ bool radix_pick(const LAS unsigned* h, int k, int lane, int& d, int& kn, int& cnt) {
    const u32x4_t c = *(const LAS u32x4_t*)(h + 4 * lane);
    const unsigned t = c.x + c.y + c.z + c.w;
    int pv = (int)t;
    pv += __builtin_amdgcn_update_dpp(0, pv, 0x111, 0xf, 0xf, false);
    pv += __builtin_amdgcn_update_dpp(0, pv, 0x112, 0xf, 0xf, false);
    pv += __builtin_amdgcn_update_dpp(0, pv, 0x114, 0xf, 0xf, false);
    pv += __builtin_amdgcn_update_dpp(0, pv, 0x118, 0xf, 0xf, false);
    pv += __builtin_amdgcn_update_dpp(0, pv, 0x142, 0xa, 0xf, false);
    pv += __builtin_amdgcn_update_dpp(0, pv, 0x143, 0xc, 0xf, false);
    const unsigned total = (unsigned)__builtin_amdgcn_readlane(pv, 63);
    unsigned gt = total - (unsigned)pv; int dsel = -1; unsigned knn = 0u, cc = 0u; const unsigned kr = (unsigned)k;
    { const unsigned ge = gt + c.w; if (gt < kr && kr <= ge) { dsel = 4 * lane + 3; knn = kr - gt; cc = c.w; } gt = ge; }
    { const unsigned ge = gt + c.z; if (gt < kr && kr <= ge) { dsel = 4 * lane + 2; knn = kr - gt; cc = c.z; } gt = ge; }
    { const unsigned ge = gt + c.y; if (gt < kr && kr <= ge) { dsel = 4 * lane + 1; knn = kr - gt; cc = c.y; } gt = ge; }
    { const unsigned ge = gt + c.x; if (gt < kr && kr <= ge) { dsel = 4 * lane + 0; knn = kr - gt; cc = c.x; } gt = ge; }
    const unsigned long long bal = __ballot(dsel >= 0);
    if (bal == 0ull) return false;
    const int src = __builtin_amdgcn_readfirstlane(__ffsll((long long)bal) - 1);
    d = __builtin_amdgcn_readlane(dsel, src); kn = __builtin_amdgcn_readlane((int)knn, src); cnt = __builtin_amdgcn_readlane((int)cc, src);
    return true;
}
constexpr int IDX_LCAP = 2048;
template <int NJ> __device__ __forceinline__ void idx_select(const unsigned* __restrict__ sc, int nj, int wend, unsigned long long* mrow, LAS unsigned* hist, LAS unsigned* list, int lane) {
    unsigned u[NJ];
#pragma unroll
    for (int j = 0; j < NJ; ++j) u[j] = sc[j * 64 + lane];
#pragma unroll
    for (int j = 0; j < NJ; ++j) u[j] = (j < nj) ? u[j] : 0u;
    unsigned prefix = 0u; int krem = 256, d = 0, kn = 0, cnt = 0;
    hist[lane] = 0u; hist[lane + 64] = 0u; hist[lane + 128] = 0u; hist[lane + 192] = 0u;
    LDS_WAIT();
    { int njp = nj; asm volatile("" : "+s"(njp));
#pragma unroll
      for (int j = 0; j < NJ; ++j) { if (j < njp) __hip_atomic_fetch_add(hist + (u[j] >> 24), 1u, __ATOMIC_RELAXED, __HIP_MEMORY_SCOPE_WORKGROUP); } }
    LDS_WAIT();
    if (!radix_pick(hist, krem, lane, d, kn, cnt)) return;
    prefix = (unsigned)d << 24; krem = kn;
    if (cnt <= IDX_LCAP) {
        int base = 0;
        { int njp = nj; asm volatile("" : "+s"(njp));
#pragma unroll
          for (int j = 0; j < NJ; ++j) { if (j < njp) { const bool m = (u[j] >> 24) == (unsigned)d; const unsigned long long bal = __ballot(m);
                if (bal != 0ull) { if (m) list[base + (int)__builtin_amdgcn_mbcnt_hi((unsigned)(bal >> 32), __builtin_amdgcn_mbcnt_lo((unsigned)bal, 0u))] = u[j]; base += __popcll(bal); } } } }
        LDS_WAIT();
#pragma unroll 1
        for (int pass = 1; pass < 4; ++pass) {
            const int shift = 24 - 8 * pass; const unsigned himask = 0xffffffffu << (shift + 8);
            hist[lane] = 0u; hist[lane + 64] = 0u; hist[lane + 128] = 0u; hist[lane + 192] = 0u;
            LDS_WAIT();
            for (int i0 = lane; i0 < base; i0 += 256) {
                unsigned v[4]; bool ok[4];
#pragma unroll
                for (int q4 = 0; q4 < 4; ++q4) { const int i = i0 + 64 * q4; ok[q4] = i < base; v[q4] = list[ok[q4] ? i : 0]; }
#pragma unroll
                for (int q4 = 0; q4 < 4; ++q4) { if (ok[q4] && ((v[q4] ^ prefix) & himask) == 0u) __hip_atomic_fetch_add(hist + ((v[q4] >> shift) & 255u), 1u, __ATOMIC_RELAXED, __HIP_MEMORY_SCOPE_WORKGROUP); }
            }
            LDS_WAIT();
            if (!radix_pick(hist, krem, lane, d, kn, cnt)) break;
            prefix |= (unsigned)d << shift; krem = kn;
        }
    } else {
#pragma unroll 1
        for (int pass = 1; pass < 4; ++pass) {
            const int shift = 24 - 8 * pass; const unsigned himask = 0xffffffffu << (shift + 8);
            int njp = nj; asm volatile("" : "+s"(njp));
            hist[lane] = 0u; hist[lane + 64] = 0u; hist[lane + 128] = 0u; hist[lane + 192] = 0u;
            LDS_WAIT();
#pragma unroll
            for (int j = 0; j < NJ; ++j) { if (j < njp) { if (((u[j] ^ prefix) & himask) == 0u) __hip_atomic_fetch_add(hist + ((u[j] >> shift) & 255u), 1u, __ATOMIC_RELAXED, __HIP_MEMORY_SCOPE_WORKGROUP); } }
            LDS_WAIT();
            if (!radix_pick(hist, krem, lane, d, kn, cnt)) break;
            prefix |= (unsigned)d << shift; krem = kn;
        }
    }
    const unsigned thr = prefix; unsigned wl0 = 0u, wh0 = 0u, wl1 = 0u, wh1 = 0u; int total = 0;
#pragma unroll
    for (int j = 0; j < NJ; ++j) {
        const unsigned long long word = __ballot(u[j] >= thr);
        total += __popcll(word);
        { const unsigned wlo_ = (unsigned)__builtin_amdgcn_readfirstlane((int)(unsigned)word), whi_ = (unsigned)__builtin_amdgcn_readfirstlane((int)(unsigned)(word >> 32));
          if (j < 64) { asm volatile("v_writelane_b32 %0, %1, %2" : "+v"(wl0) : "s"(wlo_), "n"(j & 63)); asm volatile("v_writelane_b32 %0, %1, %2" : "+v"(wh0) : "s"(whi_), "n"(j & 63)); }
          else { asm volatile("v_writelane_b32 %0, %1, %2" : "+v"(wl1) : "s"(wlo_), "n"(j & 63)); asm volatile("v_writelane_b32 %0, %1, %2" : "+v"(wh1) : "s"(whi_), "n"(j & 63)); } }
    }
    if (__builtin_amdgcn_readfirstlane(total) != 256) {
        int taken = 0;
#pragma unroll
        for (int j = 0; j < NJ; ++j) {
            unsigned long long word = __ballot(u[j] > thr);
            unsigned long long e = __ballot(u[j] == thr);
            if (e != 0ull) { const int need = krem - taken;
                if (need > 0) { int n = __popcll(e); unsigned long long sel = e;
                    if (n > need) { sel = 0ull; for (int t2 = 0; t2 < need; ++t2) { const unsigned long long b = e & (~e + 1ull); sel |= b; e ^= b; } n = need; }
                    word |= sel; taken += n; } }
            { const unsigned wlo_ = (unsigned)__builtin_amdgcn_readfirstlane((int)(unsigned)word), whi_ = (unsigned)__builtin_amdgcn_readfirstlane((int)(unsigned)(word >> 32));
              if (j < 64) { asm volatile("v_writelane_b32 %0, %1, %2" : "+v"(wl0) : "s"(wlo_), "n"(j & 63)); asm volatile("v_writelane_b32 %0, %1, %2" : "+v"(wh0) : "s"(whi_), "n"(j & 63)); }
              else { asm volatile("v_writelane_b32 %0, %1, %2" : "+v"(wl1) : "s"(wlo_), "n"(j & 63)); asm volatile("v_writelane_b32 %0, %1, %2" : "+v"(wh1) : "s"(whi_), "n"(j & 63)); } }
        }
    }
    if (lane < wend) mrow[lane] = ((unsigned long long)wh0 << 32) | wl0;
    if (NJ > 64) { if (lane + 64 < wend) mrow[lane + 64] = ((unsigned long long)wh1 << 32) | wl1; }
}

__device__ __forceinline__ float relu_i(float x) { const int b = __float_as_int(x); return __int_as_float(b > 0 ? b : 0); }
__device__ __forceinline__ f32x16_t idx_chain(const bf16x8_t (&Af)[4], const bf16x8_t (&B4)[4]) {
    f32x16_t acc = f32x16_t{};
#pragma unroll
    for (int s = 0; s < 4; ++s) acc = __builtin_amdgcn_mfma_f32_32x32x16_bf16(Af[s], B4[s], acc, 0, 0, 0);
    return acc;
}
__device__ __forceinline__ unsigned idx_score_key(const f32x16_t& acc, const f32x4_t (&wv)[4]) {
    float sc0 = 0.f, sc1 = 0.f;
#pragma unroll
    for (int i = 0; i < 16; i += 2) { sc0 += relu_i(acc[i]) * wv[i >> 2][i & 3]; sc1 += relu_i(acc[i + 1]) * wv[(i + 1) >> 2][(i + 1) & 3]; }
    const unsigned bts = __float_as_uint(sc0 + sc1);
    return bts ^ ((unsigned)((int)bts >> 31) | 0x80000000u);
}
template <bool FULL> __device__ __forceinline__ void idx_rt_block(const bf16x8_t (&Bf)[8][4], const bf16x8_t (&Af)[4], const f32x4_t (&wv)[4], unsigned* srow, int tile0, int ntile) {
    if (FULL) {
        f32x16_t accA = idx_chain(Af, Bf[0]), accB;
#pragma unroll
        for (int kt = 0; kt < 8; ++kt) {
            if (kt + 1 < 8) accB = idx_chain(Af, Bf[kt + 1]);
            srow[(tile0 + kt * 8) * 32] = idx_score_key(accA, wv);
            if (kt + 1 < 8) {
#pragma unroll
                for (int s = 0; s < 4; ++s) { __builtin_amdgcn_sched_group_barrier(0x008, 1, 0); __builtin_amdgcn_sched_group_barrier(0x002, 10, 0); }
            }
            accA = accB;
        }
    } else {
#pragma unroll
        for (int kt = 0; kt < 8; ++kt) { const int tile = tile0 + kt * 8;
            if (tile < ntile) { const f32x16_t acc = idx_chain(Af, Bf[kt]); srow[tile * 32] = idx_score_key(acc, wv); } }
    }
}
__device__ __forceinline__ void indexer_phase(const Params& P, LAS unsigned char* lds, int tid, int lane, int wave) {
    unsigned char* ws = P.ws;
    const bf16raw* proj = (const bf16raw*)(ws + WS_PROJ); const bf16raw* KI = (const bf16raw*)(ws + WS_KI); const float* WIf = (const float*)(ws + WS_WI);
    unsigned long long* MASK = (unsigned long long*)(ws + WS_MASK); unsigned* ctl = (unsigned*)(ws + WS_CTL);
    float* scratch = P.out + (size_t)blockIdx.x * (16 * 8192);
    LAS unsigned* list = (LAS unsigned*)(lds + 45056) + wave * IDX_LCAP;
    LAS float* WL = (LAS float*)(lds + 32768); LAS unsigned* hist = (LAS unsigned*)(lds + 33792) + wave * 256; volatile LAS int* itemw = (volatile LAS int*)(lds + 41984);
    const int r32 = lane & 31, hi = lane >> 5;
    if (blockIdx.x >= 256) return;
    for (;;) {
        if (tid == 0) *itemw = (int)atomicAdd(ctl + CW_IDXQ, 1u);
        __syncthreads();
        const int it = *itemw;
        __syncthreads();
        if (it >= 2048) break;
        const int qt = 511 - (it >> 2), b = it & 3, q0 = qt * 16, n_adm = ((q0 >> 6) + 1) * 64, wend = ((q0 >> 8) + 1) * 4, tok0 = b * SEQ + q0;
        if (n_adm <= 256) {
            if (tid < 64) { const int q = tid >> 2, j = tid & 3; MASK[(size_t)(tok0 + q) * 128 + j] = (j < (n_adm >> 6)) ? ~0ull : 0ull; }
            continue;
        }
        for (int c = tid; c < 2048; c += NTHR) { const int l = c & 63, s = (c >> 6) & 3, rt = c >> 8, rho = l & 31, hf = l >> 5, par = (rho >> 2) & 1, head = (rho & 3) + 4 * (rho >> 3);
            *(LAS u32x4_t*)(lds + c * 16) = *(const u32x4_t*)(proj + (size_t)(tok0 + 2 * rt + par) * PP + C_QI + head * 64 + 16 * s + 8 * hf); }
        if (tid < 256) WL[tid] = WIf[(size_t)tok0 * 16 + tid];
        __syncthreads();
        const int ntile = n_adm >> 5, npass = (ntile + 63) >> 6;
        for (int p = 0; p < npass; ++p) {
            bf16x8_t Bf[8][4];
#pragma unroll
            for (int kt = 0; kt < 8; ++kt) { const int tile = p * 64 + kt * 8 + wave;
                const int tcl = tile < ntile ? tile : ntile - 1;
                const bf16raw* kp = KI + (size_t)(b * SEQ + tcl * 32 + r32) * 64 + 8 * hi;
#pragma unroll
                for (int s = 0; s < 4; ++s) Bf[kt][s] = *(const bf16x8_t*)(kp + 16 * s); }
            const int tile0 = p * 64 + wave; const bool full = tile0 + 56 < ntile;
#pragma unroll 1
            for (int rt = 0; rt < 8; ++rt) {
                bf16x8_t Af[4];
#pragma unroll
                for (int s = 0; s < 4; ++s) Af[s] = *(const LAS bf16x8_t*)(lds + ((rt * 4 + s) * 64 + lane) * 16);
                f32x4_t wv[4];
#pragma unroll
                for (int e = 0; e < 4; ++e) wv[e] = *(const LAS f32x4_t*)(WL + (2 * rt + hi) * 16 + 4 * e);
                unsigned* srow = (unsigned*)scratch + (2 * rt + hi) * 8192 + r32;
                if (full) idx_rt_block<true>(Bf, Af, wv, srow, tile0, ntile); else idx_rt_block<false>(Bf, Af, wv, srow, tile0, ntile);
            }
        }
        __syncthreads();
        const int nj = n_adm >> 6;
#pragma unroll 1
        for (int qq = 2 * wave; qq < 2 * wave + 2; ++qq) {
            const unsigned* sc = (const unsigned*)scratch + qq * 8192; unsigned long long* mrow = MASK + (size_t)(tok0 + qq) * 128;
            int njq = nj; asm volatile("" : "+s"(njq));
            if (njq <= 16) idx_select<16>(sc, njq, wend, mrow, hist, list, lane);
            else if (njq <= 32) idx_select<32>(sc, njq, wend, mrow, hist, list, lane);
            else if (njq <= 64) idx_select<64>(sc, njq, wend, mrow, hist, list, lane);
            else idx_select<128>(sc, njq, wend, mrow, hist, list, lane);
        }
        __syncthreads();
    }
}

__device__ __forceinline__ attn::BlockRef<attn::bf16, attn::bf16> att_ref(unsigned char* ws, int bi) {
    const int G_ = (int)gridDim.x, bx_ = (int)blockIdx.x, vg = (G_ % 8 == 0) ? (bx_ & 7) * (G_ >> 3) + (bx_ >> 3) : bx_;
    const int item = vg + (bi >> 1) * G_, bh = item >> 4, pr = item & 15, qb = (bi & 1) ? 31 - pr : pr, b = bh >> 3, h = bh & 7;
    attn::bf16* proj = (attn::bf16*)(ws + WS_PROJ); const size_t tokb = (size_t)b * SEQ;
    attn::BlockRef<attn::bf16, attn::bf16> r;
    r.Q = proj + (tokb + qb * 256) * PP + C_Q + h * 128; r.K = proj + tokb * PP + C_K + h * 128; r.V = proj + tokb * PP + C_V + h * 128;
    r.O = proj + (tokb + qb * 256) * PP + C_Q + h * 128; r.MK = (const unsigned long long*)(ws + WS_MASK) + (tokb + qb * 256) * 128; r.P0 = qb * 256;
    return r;
}
__device__ __forceinline__ void attn_phase(unsigned char* ws, char* lds) {
    const int nitems = (int)blockIdx.x < 512 ? (512 - (int)blockIdx.x + (int)gridDim.x - 1) / (int)gridDim.x : 0, nb = 2 * nitems;
    if (nb == 0) return;
    attn::Seam<attn::bf16> S;
    { const auto r0 = att_ref(ws, 0); attn::causal_swa_prime<attn::bf16, attn::bf16>(r0, SEQ, lds, S); }
    for (int bi = 0; bi < nb; ++bi) {
        const auto cur = att_ref(ws, bi); const auto nxt = att_ref(ws, bi + 1 < nb ? bi + 1 : bi);
        attn::causal_swa_block<attn::bf16, attn::bf16>(cur, nxt, SEQ, SEQ, lds, S);
    }
}

#define XB_TMO      128
#define XB_XCNT(j)  (256  + 64 * (j))
#define XB_XSUB(j)  (1280 + 64 * (j))
#define XB_XGEN(j)  (2304 + 64 * (j))
#define XB_TOP      3328
#define XB_TOPGEN   3392
#define XB_SPIN_CAP (1u << 18)

__device__ __forceinline__ unsigned xb_ld(unsigned* p)              { return __hip_atomic_load(p, __ATOMIC_RELAXED, __HIP_MEMORY_SCOPE_AGENT); }
__device__ __forceinline__ unsigned xb_add(unsigned* p, unsigned v) { return __hip_atomic_fetch_add(p, v, __ATOMIC_RELAXED, __HIP_MEMORY_SCOPE_AGENT); }
__device__ __forceinline__ unsigned xb_xcc_id() { return (unsigned)__builtin_amdgcn_s_getreg((3 << 11) | 20) & 0xFu; }
#define XB_SPIN(cond, bar) do { unsigned _sp = 0; while (cond) { __builtin_amdgcn_s_sleep(1); \
    if ((++_sp & 255u) == 0u) { if (xb_ld(&(bar)[XB_TMO])) break; if (_sp > XB_SPIN_CAP) { atomicAdd(&(bar)[XB_TMO], 1u); break; } } } } while (0)

struct XcdBarrier {
    unsigned* bar; unsigned x;
    volatile LAS unsigned* st;
};

__device__ __forceinline__ XcdBarrier xcd_barrier_post(unsigned* bar, volatile LAS unsigned* st) {
    XcdBarrier b; b.bar = bar; b.x = xb_xcc_id(); b.st = st;
    if (threadIdx.x == 0) (void)xb_add(&bar[XB_XCNT(b.x)], 1u);
    return b;
}
__device__ __forceinline__ void xcd_barrier_complete(unsigned* bar, unsigned x, unsigned& nloc, unsigned& nx) {
    const unsigned G = gridDim.x * gridDim.y * gridDim.z;
    unsigned sum, cnt, mine, sp = 0u;
    for (;;) {
        sum = 0u; cnt = 0u; mine = 0u;
#pragma unroll
        for (unsigned j = 0; j < 16; ++j) { const unsigned c = xb_ld(&bar[XB_XCNT(j)]); sum += c; cnt += (c > 0u) ? 1u : 0u; mine = (j == x) ? c : mine; }
        if (sum == G) break;
        __builtin_amdgcn_s_sleep(1);
        if ((++sp & 255u) == 0u) { if (xb_ld(&bar[XB_TMO])) break; if (sp > XB_SPIN_CAP) { atomicAdd(&bar[XB_TMO], 1u); break; } }
    }
    nloc = mine > 0u ? mine : 1u; nx = cnt > 0u ? cnt : 1u;
}

__device__ __forceinline__ void xcd_barrier(const XcdBarrier& b) {
    asm volatile("s_waitcnt vmcnt(0)" ::: "memory");
    __syncthreads();
    if (threadIdx.x == 0) {
        unsigned* bar = b.bar;
        __builtin_amdgcn_s_waitcnt(0);
        unsigned nloc = b.st[0], nx = b.st[1];
        if (nloc == 0u) { xcd_barrier_complete(bar, b.x, nloc, nx); b.st[0] = nloc; b.st[1] = nx; }
        const unsigned old = xb_add(&bar[XB_XSUB(b.x)], 1u);
        const unsigned gen = old / nloc;
        if (old + 1u == (gen + 1u) * nloc) {
            __builtin_amdgcn_fence(__ATOMIC_RELEASE, "agent");
            asm volatile("s_waitcnt vmcnt(0)" ::: "memory");
            const unsigned og = xb_add(&bar[XB_TOP], 1u);
            const unsigned tg = og / nx;
            if (og + 1u == (tg + 1u) * nx) xb_add(&bar[XB_TOPGEN], 1u);
            else XB_SPIN(xb_ld(&bar[XB_TOPGEN]) == tg, bar);
            __builtin_amdgcn_fence(__ATOMIC_ACQUIRE, "agent");
            xb_add(&bar[XB_XGEN(b.x)], 1u);
            asm volatile("s_waitcnt vmcnt(0)" ::: "memory");
        } else {
            XB_SPIN(xb_ld(&bar[XB_XGEN(b.x)]) == gen, bar);
            __builtin_amdgcn_fence(__ATOMIC_ACQUIRE, "agent");
            asm volatile("s_waitcnt vmcnt(0)" ::: "memory");
        }
    }
    __syncthreads();
}

__global__ void __launch_bounds__(NTHR, 2) fwd_kernel(Params P) {
    extern __shared__ __attribute__((aligned(16))) unsigned char lds_raw[];
    cg::grid_group grid = cg::this_grid();
    LAS unsigned char* lds = (LAS unsigned char*)lds_raw;
    const int tid = threadIdx.x, lane = tid & 63, wave = __builtin_amdgcn_readfirstlane(tid >> 6);
    const int gw = blockIdx.x * NWAVES + wave, ngw = gridDim.x * NWAVES;
    unsigned char* ws = P.ws;
    bf16raw* XN = (bf16raw*)(ws + WS_XN); bf16raw* PROJ = (bf16raw*)(ws + WS_PROJ); bf16raw* HB = PROJ;
    float* out = P.out; float* SS1 = (float*)(ws + WS_SS1); float* SS2 = SS1 + MTOK;

    volatile LAS unsigned* bst = (volatile LAS unsigned*)(lds + LDS_BYTES - 64);
    if (tid == 0) { bst[0] = 0u; bst[1] = 0u; }
    __syncthreads();
    p0_prologue(P, lds, tid, lane, wave);
    grid.sync();
    const XcdBarrier xbar = xcd_barrier_post((unsigned*)(ws + WS_CTL) + CW_BAR, bst);
#define GSYNC() xcd_barrier(xbar)
    { pg8::EpiSwiglu E{HB, DFF, nullptr}; run_gemm(lds, XN, DM, (const bf16raw*)(ws + WS_WGU1), DM, 2 * DFF, DM, E); }
    GSYNC();
    { pg8::EpiResid<false, false, true> E{P.in[0], nullptr, DM, 0.5f, XN, SS1}; run_gemm(lds, HB, DFF, (const bf16raw*)(ws + WS_WD1), DFF, DM, DFF, E); }
    GSYNC();
    { pg8::EpiStore E{PROJ, PP, SS1}; run_gemm(lds, XN, DM, (const bf16raw*)(ws + WS_WIN), DM, PP, DM, E); }
    GSYNC();
    for (int m = gw; m < MTOK; m += ngw) prep_token(P, m, lane);
    GSYNC();
    sgu_phase(P, lds, tid, lane, wave);
    indexer_phase(P, lds, tid, lane, wave);
    GSYNC();
    attn_phase(ws, (char*)lds_raw);
    GSYNC();
    { pg8::EpiGate<1> E{PROJ + C_GA, PROJ + C_GA, PP}; run_gemm(lds, PROJ + C_Q, PP, (const bf16raw*)(ws + WS_WUA), 1024, DM, 1024, E); }
    { pg8::EpiGate<2> E{PROJ + C_GB, PROJ + C_GA, PP}; run_gemm(lds, PROJ + C_U, PP, (const bf16raw*)(ws + WS_WUS), 1024, DM, 1024, E); }
    GSYNC();
    { pg8::EpiResid<true, false, true> E{XN, nullptr, DM, 1.0f, XN, SS2}; run_gemm(lds, PROJ + C_GA, PP, (const bf16raw*)(ws + WS_WOUT), DM, DM, DM, E); }
    GSYNC();
    { pg8::EpiSwiglu E{HB, DFF, SS2}; run_gemm(lds, XN, DM, (const bf16raw*)(ws + WS_WGU2), DM, 2 * DFF, DM, E); }
    GSYNC();
    { pg8::EpiResid<true, true, false> E{XN, out, DM, 0.5f, nullptr, nullptr}; run_gemm(lds, HB, DFF, (const bf16raw*)(ws + WS_WD2), DFF, DM, DFF, E); }
}

extern "C" void kernel_launch(void* const* d_in, const int* in_sizes, int n_in, void* d_out, int out_size, void* d_ws, size_t ws_size, hipStream_t stream) {
    static int grid = 0;
    if (grid == 0) {
        if (n_in != 21 || ws_size < WS_END) { fprintf(stderr, "kernel_launch: unexpected n_in %d / ws %zu\n", n_in, ws_size); grid = -1; return; }
        int dev = 0, cus = 0, per_cu = 0;
        (void)hipGetDevice(&dev); (void)hipDeviceGetAttribute(&cus, hipDeviceAttributeMultiprocessorCount, dev);
        if (hipFuncSetAttribute((const void*)fwd_kernel, hipFuncAttributeMaxDynamicSharedMemorySize, LDS_BYTES) != hipSuccess) fprintf(stderr, "kernel_launch: hipFuncSetAttribute failed\n");
        if (hipOccupancyMaxActiveBlocksPerMultiprocessor(&per_cu, (const void*)fwd_kernel, NTHR, LDS_BYTES) != hipSuccess || per_cu < 1) fprintf(stderr, "kernel_launch: occupancy query says %d\n", per_cu);
        (void)hipGetLastError();
        grid = cus > 256 ? 256 : cus; if (grid < 1) grid = 256;
    }
    if (grid < 0) return;
    Params p{};
    for (int i = 0; i < 21; ++i) p.in[i] = (const float*)d_in[i];
    p.out = (float*)d_out; p.ws = (unsigned char*)d_ws;
    void* args[] = {&p};
    const hipError_t e = hipLaunchCooperativeKernel((const void*)fwd_kernel, dim3(grid), dim3(NTHR), args, LDS_BYTES, stream);
    if (e != hipSuccess) fprintf(stderr, "cooperative launch failed: %s (grid %d)\n", hipGetErrorString(e), grid);
}
```

```cpp
#include <hip/hip_runtime.h>
#include <hip/hip_cooperative_groups.h>
#include <hip/hip_bf16.h>
#include <cstdio>
#include <cstdint>
#include <cmath>
namespace cg = cooperative_groups;

constexpr int BATCH = 4, SEQ = 8192, DM = 2048, MTOK = BATCH * SEQ, DFF = 5632;
constexpr int PP = 10496;
constexpr int C_Q = 0, C_K = 1024, C_V = 2048, C_QI = 3072, C_KI = 4096, C_WI = 4160, C_U = 4352, C_VS = 5376, C_GA = 6400, C_GB = 8448;
constexpr float EPS = 1e-6f;
constexpr int NWAVES = 8, NTHR = 512;
constexpr size_t MiB = 1u << 20;
constexpr size_t WS_CTL = 0, WS_SS1 = 256 * 1024  , WS_WSB = 1 * MiB, WS_KI = 2 * MiB, WS_WI = 6 * MiB, WS_WGU1 = 8 * MiB, WS_WD1 = 52 * MiB, WS_WGU2 = 74 * MiB, WS_WD2 = 118 * MiB,
                 WS_WIN = 140 * MiB, WS_WUA = 181 * MiB, WS_WUS = 185 * MiB, WS_WOUT = 189 * MiB, WS_MASK = 197 * MiB, WS_XN = 229 * MiB, WS_PROJ = 357 * MiB, WS_END = 1013 * MiB;
static_assert(WS_PROJ + (size_t)MTOK * PP * 2 <= WS_END && WS_XN + (size_t)MTOK * DM * 2 <= WS_PROJ && WS_MASK + (size_t)MTOK * 128 * 8 <= WS_XN, "ws map");
constexpr int LDS_BYTES = 147456;

typedef unsigned short bf16raw;
typedef unsigned u32x4_t __attribute__((ext_vector_type(4)));
typedef unsigned u32x2_t __attribute__((ext_vector_type(2)));
typedef float f32x4_t __attribute__((ext_vector_type(4)));
typedef float f32x16_t __attribute__((ext_vector_type(16)));
typedef short bf16x8_t __attribute__((ext_vector_type(8)));
#define LAS __attribute__((address_space(3)))

__device__ __forceinline__ float bf2f(unsigned short b) { return __uint_as_float((unsigned)b << 16); }
__device__ __forceinline__ float bflo(unsigned w) { return __uint_as_float(w << 16); }
__device__ __forceinline__ float bfhi(unsigned w) { return __uint_as_float(w & 0xffff0000u); }
__device__ __forceinline__ unsigned pkbf(float lo, float hi) { unsigned r; asm volatile("v_cvt_pk_bf16_f32 %0, %1, %2" : "=v"(r) : "v"(lo), "v"(hi)); return r; }
__device__ __forceinline__ float fast_sigmoid(float x) { return __builtin_amdgcn_rcpf(1.0f + __builtin_amdgcn_exp2f(-1.4426950408889634f * x)); }
__device__ __forceinline__ float silu_f(float x) { return x * fast_sigmoid(x); }
__device__ __forceinline__ float gelu_tanh_f(float x) { const float z2 = 1.5957691216057308f * (x + 0.044715f * x * x * x); return x * fast_sigmoid(z2); }
__device__ __forceinline__ float wave_sum(float v) {
#pragma unroll
    for (int o = 1; o < 64; o <<= 1) v += __shfl_xor(v, o);
    return v;
}
namespace pg8 {
#define PG8_LAS __attribute__((address_space(3)))
typedef unsigned short bf16_t;
typedef short bf16x8 __attribute__((ext_vector_type(8)));
typedef float f32x4 __attribute__((ext_vector_type(4)));
typedef unsigned u32x4 __attribute__((ext_vector_type(4)));
constexpr int BM = 256, BK = 64, HALF = 128, HTB = HALF * BK * 2  , STAGE_BYTES = 8 * HTB, NXCD = 8, WGM = 8;

__host__ __device__ __forceinline__ int lds_byte(int r, int c) { const int st = (r >> 4) * 2 + (c >> 5), rr = r & 15, cc = c & 31, ob = rr * 64 + cc * 2; return st * 1024 + (ob ^ (((ob >> 9) & 1) << 5)); }
__host__ __device__ __forceinline__ void stage_rc(int b, int& R, int& C) { const int st = b / 1024, sb = b % 1024, swz = sb ^ (((sb >> 9) & 1) << 5); R = (st >> 1) * 16 + swz / 64; C = (st & 1) * 32 + (swz % 64) / 2; }
__host__ __device__ __forceinline__ int perm32(int rho) { const int n = rho >> 4, i = rho & 15; return 8 * (i >> 2) + 4 * n + (i & 3); }

struct Unit { int pm, pn; };
struct Gemm { const bf16_t* A; const bf16_t* Bt; int M, N, K, lda, ldb; };

struct StaticOrder {
    int nM, nN, nwg, G, c, wgm;
    __host__ __device__ void init(int M, int N, int G_, int c_) { nM = M / BM; nN = N / BM; nwg = nM * nN; G = G_; c = c_; wgm = nN <= 8 ? 4 : WGM; }
    __host__ __device__ bool next(int i, Unit& u) const {
        const long L = (long)i * G + c; if (L >= nwg) return false;
        int wgid = (int)L; { const int q = nwg / NXCD, r = nwg % NXCD, xcd = wgid % NXCD, off = wgid / NXCD; wgid = (xcd < r ? xcd * (q + 1) : r * (q + 1) + (xcd - r) * q) + off; }
        const int nig = wgm * nN, gid = wgid / nig, fm = gid * wgm, gsz = (nM - fm) < wgm ? (nM - fm) : wgm;
        u.pm = fm + ((wgid % nig) % gsz); u.pn = (wgid % nig) / gsz; return true;
    }
    __device__ __forceinline__ void a_ready(const Unit&) const {}
    __device__ __forceinline__ void done(const Unit&) const {}
};

__device__ __forceinline__ unsigned cvt_pk_bf16(float lo, float hi) { unsigned r; asm volatile("v_cvt_pk_bf16_f32 %0, %1, %2" : "=v"(r) : "v"(lo), "v"(hi)); return r; }
typedef float f32x2 __attribute__((ext_vector_type(2)));

__device__ __forceinline__ float sigm(float x) { return __builtin_amdgcn_rcpf(1.0f + __builtin_amdgcn_exp2f(-1.4426950408889634f * x)); }
struct EpiStore {
    static constexpr bool PERM = true, AFTER_DRAIN = false;
    bf16_t* O; int ldc; const float* ss;
    __device__ __forceinline__ void operator()(const f32x4 (&acc)[2][2][4][2], const Unit& u, int wr, int wc, int fr, int fq) const {
        const int row0 = u.pm * BM + wr * 64 + fr, col0 = u.pn * BM + wc * 32 + 8 * fq;
#pragma unroll
        for (int ai = 0; ai < 2; ++ai)
#pragma unroll
            for (int m = 0; m < 4; ++m) { bf16_t* rowp = O + (size_t)(row0 + ai * HALF + m * 16) * ldc + col0;
                const float rs = ss ? __builtin_amdgcn_rsqf(ss[row0 + ai * HALF + m * 16] * (1.0f / 2048.0f) + 1e-6f) : 1.0f;
#pragma unroll
                for (int bj = 0; bj < 2; ++bj) { const f32x4 v0 = acc[ai][bj][m][0] * rs, v1 = acc[ai][bj][m][1] * rs;
                    u32x4 w; w.x = cvt_pk_bf16(v0[0], v0[1]); w.y = cvt_pk_bf16(v0[2], v0[3]); w.z = cvt_pk_bf16(v1[0], v1[1]); w.w = cvt_pk_bf16(v1[2], v1[3]);
                    *(u32x4*)(rowp + bj * HALF) = w; } }
    }
};
struct EpiSwiglu {
    static constexpr bool PERM = true, AFTER_DRAIN = false;
    bf16_t* H; int ldc; const float* ss;
    __device__ __forceinline__ void operator()(const f32x4 (&acc)[2][2][4][2], const Unit& u, int wr, int wc, int fr, int fq) const {
        const int row0 = u.pm * BM + wr * 64 + fr, col0 = u.pn * HALF + wc * 32 + 8 * fq;
#pragma unroll
        for (int ai = 0; ai < 2; ++ai)
#pragma unroll
            for (int m = 0; m < 4; ++m) { bf16_t* rowp = H + (size_t)(row0 + ai * HALF + m * 16) * ldc + col0;
                const float rs = ss ? __builtin_amdgcn_rsqf(ss[row0 + ai * HALF + m * 16] * (1.0f / 2048.0f) + 1e-6f) : 1.0f;
                float h[8];
#pragma unroll
                for (int n = 0; n < 2; ++n)
#pragma unroll
                    for (int j = 0; j < 4; ++j) { const float g = acc[ai][0][m][n][j] * rs, up = acc[ai][1][m][n][j] * rs; h[n * 4 + j] = g * sigm(g) * up; }
                u32x4 w; w.x = cvt_pk_bf16(h[0], h[1]); w.y = cvt_pk_bf16(h[2], h[3]); w.z = cvt_pk_bf16(h[4], h[5]); w.w = cvt_pk_bf16(h[6], h[7]);
                *(u32x4*)rowp = w; }
    }
};
template <bool BASEBF, bool OUTF32, bool OUTBF> struct EpiResid {
    static constexpr bool PERM = true, AFTER_DRAIN = false;
    const void* base; float* out; int ldc; float alpha; bf16_t* xb; float* ss;
    __device__ __forceinline__ void operator()(const f32x4 (&acc)[2][2][4][2], const Unit& u, int wr, int wc, int fr, int fq) const {
        const int row0 = u.pm * BM + wr * 64 + fr, col0 = u.pn * BM + wc * 32 + 8 * fq;
#pragma unroll
        for (int ai = 0; ai < 2; ++ai)
#pragma unroll
            for (int m = 0; m < 4; ++m) { const size_t off = (size_t)(row0 + ai * HALF + m * 16) * ldc + col0; float sq = 0.f;
#pragma unroll
                for (int bj = 0; bj < 2; ++bj) { f32x4 b0, b1;
                    if (BASEBF) { const u32x4 w = *(const u32x4*)((const bf16_t*)base + off + bj * HALF);
                        b0 = (f32x4){__uint_as_float(w.x << 16), __uint_as_float(w.x & 0xffff0000u), __uint_as_float(w.y << 16), __uint_as_float(w.y & 0xffff0000u)};
                        b1 = (f32x4){__uint_as_float(w.z << 16), __uint_as_float(w.z & 0xffff0000u), __uint_as_float(w.w << 16), __uint_as_float(w.w & 0xffff0000u)}; }
                    else { b0 = *(const f32x4*)((const float*)base + off + bj * HALF); b1 = *(const f32x4*)((const float*)base + off + bj * HALF + 4); }
                    const f32x4 o0 = b0 + acc[ai][bj][m][0] * alpha, o1 = b1 + acc[ai][bj][m][1] * alpha;
                    if (OUTF32) { *(f32x4*)(out + off + bj * HALF) = o0; *(f32x4*)(out + off + bj * HALF + 4) = o1; }
                    if (OUTBF) { sq += ((o0[0] * o0[0] + o0[1] * o0[1]) + (o0[2] * o0[2] + o0[3] * o0[3])) + ((o1[0] * o1[0] + o1[1] * o1[1]) + (o1[2] * o1[2] + o1[3] * o1[3]));
                        u32x4 w; w.x = cvt_pk_bf16(o0[0], o0[1]); w.y = cvt_pk_bf16(o0[2], o0[3]); w.z = cvt_pk_bf16(o1[0], o1[1]); w.w = cvt_pk_bf16(o1[2], o1[3]); *(u32x4*)(xb + off + bj * HALF) = w; } }
                if (OUTBF) { sq += __shfl_xor(sq, 16); sq += __shfl_xor(sq, 32); if (fq == 0) atomicAdd(ss + row0 + ai * HALF + m * 16, sq); } }
    }
};
template <int MODE> struct EpiGate {
    static constexpr bool PERM = true, AFTER_DRAIN = false;
    const bf16_t* G; bf16_t* T; int ldc;
    __device__ __forceinline__ void operator()(const f32x4 (&acc)[2][2][4][2], const Unit& u, int wr, int wc, int fr, int fq) const {
        const int row0 = u.pm * BM + wr * 64 + fr, col0 = u.pn * BM + wc * 32 + 8 * fq;
#pragma unroll
        for (int ai = 0; ai < 2; ++ai)
#pragma unroll
            for (int m = 0; m < 4; ++m) { const size_t off = (size_t)(row0 + ai * HALF + m * 16) * ldc + col0;
#pragma unroll
                for (int bj = 0; bj < 2; ++bj) { const u32x4 gw = *(const u32x4*)(G + off + bj * HALF); u32x4 tw = {0u, 0u, 0u, 0u}; if (MODE == 2) tw = *(const u32x4*)(T + off + bj * HALF);
                    float o[8];
#pragma unroll
                    for (int e = 0; e < 4; ++e) { const unsigned g2 = gw[e], t2 = tw[e]; const int n = e >> 1, j = (e & 1) * 2;
                        float a0 = sigm(__uint_as_float(g2 << 16)) * acc[ai][bj][m][n][j], a1 = sigm(__uint_as_float(g2 & 0xffff0000u)) * acc[ai][bj][m][n][j + 1];
                        if (MODE == 2) { a0 += __uint_as_float(t2 << 16); a1 += __uint_as_float(t2 & 0xffff0000u); }
                        o[2 * e] = a0; o[2 * e + 1] = a1; }
                    u32x4 w; w.x = cvt_pk_bf16(o[0], o[1]); w.y = cvt_pk_bf16(o[2], o[3]); w.z = cvt_pk_bf16(o[4], o[5]); w.w = cvt_pk_bf16(o[6], o[7]);
                    *(u32x4*)(T + off + bj * HALF) = w; } }
    }
};
template <class Epi, class Sched, bool ALIGN_EPI = false, bool SP2 = false>
__device__ __forceinline__ void gemm_phase(PG8_LAS unsigned char* lds, const Gemm g, const Sched& S, const Epi& E) {
    int tid_o = threadIdx.x; asm volatile("" : "+v"(tid_o));
    const int tid = tid_o, wid = __builtin_amdgcn_readfirstlane(tid >> 6), lane = tid & 63, wr = wid >> 2, wc = wid & 3, fr = lane & 15, fq = lane >> 4;
    const int K = g.K, nt = K / BK;
    unsigned voffA[2], voffB[2];
#pragma unroll
    for (int i = 0; i < 2; ++i) { int R, C; stage_rc(tid * 16 + i * 8192, R, C); const int Rb = Epi::PERM ? ((R & ~31) + perm32(R & 31)) : R;
        voffA[i] = (unsigned)(R * g.lda + C) * 2u; voffB[i] = (unsigned)(Rb * g.ldb + C) * 2u; }
    const size_t kstep = (size_t)(BK * 2);
    const size_t hstepA = (size_t)HALF * g.lda * 2, hstepB = (size_t)HALF * g.ldb * 2;
    const size_t tstepA = 2 * hstepA, tstepB = 2 * hstepB;
    const unsigned ldsw = (unsigned)wid * 1024u;
    const int aoff = lds_byte(wr * 64 + fr, fq * 8), boff = lds_byte(wc * 32 + fr, fq * 8);
#define PG8_SA(b, h) (((b) * 2 + (h)) * HTB)
#define PG8_SB(b, h) ((4 + (b) * 2 + (h)) * HTB)
#define PG8_STAGE(bufoff, gbase, voff) do { _Pragma("unroll") for (int _i = 0; _i < 2; ++_i) \
        __builtin_amdgcn_global_load_lds((const unsigned*)((const char*)(gbase) + (voff)[_i]), (PG8_LAS unsigned*)(lds + (bufoff) + ldsw + _i * 8192), 16, 0, 0); } while (0)
#define PG8_LDA(dst, b, h) do { _Pragma("unroll") for (int m = 0; m < 4; ++m) _Pragma("unroll") for (int k = 0; k < 2; ++k) dst[m][k] = *(const PG8_LAS bf16x8*)(lds + PG8_SA(b, h) + aoff + m * 2048 + k * 1024); } while (0)
#define PG8_LDB(dst, b, h) do { _Pragma("unroll") for (int n = 0; n < 2; ++n) _Pragma("unroll") for (int k = 0; k < 2; ++k) dst[n][k] = *(const PG8_LAS bf16x8*)(lds + PG8_SB(b, h) + boff + n * 2048 + k * 1024); } while (0)
#define PG8_MMA(ai, bj, At, Bt) do { __builtin_amdgcn_s_setprio(1); _Pragma("unroll") for (int m = 0; m < 4; ++m) _Pragma("unroll") for (int n = 0; n < 2; ++n) _Pragma("unroll") for (int k = 0; k < 2; ++k) \
        acc[ai][bj][m][n] = __builtin_amdgcn_mfma_f32_16x16x32_bf16(Bt[n][k], At[m][k], acc[ai][bj][m][n], 0, 0, 0); __builtin_amdgcn_s_setprio(0); } while (0)
#define PG8_WAIT_V(n) asm volatile("s_waitcnt vmcnt(" #n ")" ::: "memory")
#define PG8_WAIT_L(n) asm volatile("s_waitcnt lgkmcnt(" #n ")" ::: "memory")
#define PG8_BAR __builtin_amdgcn_s_barrier()
#define PG8_SCHED __builtin_amdgcn_sched_barrier(0)
    Unit cur, nxt; int ui = 0;
    if (!S.next(0, cur)) return;
    f32x4 acc[2][2][4][2];
#pragma unroll
    for (int a = 0; a < 2; ++a)
#pragma unroll
        for (int b = 0; b < 2; ++b)
#pragma unroll
            for (int m = 0; m < 4; ++m)
#pragma unroll
                for (int n = 0; n < 2; ++n) acc[a][b][m][n] = (f32x4){0.f, 0.f, 0.f, 0.f};
    bf16x8 At[4][2], B0[2][2], B1[2][2];
    const char* cA = (const char*)g.A + (size_t)cur.pm * tstepA; const char* cB = (const char*)g.Bt + (size_t)cur.pn * tstepB;
    S.a_ready(cur);
    if constexpr (SP2) {
        PG8_STAGE(PG8_SB(0, 0), cB, voffB); PG8_STAGE(PG8_SB(0, 1), cB + hstepB, voffB); PG8_STAGE(PG8_SA(0, 0), cA, voffA); PG8_STAGE(PG8_SA(0, 1), cA + hstepA, voffA);
        if (wr == 1) PG8_BAR;
        PG8_WAIT_V(2); PG8_BAR;
        PG8_STAGE(PG8_SB(1, 0), cB + kstep, voffB); PG8_STAGE(PG8_SA(1, 0), cA + kstep, voffA); PG8_STAGE(PG8_SB(1, 1), cB + hstepB + kstep, voffB);
        PG8_WAIT_V(6); PG8_BAR;
    } else {
        PG8_STAGE(PG8_SB(0, 0), cB, voffB); PG8_STAGE(PG8_SA(0, 0), cA, voffA); PG8_STAGE(PG8_SB(0, 1), cB + hstepB, voffB); PG8_STAGE(PG8_SA(0, 1), cA + hstepA, voffA);
        if (wr == 1) PG8_BAR;
        PG8_WAIT_V(4); PG8_BAR;
        PG8_STAGE(PG8_SB(1, 0), cB + kstep, voffB); PG8_STAGE(PG8_SA(1, 0), cA + kstep, voffA); PG8_STAGE(PG8_SB(1, 1), cB + hstepB + kstep, voffB);
        PG8_WAIT_V(6); PG8_BAR;
    }
    for (;;) {
        const bool has_next = S.next(ui + 1, nxt);
        const char* nA = has_next ? (const char*)g.A + (size_t)nxt.pm * tstepA : cA; const char* nB = has_next ? (const char*)g.Bt + (size_t)nxt.pn * tstepB : cB;
        for (int t = 0; t < nt; t += 2) {
            const bool last = (t == nt - 2);
            const char* a1 = cA + (size_t)(t + 1) * kstep;
            const char* a2 = last ? nA : cA + (size_t)(t + 2) * kstep; const char* b2 = last ? nB : cB + (size_t)(t + 2) * kstep;
            const char* a3 = a2 + kstep; const char* b3 = b2 + kstep;
            if (last && has_next) S.a_ready(nxt);
            if constexpr (SP2) {
            PG8_LDB(B0, 0, 0); PG8_LDB(B1, 0, 1); PG8_SCHED; PG8_LDA(At, 0, 0); PG8_STAGE(PG8_SA(1, 1), a1 + hstepA, voffA);
            PG8_WAIT_V(8); PG8_WAIT_L(0); PG8_BAR; PG8_MMA(0, 0, At, B0); PG8_MMA(0, 1, At, B1); PG8_BAR; PG8_SCHED;
            PG8_LDA(At, 0, 1); PG8_STAGE(PG8_SB(0, 0), b2, voffB); PG8_STAGE(PG8_SB(0, 1), b2 + hstepB, voffB); PG8_STAGE(PG8_SA(0, 0), a2, voffA);
            PG8_WAIT_V(8); PG8_WAIT_L(0); PG8_BAR; PG8_MMA(1, 0, At, B0); PG8_MMA(1, 1, At, B1); PG8_BAR; PG8_SCHED;
            PG8_LDB(B0, 1, 0); PG8_LDB(B1, 1, 1); PG8_SCHED; PG8_LDA(At, 1, 0); PG8_STAGE(PG8_SA(0, 1), a2 + hstepA, voffA);
            PG8_WAIT_V(8); PG8_WAIT_L(0); PG8_BAR; PG8_MMA(0, 0, At, B0); PG8_MMA(0, 1, At, B1); PG8_BAR; PG8_SCHED;
            PG8_LDA(At, 1, 1); PG8_STAGE(PG8_SB(1, 0), b3, voffB); PG8_STAGE(PG8_SB(1, 1), b3 + hstepB, voffB); PG8_STAGE(PG8_SA(1, 0), a3, voffA);
            PG8_WAIT_V(8); PG8_WAIT_L(0); PG8_BAR; PG8_MMA(1, 0, At, B0); PG8_MMA(1, 1, At, B1); PG8_BAR; PG8_SCHED;
            } else {
            PG8_LDB(B0, 0, 0); PG8_SCHED; PG8_LDA(At, 0, 0); PG8_STAGE(PG8_SA(1, 1), a1 + hstepA, voffA);
            PG8_WAIT_L(8); PG8_BAR; PG8_WAIT_L(0); PG8_MMA(0, 0, At, B0); PG8_BAR; PG8_SCHED;
            PG8_LDB(B1, 0, 1); PG8_STAGE(PG8_SB(0, 0), b2, voffB);
            PG8_BAR; PG8_WAIT_L(0); PG8_MMA(0, 1, At, B1); PG8_BAR;
            PG8_LDA(At, 0, 1); PG8_STAGE(PG8_SA(0, 0), a2, voffA);
            PG8_BAR; PG8_WAIT_L(0); PG8_MMA(1, 0, At, B0); PG8_BAR; PG8_SCHED;
            PG8_STAGE(PG8_SB(0, 1), b2 + hstepB, voffB);
            PG8_WAIT_V(6); PG8_BAR; PG8_MMA(1, 1, At, B1); PG8_BAR;
            PG8_LDB(B0, 1, 0); PG8_SCHED; PG8_LDA(At, 1, 0); PG8_STAGE(PG8_SA(0, 1), a2 + hstepA, voffA);
            PG8_WAIT_L(8); PG8_BAR; PG8_WAIT_L(0); PG8_MMA(0, 0, At, B0); PG8_BAR; PG8_SCHED;
            PG8_LDB(B1, 1, 1); PG8_STAGE(PG8_SB(1, 0), b3, voffB);
            PG8_BAR; PG8_WAIT_L(0); PG8_MMA(0, 1, At, B1); PG8_BAR;
            PG8_LDA(At, 1, 1); PG8_STAGE(PG8_SA(1, 0), a3, voffA);
            PG8_BAR; PG8_WAIT_L(0); PG8_MMA(1, 0, At, B0); PG8_BAR; PG8_SCHED;
            PG8_STAGE(PG8_SB(1, 1), b3 + hstepB, voffB);
            PG8_WAIT_V(6); PG8_BAR; PG8_MMA(1, 1, At, B1); PG8_BAR;
            }
        }
        if constexpr (ALIGN_EPI) { if (wr == 0) PG8_BAR; }
        if constexpr (!Epi::AFTER_DRAIN) { E(acc, cur, wr, wc, fr, fq); S.done(cur); }
        if (!has_next) break;
#pragma unroll
        for (int a = 0; a < 2; ++a)
#pragma unroll
            for (int b = 0; b < 2; ++b)
#pragma unroll
                for (int m = 0; m < 4; ++m)
#pragma unroll
                    for (int n = 0; n < 2; ++n) acc[a][b][m][n] = (f32x4){0.f, 0.f, 0.f, 0.f};
        cur = nxt; cA = nA; cB = nB; ++ui;
        if constexpr (ALIGN_EPI) { if (wr == 1) PG8_BAR; }
    }
    PG8_WAIT_V(0);
    if constexpr (!ALIGN_EPI) { if (wr == 0) PG8_BAR; }
    PG8_BAR;
    if constexpr (Epi::AFTER_DRAIN) { E.fused(acc, cur, wr, wc, fr, fq, lds, wid, lane); S.done(cur); }
#undef PG8_SA
#undef PG8_SB
#undef PG8_STAGE
#undef PG8_LDA
#undef PG8_LDB
#undef PG8_MMA
#undef PG8_WAIT_V
#undef PG8_WAIT_L
#undef PG8_BAR
#undef PG8_SCHED
}
}
namespace attn {
using bf16 = __hip_bfloat16;
typedef short bf16x8 __attribute__((ext_vector_type(8)));
typedef short s16x4 __attribute__((ext_vector_type(4)));
typedef float f32x16 __attribute__((ext_vector_type(16)));
typedef float f32x4 __attribute__((ext_vector_type(4)));
typedef unsigned u32x4 __attribute__((ext_vector_type(4)));
template <class A, class Bt> struct same_t { static constexpr bool v = false; };
template <class A> struct same_t<A, A> { static constexpr bool v = true; };
constexpr int D = 128, PITCH = PP;
constexpr float THR = 8.f;
constexpr bool WSKIP = false;
constexpr float SCALE = 0.08838834764831845f;
constexpr int NW = 8, QBLK = 32, KVBLK = 64, QB = NW * QBLK;
constexpr int SHM_V = KVBLK * D * 2, SHM_K = KVBLK * D * 2;
constexpr int ATT_LDS_BYTES = 2 * SHM_V + 2 * SHM_K + NW * 64 * 4;
#define KSWZ(row, colB) ((row) * 256 + ((colB) ^ (((row) & 7) << 4)))
#define SBAR() __builtin_amdgcn_sched_barrier(0)
__device__ __forceinline__ int v_st(int k, int c) { const int kk = (k & ~0xC) | ((k & 4) << 1) | ((k & 8) >> 1); return ((kk >> 3) * 4 + (c >> 5)) * 512 + ((kk & 7) * 32 + (c & 31)) * 2; }
__device__ __forceinline__ int v_rd_base(int lane) { return ((lane & 3) << 3) | (((lane >> 2) & 3) << 6) | (((lane >> 4) & 1) << 5) | (((lane >> 5) & 1) << 8); }
constexpr int v_rd_off(int d0, int ks, int half) { return d0 * 512 + ks * 4096 + half * 2048; }
__device__ __forceinline__ int crow(int r, int hi) { return (r & 3) + 8 * (r >> 2) + 4 * hi; }
__device__ __forceinline__ unsigned cvtpk(float lo, float hi) {
    unsigned r; asm volatile("v_cvt_pk_bf16_f32 %0, %1, %2" : "=v"(r) : "v"(lo), "v"(hi)); return r;
}
__device__ __forceinline__ bf16x8 pack8(f32x4 a, f32x4 b) {
    u32x4 w = {cvtpk(a[0], a[1]), cvtpk(a[2], a[3]), cvtpk(b[0], b[1]), cvtpk(b[2], b[3])};
    return *reinterpret_cast<bf16x8*>(&w);
}
template <class T> __device__ __forceinline__ bf16x8 load8(const T* p) {
    if constexpr (same_t<T, float>::v) { return pack8(*(const f32x4*)p, *(const f32x4*)(p + 4)); }
    else { return *reinterpret_cast<const bf16x8*>(p); }
}
__device__ __forceinline__ void mask_bits(f32x16& p0, f32x16& p1, unsigned long long mw, int hi) {
    const float NEG = -__builtin_inff();
    const unsigned a = (unsigned)mw >> (4 * hi), b = (unsigned)(mw >> 32) >> (4 * hi);
#pragma unroll
    for (int r = 0; r < 16; ++r) {
        const int c = (r & 3) + 8 * (r >> 2);
        if (!((a >> c) & 1u)) p0[r] = NEG;
        if (!((b >> c) & 1u)) p1[r] = NEG;
    }
}
__device__ __forceinline__ void partialSM(f32x16& p0, f32x16& p1, float& m_reg, float& mn, float& alpha) {
    float pmax = p0[0]; for (int r = 1; r < 16; ++r) pmax = fmaxf(pmax, p0[r]); for (int r = 0; r < 16; ++r) pmax = fmaxf(pmax, p1[r]);
    { auto rr = __builtin_amdgcn_permlane32_swap(__float_as_uint(pmax), __float_as_uint(pmax), false, false);
      pmax = fmaxf(__uint_as_float(rr[0]), __uint_as_float(rr[1])); }
    constexpr float C2 = 1.4426950408889634f * SCALE;
    if (__builtin_expect(__all((pmax - m_reg) * SCALE <= THR), 1)) { mn = m_reg; alpha = 1.f; }
    else { mn = fmaxf(m_reg, pmax); alpha = __builtin_amdgcn_exp2f((m_reg - mn) * C2); m_reg = mn; }
    const float mnL = -mn * C2;
    for (int r = 0; r < 16; ++r) p0[r] = fmaf(p0[r], C2, mnL); for (int r = 0; r < 16; ++r) p1[r] = fmaf(p1[r], C2, mnL);
    for (int r = 0; r < 16; ++r) p0[r] = __builtin_amdgcn_exp2f(p0[r]);
}
__device__ __forceinline__ void finishSM(f32x16& p0, f32x16& p1, float alpha, float& l_reg, bf16x8& pa0, bf16x8& pa1, bf16x8& pa2, bf16x8& pa3) {
    for (int r = 0; r < 16; ++r) p1[r] = __builtin_amdgcn_exp2f(p1[r]);
    float ps = 0; for (int r = 0; r < 16; ++r) ps += p0[r]; for (int r = 0; r < 16; ++r) ps += p1[r];
    { auto rr = __builtin_amdgcn_permlane32_swap(__float_as_uint(ps), __float_as_uint(ps), false, false);
      ps = __uint_as_float(rr[0]) + __uint_as_float(rr[1]); }
    l_reg = l_reg * alpha + ps;
#define PK4(P, B_, OUT) do { unsigned a0 = cvtpk(P[B_+0], P[B_+1]), a1 = cvtpk(P[B_+2], P[B_+3]);                          \
        unsigned b0 = cvtpk(P[B_+4], P[B_+5]), b1 = cvtpk(P[B_+6], P[B_+7]);                                             \
        auto r0 = __builtin_amdgcn_permlane32_swap(a0, b0, false, false); auto r1 = __builtin_amdgcn_permlane32_swap(a1, b1, false, false); \
        u32x4 w = {r0[0], r1[0], r0[1], r1[1]}; OUT = *reinterpret_cast<bf16x8*>(&w); } while (0)
    PK4(p0, 0, pa0); PK4(p0, 8, pa1); PK4(p1, 0, pa2); PK4(p1, 8, pa3);
#undef PK4
}
template <int KB, bool SK>
__device__ __forceinline__ void qkt(f32x16& p0, f32x16& p1, const char* K_lds, int r32, int hi, const bf16x8* qr, bool act) {
    if (SK && !act) { const float NEG = -__builtin_inff();
#pragma unroll
        for (int r = 0; r < 16; ++r) { p0[r] = NEG; p1[r] = NEG; } return; }
    p0 = f32x16{}; p1 = f32x16{};
    const char* kb[4];
#pragma unroll
    for (int dd = 0; dd < 4; ++dd) kb[dd] = K_lds + KB * SHM_K + KSWZ(r32, (dd * 16 + hi * 8) * 2);
#pragma unroll
    for (int d0 = 0; d0 < 8; ++d0) { const char* a = kb[d0 & 3] + (d0 >> 2) * 128;
        bf16x8 b0 = *reinterpret_cast<const bf16x8*>(a);
        bf16x8 b1 = *reinterpret_cast<const bf16x8*>(a + 32 * 256);
        p0 = __builtin_amdgcn_mfma_f32_32x32x16_bf16(b0, qr[d0], p0, 0, 0, 0);
        p1 = __builtin_amdgcn_mfma_f32_32x32x16_bf16(b1, qr[d0], p1, 0, 0, 0); }
}
template <int VB, bool SK>
__device__ __forceinline__ void pv_tile(f32x16* o, int vb0, bf16x8 pa0, bf16x8 pa1, bf16x8 pa2, bf16x8 pa3, bool act) {
    if (SK && !act) return;
#define TRRD(dst, off) asm volatile("ds_read_b64_tr_b16 %0, %1 offset:%2" : "=&v"(dst) : "v"(vb0), "i"(off) : "memory")
#define PV_D0(d0) do { s16x4 l0, l1, l2, l3, h0, h1, h2, h3; constexpr int b_ = VB * SHM_V + v_rd_off(d0, 0, 0);     \
        TRRD(l0, b_); TRRD(h0, b_ + 2048); TRRD(l1, b_ + 4096); TRRD(h1, b_ + 6144); TRRD(l2, b_ + 8192); TRRD(h2, b_ + 10240); TRRD(l3, b_ + 12288); TRRD(h3, b_ + 14336); \
        asm volatile("s_waitcnt lgkmcnt(0)" ::: "memory"); SBAR();                 \
        o[d0] = __builtin_amdgcn_mfma_f32_32x32x16_bf16(pa0, (bf16x8){l0[0], l0[1], l0[2], l0[3], h0[0], h0[1], h0[2], h0[3]}, o[d0], 0, 0, 0);   \
        o[d0] = __builtin_amdgcn_mfma_f32_32x32x16_bf16(pa1, (bf16x8){l1[0], l1[1], l1[2], l1[3], h1[0], h1[1], h1[2], h1[3]}, o[d0], 0, 0, 0);   \
        o[d0] = __builtin_amdgcn_mfma_f32_32x32x16_bf16(pa2, (bf16x8){l2[0], l2[1], l2[2], l2[3], h2[0], h2[1], h2[2], h2[3]}, o[d0], 0, 0, 0);   \
        o[d0] = __builtin_amdgcn_mfma_f32_32x32x16_bf16(pa3, (bf16x8){l3[0], l3[1], l3[2], l3[3], h3[0], h3[1], h3[2], h3[3]}, o[d0], 0, 0, 0); } while (0)
    PV_D0(0); PV_D0(1); PV_D0(2); PV_D0(3);
#undef PV_D0
#undef TRRD
}
template <class TIn, class TOut> struct BlockRef { const TIn* Q; const TIn* K; const TIn* V; TOut* O; const unsigned long long* MK; int P0; };
template <class TIn> struct Seam {
    bf16x8 qr[8];
    bf16x8 st_v0, st_v1, st_k0, st_k1; f32x4 sf0, sf1, sf2, sf3;
    f32x4 tq[16];
};
__device__ __forceinline__ int swa_jlo(int P0, int W) { const int lowk = P0 - W + 1; return lowk > 0 ? lowk / KVBLK : 0; }
#define ROW(p, k0, rr) ((p) + (size_t)((k0) + (rr)) * PITCH + sc)
#define VMW() asm volatile("s_waitcnt vmcnt(0)" ::: "memory")
#define VMWN(n) asm volatile("s_waitcnt vmcnt(%0)" :: "i"(n) : "memory")
#define SLOAD_H(Kp, Vp, k0) do { S.st_v0 = load8<TIn>(ROW(Vp, k0, sr)); S.st_v1 = load8<TIn>(ROW(Vp, k0, 32 + sr));              \
                         S.st_k0 = load8<TIn>(ROW(Kp, k0, sr)); S.st_k1 = load8<TIn>(ROW(Kp, k0, 32 + sr)); } while (0)
#define SWRITE_HK(bf) do { *(bf16x8*)(K_lds + (bf) * SHM_K + kws) = S.st_k0; *(bf16x8*)(K_lds + (bf) * SHM_K + kws + 32 * 256) = S.st_k1; } while (0)
#define SWRITE_HV(bf) do { *(bf16x8*)(V_lds + (bf) * SHM_V + vst0) = S.st_v0; *(bf16x8*)(V_lds + (bf) * SHM_V + vst1) = S.st_v1; } while (0)
#define SWRITE_H(bf) do { SWRITE_HV(bf); SWRITE_HK(bf); } while (0)
#define SLOAD_F(p, k0) do { S.sf0 = *(const f32x4*)ROW(p, k0, sr); S.sf1 = *(const f32x4*)(ROW(p, k0, sr) + 4);                \
                            S.sf2 = *(const f32x4*)ROW(p, k0, 32 + sr); S.sf3 = *(const f32x4*)(ROW(p, k0, 32 + sr) + 4); } while (0)
#define SWRITE_KF(bf) do { *(bf16x8*)(K_lds + (bf) * SHM_K + kws) = pack8(S.sf0, S.sf1); *(bf16x8*)(K_lds + (bf) * SHM_K + kws + 32 * 256) = pack8(S.sf2, S.sf3); } while (0)
#define SWRITE_VF(bf) do { *(bf16x8*)(V_lds + (bf) * SHM_V + vst0) = pack8(S.sf0, S.sf1); *(bf16x8*)(V_lds + (bf) * SHM_V + vst1) = pack8(S.sf2, S.sf3); } while (0)
template <class TIn, class TOut>
__device__ __forceinline__ void causal_swa_prime(const BlockRef<TIn, TOut>& cur, int W, char* lds, Seam<TIn>& S) {
    constexpr bool F32 = same_t<TIn, float>::v;
    const int tid = threadIdx.x, wid = __builtin_amdgcn_readfirstlane(tid >> 6), lane = tid & 63, r32 = lane & 31, hi = lane >> 5;
    const int sr = tid >> 4, sc = (tid & 15) * 8, kws = KSWZ(sr, sc * 2); char* K_lds = lds + 2 * SHM_V;
    const int kb0 = swa_jlo(cur.P0, W) * KVBLK;
    for (int d0 = 0; d0 < 8; ++d0) S.qr[d0] = load8<TIn>(cur.Q + (size_t)(wid * QBLK + r32) * PITCH + d0 * 16 + hi * 8);
    if constexpr (F32) { SLOAD_F((const float*)cur.K, kb0); VMW(); SWRITE_KF(0); SBAR(); SLOAD_F((const float*)cur.V, kb0); }
    else { SLOAD_H(cur.K, cur.V, kb0); VMW(); SWRITE_HK(0); }
    __syncthreads();
}
template <class TIn, class TOut>
__device__ __forceinline__ void causal_swa_block(const BlockRef<TIn, TOut>& cur, const BlockRef<TIn, TOut>& nxt, int skv, int W, char* lds, Seam<TIn>& S) {
    constexpr bool F32 = same_t<TIn, float>::v;
    const int tid = threadIdx.x, wid = __builtin_amdgcn_readfirstlane(tid >> 6), lane = tid & 63, r32 = lane & 31, hi = lane >> 5;
    const int j_lo = swa_jlo(cur.P0, W);
    int j_hi = (cur.P0 + QB - 1) / KVBLK + 1; if (j_hi > skv / KVBLK) j_hi = skv / KVBLK;
    const int NT = j_hi - j_lo;
    const int kbn = swa_jlo(nxt.P0, W) * KVBLK;
    const int qlo = cur.P0 + wid * QBLK, qm = qlo + r32 - 4 * hi;
    char* V_lds = lds; char* K_lds = lds + 2 * SHM_V;
    float* ws = (float*)(lds + 2 * SHM_V + 2 * SHM_K) + wid * 64; float* li_l = ws, * al_l = ws + 32;
    float m_reg = -1e30f, l_reg = 0; f32x16 o[4] = {};
    const int sr = tid >> 4, sc = (tid & 15) * 8, vst0 = v_st(sr, sc), vst1 = v_st(32 + sr, sc), kws = KSWZ(sr, sc * 2);
    const int vb0 = (int)(uintptr_t)V_lds + v_rd_base(lane);
    const TIn* Kh = cur.K; const TIn* Vh = cur.V;
    const unsigned long long* mrow = cur.MK + (size_t)(wid * QBLK + r32) * 128; unsigned long long mwA, mwB = 0ull;
#define RESC(a) do { if (__any((a) < 1.f)) { if (hi == 0) al_l[r32] = (a); asm volatile("s_waitcnt lgkmcnt(0)" ::: "memory");              \
                     for (int d_ = 0; d_ < 4; ++d_) for (int r = 0; r < 16; ++r) o[d_][r] *= al_l[crow(r, hi)]; } } while (0)
#define KBASE(t) ((j_lo + (t)) * KVBLK)
#define ACT(t) (KBASE(t) <= qlo + QBLK - 1 && KBASE(t) + KVBLK - 1 >= qlo - W + 1)
#define MASKT(P0_, P1_, MW_) mask_bits(P0_, P1_, MW_, hi)
    constexpr int NQL = F32 ? 16 : 8;
    constexpr bool SK = WSKIP && !F32;
#define SEAM_K0() do { VMWN(NQL); if constexpr (F32) { SWRITE_KF(0); SBAR(); SLOAD_F((const float*)nxt.V, kbn); } else { SWRITE_HK(0); } SBAR(); } while (0)
    f32x16 pA0, pA1, pB0, pB1; float mnA, mnB, alA, alB; bf16x8 pa0, pa1, pa2, pa3;
    if constexpr (F32) { VMW(); SWRITE_VF(0); SBAR(); } else { SWRITE_HV(0); SBAR(); }
    if (NT > 1) { if constexpr (F32) SLOAD_F((const float*)Kh, KBASE(1)); else SLOAD_H(Kh, Vh, KBASE(1)); }
    mwA = mrow[0]; SBAR(); qkt<0, SK>(pA0, pA1, K_lds, r32, hi, S.qr, ACT(0));
    if constexpr (F32) { if (NT > 1) { VMW(); SWRITE_KF(1); SBAR(); SLOAD_F((const float*)Vh, KBASE(1)); } }
    MASKT(pA0, pA1, mwA); partialSM(pA0, pA1, m_reg, mnA, alA);
    if (NT > 1) { VMW(); if constexpr (F32) { SWRITE_VF(1); SBAR(); if (NT > 2) SLOAD_F((const float*)Kh, KBASE(2)); } else SWRITE_H(1); }
    __syncthreads();
#define HALF_STEP(PX0, PX1, mnX, alX, PY0, PY1, alY, t, KB, VB, SB, MWX) do {                                                      \
        MWX = mrow[(t)]; SBAR(); qkt<KB, SK>(PX0, PX1, K_lds, r32, hi, S.qr, ACT(t));                                             \
        finishSM(PY0, PY1, alY, l_reg, pa0, pa1, pa2, pa3); SBAR();                                                           \
        if ((t) + 1 < NT) { if constexpr (F32) { VMW(); SWRITE_KF(SB); SBAR(); SLOAD_F((const float*)Vh, KBASE((t) + 1)); }  \
                            else { SLOAD_H(Kh, Vh, KBASE((t) + 1)); } SBAR(); }                                               \
        pv_tile<VB, SK>(o, vb0, pa0, pa1, pa2, pa3, ACT((t) - 1)); MASKT(PX0, PX1, MWX); partialSM(PX0, PX1, m_reg, mnX, alX);                                        \
        __syncthreads();                                                                                                      \
        if ((t) + 1 < NT) { VMW(); if constexpr (F32) { SWRITE_VF(SB); SBAR(); if ((t) + 2 < NT) SLOAD_F((const float*)Kh, KBASE((t) + 2)); } \
                            else { SWRITE_H(SB); } }                                                                          \
        RESC(alX); __syncthreads(); } while (0)
    for (int t = 1; t + 1 < NT; t += 2) {
        HALF_STEP(pB0, pB1, mnB, alB, pA0, pA1, alA, t, 1, 0, 0, mwB);
        HALF_STEP(pA0, pA1, mnA, alA, pB0, pB1, alB, t + 1, 0, 1, 1, mwA);
    }
    const bool even = (NT & 1) == 0;
    if (even) { mwB = mrow[NT - 1]; SBAR(); qkt<1, SK>(pB0, pB1, K_lds, r32, hi, S.qr, ACT(NT - 1)); SBAR(); }
#define QROW(e) (nxt.Q + (size_t)(wid * QBLK + r32) * PITCH + ((e) >> 1) * 16 + hi * 8 + ((e) & 1) * 4)
    if constexpr (F32) { SLOAD_F((const float*)nxt.K, kbn); SBAR();
#pragma unroll
        for (int e = 0; e < 8; ++e) S.tq[e] = *(const f32x4*)QROW(e); }
    else { SLOAD_H(nxt.K, nxt.V, kbn); SBAR();
#pragma unroll
        for (int d0 = 0; d0 < 8; ++d0) S.qr[d0] = load8<TIn>(nxt.Q + (size_t)(wid * QBLK + r32) * PITCH + d0 * 16 + hi * 8); }
    SBAR();
    finishSM(pA0, pA1, alA, l_reg, pa0, pa1, pa2, pa3); SBAR();
    if constexpr (F32) {
#pragma unroll
        for (int e = 8; e < 16; ++e) S.tq[e] = *(const f32x4*)QROW(e); SBAR(); }
#undef QROW
    pv_tile<0, SK>(o, vb0, pa0, pa1, pa2, pa3, ACT(even ? NT - 2 : NT - 1));
    if (even) { MASKT(pB0, pB1, mwB); partialSM(pB0, pB1, m_reg, mnB, alB); __syncthreads(); RESC(alB);
        finishSM(pB0, pB1, alB, l_reg, pa0, pa1, pa2, pa3); SBAR(); pv_tile<1, SK>(o, vb0, pa0, pa1, pa2, pa3, ACT(NT - 1)); }
    SBAR(); SEAM_K0();
    if (hi == 0) li_l[r32] = l_reg; asm volatile("s_waitcnt lgkmcnt(0)" ::: "memory");
    float rli[16];
#pragma unroll
    for (int r = 0; r < 16; ++r) rli[r] = __builtin_amdgcn_rcpf(li_l[crow(r, hi)]);
    TOut* Ow = cur.O + (size_t)(wid * QBLK) * PITCH;
#pragma unroll
    for (int r = 0; r < 16; ++r) { const int orow = crow(r, hi);
#pragma unroll
        for (int d0 = 0; d0 < 4; ++d0) { const float v = o[d0][r] * rli[r];
            if constexpr (same_t<TOut, float>::v) { Ow[(size_t)orow * PITCH + d0 * 32 + r32] = v; }
            else { const float vn = __shfl_xor(v, 1);
                   if ((r32 & 1) == 0) *(unsigned*)(Ow + (size_t)orow * PITCH + d0 * 32 + r32) = cvtpk(v, vn); } } }
    if constexpr (F32) {
#pragma unroll
        for (int d0 = 0; d0 < 8; ++d0) S.qr[d0] = pack8(S.tq[2 * d0], S.tq[2 * d0 + 1]); }
    __syncthreads();
#undef RESC
#undef KBASE
#undef ACT
#undef MASKT
#undef SEAM_K0
#undef HALF_STEP
}
#undef ROW
#undef VMW
#undef VMWN
#undef SLOAD_H
#undef SWRITE_HK
#undef SWRITE_HV
#undef SWRITE_H
#undef SLOAD_F
#undef SWRITE_KF
#undef SWRITE_VF

#undef KSWZ
#undef SBAR
}

struct Params { const float* in[21]; float* out; unsigned char* ws; };
__constant__ float ROPE_INVF[24] = { 1.000000000e+00f, 4.403665960e-01f, 1.939227432e-01f, 8.539710194e-02f, 3.760603070e-02f, 1.656044088e-02f, 7.292664610e-03f, 3.211446106e-03f,
    1.414213562e-03f, 6.227724371e-04f, 2.742481884e-04f, 1.207697351e-04f, 5.318295734e-05f, 2.341999971e-05f, 1.031338525e-05f, 4.541670478e-06f,
    1.000000000e+00f, 1.939227432e-01f, 3.760603070e-02f, 7.292664610e-03f, 1.414213562e-03f, 2.742481884e-04f, 5.318295734e-05f, 1.031338525e-05f };
constexpr int CW_IDXQ = 64;
constexpr int CW_BAR = 4096;
#define XCD_BAR_WORDS 3456

#define LDS_WAIT() asm volatile("s_waitcnt lgkmcnt(0)" ::: "memory")

__device__ __forceinline__ int rowmap(int mode, int c) {
    if (mode == 1) return ((c >> 7) << 8) + (c & 127);
    if (mode == 2) return ((c >> 7) << 8) + 128 + (c & 127);
    if (mode == 3) return c < 4176 ? c : c + 176;
    return c;
}
__device__ __forceinline__ void transpose_item(const float* __restrict__ W, int K, int N, bf16raw* WT, int mode, LAS float* scr, int item, int lane, const float* __restrict__ gain = nullptr) {
    const int nblk = (N + 63) >> 6, kb = item / nblk, nb = item - kb * nblk, k0 = 64 * kb, n0 = 64 * nb;
    const int nn = n0 + (lane & 15) * 4; const bool ok = nn + 3 < N;
#pragma unroll 8
    for (int i = 0; i < 16; ++i) { const int kk = 4 * i + (lane >> 4); f32x4_t v = {0.f, 0.f, 0.f, 0.f}; if (ok) v = *(const f32x4_t*)(W + (size_t)(k0 + kk) * N + nn);
        if (gain) v = v * gain[k0 + kk];
        LAS float* d = scr + kk * 65 + (lane & 15) * 4; d[0] = v.x; d[1] = v.y; d[2] = v.z; d[3] = v.w; }
    LDS_WAIT();
    const int c = lane & 7;
#pragma unroll
    for (int j = 0; j < 8; ++j) { const int n = (lane >> 3) + 8 * j; const LAS float* s = scr + (8 * c) * 65 + n;
        u32x4_t o; o.x = pkbf(s[0 * 65], s[1 * 65]); o.y = pkbf(s[2 * 65], s[3 * 65]); o.z = pkbf(s[4 * 65], s[5 * 65]); o.w = pkbf(s[6 * 65], s[7 * 65]);
        if (n0 + n < N) *(u32x4_t*)(WT + (size_t)rowmap(mode, n0 + n) * K + k0 + 8 * c) = o; }
    LDS_WAIT();
}
__device__ __forceinline__ void rms_row(const float* __restrict__ xrow, const float* __restrict__ g, bf16raw* orow, int lane) {
    f32x4_t v[8]; float s = 0.f;
#pragma unroll
    for (int j = 0; j < 8; ++j) { v[j] = ((const f32x4_t*)xrow)[64 * j + lane]; s += (v[j].x * v[j].x + v[j].y * v[j].y) + (v[j].z * v[j].z + v[j].w * v[j].w); }
    const float r = 1.0f / sqrtf(wave_sum(s) * (1.0f / DM) + EPS);
#pragma unroll
    for (int j = 0; j < 8; ++j) { const f32x4_t gv = ((const f32x4_t*)g)[64 * j + lane]; u32x2_t o; o.x = pkbf(v[j].x * r * gv.x, v[j].y * r * gv.y); o.y = pkbf(v[j].z * r * gv.z, v[j].w * r * gv.w);
        ((u32x2_t*)orow)[64 * j + lane] = o; }
}
__device__ __forceinline__ void rms_phase(const float* x, const float* g, bf16raw* xn, int gw, int ngw, int lane) {
    for (int m = gw; m < MTOK; m += ngw) rms_row(x + (size_t)m * DM, g, xn + (size_t)m * DM, lane);
}
__device__ __forceinline__ void p0_prologue(const Params& P, LAS unsigned char* lds, int tid, int lane, int wave) {
    unsigned char* ws = P.ws;
    LAS float* scr = (LAS float*)(lds + wave * 16640);
    const int gw = blockIdx.x * NWAVES + wave, ngw = gridDim.x * NWAVES;
    constexpr int I_G = 32 * 88, I_D = 88 * 32, I_IN = 32 * 162, I_UA = 16 * 32, I_OUT = 32 * 32;
    constexpr int NITEMS = 4 * I_G + 2 * I_D + I_IN + 2 * I_UA + I_OUT;
    for (int it = gw; it < NITEMS; it += ngw) {
        int r = it;
        if (r < I_G) { transpose_item(P.in[3], DM, DFF, (bf16raw*)(ws + WS_WGU1), 1, scr, r, lane); continue; } r -= I_G;
        if (r < I_G) { transpose_item(P.in[4], DM, DFF, (bf16raw*)(ws + WS_WGU1), 2, scr, r, lane); continue; } r -= I_G;
        if (r < I_D) { transpose_item(P.in[5], DFF, DM, (bf16raw*)(ws + WS_WD1), 0, scr, r, lane); continue; } r -= I_D;
        if (r < I_G) { transpose_item(P.in[18], DM, DFF, (bf16raw*)(ws + WS_WGU2), 1, scr, r, lane, P.in[17]); continue; } r -= I_G;
        if (r < I_G) { transpose_item(P.in[19], DM, DFF, (bf16raw*)(ws + WS_WGU2), 2, scr, r, lane, P.in[17]); continue; } r -= I_G;
        if (r < I_D) { transpose_item(P.in[20], DFF, DM, (bf16raw*)(ws + WS_WD2), 0, scr, r, lane); continue; } r -= I_D;
        if (r < I_IN) { transpose_item(P.in[7], DM, 10320, (bf16raw*)(ws + WS_WIN), 3, scr, r, lane, P.in[6]); continue; } r -= I_IN;
        if (r < I_UA) { transpose_item(P.in[14], 1024, DM, (bf16raw*)(ws + WS_WUA), 0, scr, r, lane); continue; } r -= I_UA;
        if (r < I_UA) { transpose_item(P.in[15], 1024, DM, (bf16raw*)(ws + WS_WUS), 0, scr, r, lane); continue; } r -= I_UA;
        transpose_item(P.in[16], DM, DM, (bf16raw*)(ws + WS_WOUT), 0, scr, r, lane);
    }
    const int gt = blockIdx.x * NTHR + tid, ngt = gridDim.x * NTHR;
    { u32x4_t* padp = (u32x4_t*)((bf16raw*)(ws + WS_WIN) + (size_t)4176 * DM);
      for (int i = gt; i < 176 * DM / 8; i += ngt) padp[i] = (u32x4_t){0u, 0u, 0u, 0u}; }
    { const float* w_s = P.in[12]; bf16raw* wsb = (bf16raw*)(ws + WS_WSB);
      for (int i = gt; i < 8 * 128 * 128; i += ngt) { const int s = i & 127, t = (i >> 7) & 127; const float v = (t < 64 && s >= 64) ? 0.f : w_s[i]; wsb[i] = (bf16raw)(pkbf(v, 0.f) & 0xffffu); } }
    if (blockIdx.x == 0 && tid < 128) ((unsigned*)(ws + WS_CTL))[tid] = 0u;
    if (blockIdx.x == 0) { unsigned* bw = (unsigned*)(ws + WS_CTL) + CW_BAR; for (int i = tid; i < XCD_BAR_WORDS; i += NTHR) bw[i] = 0u; }
    { float* ssz = (float*)(ws + WS_SS1); for (int i = gt; i < 2 * MTOK; i += ngt) ssz[i] = 0.f; }
    rms_phase(P.in[0], P.in[2], (bf16raw*)(ws + WS_XN), gw, ngw, lane);
}

template <class Epi> __device__ __forceinline__ void run_gemm(LAS unsigned char* lds, const bf16raw* A, int lda, const bf16raw* Bt, int ldb, int N, int K, const Epi& E) {
    pg8::Gemm g{A, Bt, MTOK, N, K, lda, ldb}; pg8::StaticOrder S; S.init(MTOK, N, (int)gridDim.x, (int)blockIdx.x);
    pg8::gemm_phase<Epi, pg8::StaticOrder, true, true>(lds, g, S, E);
}

__device__ __forceinline__ void ld16(const bf16raw* p, float (&v)[16]) {
    const u32x4_t a = *(const u32x4_t*)p, b = *(const u32x4_t*)(p + 8);
#pragma unroll
    for (int e = 0; e < 4; ++e) { v[2 * e] = bflo(a[e]); v[2 * e + 1] = bfhi(a[e]); v[8 + 2 * e] = bflo(b[e]); v[8 + 2 * e + 1] = bfhi(b[e]); }
}
__device__ __forceinline__ void st16(bf16raw* p, const float (&v)[16]) {
    u32x4_t a, b;
#pragma unroll
    for (int e = 0; e < 4; ++e) { a[e] = pkbf(v[2 * e], v[2 * e + 1]); b[e] = pkbf(v[8 + 2 * e], v[8 + 2 * e + 1]); }
    *(u32x4_t*)p = a; *(u32x4_t*)(p + 8) = b;
}
__device__ __forceinline__ void unp16(const u32x4_t a, const u32x4_t b, float (&v)[16]) {
#pragma unroll
    for (int e = 0; e < 4; ++e) { v[2 * e] = bflo(a[e]); v[2 * e + 1] = bfhi(a[e]); v[8 + 2 * e] = bflo(b[e]); v[8 + 2 * e + 1] = bfhi(b[e]); }
}
struct PrepRaw { u32x4_t q0, q1, k0, k1, i0, i1, s0, s1, u0, u1; unsigned ki, wi; int pos; };
__device__ __forceinline__ PrepRaw prep_load(const Params& P, int m, int lane) {
    const bf16raw* row = (const bf16raw*)(P.ws + WS_PROJ) + (size_t)m * PP; PrepRaw r;
    r.q0 = *(const u32x4_t*)(row + C_Q + lane * 16); r.q1 = *(const u32x4_t*)(row + C_Q + lane * 16 + 8);
    r.k0 = *(const u32x4_t*)(row + C_K + lane * 16); r.k1 = *(const u32x4_t*)(row + C_K + lane * 16 + 8);
    r.i0 = *(const u32x4_t*)(row + C_QI + lane * 16); r.i1 = *(const u32x4_t*)(row + C_QI + lane * 16 + 8);
    r.s0 = *(const u32x4_t*)(row + C_VS + lane * 16); r.s1 = *(const u32x4_t*)(row + C_VS + lane * 16 + 8);
    r.u0 = *(const u32x4_t*)(row + C_U + lane * 16); r.u1 = *(const u32x4_t*)(row + C_U + lane * 16 + 8);
    r.ki = row[C_KI + lane]; r.wi = row[C_WI + (lane & 15)]; r.pos = ((const int*)P.in[1])[m];
    return r;
}
__device__ __forceinline__ void prep_token(const Params& P, int m, const PrepRaw& R, int lane) {
    bf16raw* row = (bf16raw*)(P.ws + WS_PROJ) + (size_t)m * PP;
    float cs = 1.f, sn = 0.f;
    { const float ang = (float)R.pos * ROPE_INVF[lane < 24 ? lane : 0]; double rev = (double)ang * 0.15915494309189535; rev -= rint(rev); const float fr = (float)rev;
      sn = __builtin_amdgcn_sinf(fr); cs = __builtin_amdgcn_cosf(fr); }
    float cA[16], sA[16];
#pragma unroll
    for (int i = 0; i < 16; ++i) { cA[i] = __shfl(cs, i); sA[i] = __shfl(sn, i); }
    const int sub = lane & 7; const bool rot = sub < 2; const float sg = sub == 0 ? -1.f : 1.f;
#pragma unroll
    for (int which = 0; which < 2; ++which) {
        bf16raw* p = row + (which ? C_K : C_Q) + lane * 16; const float* g = (which ? P.in[9] : P.in[8]) + sub * 16;
        float v[16]; if (which) unp16(R.k0, R.k1, v); else unp16(R.q0, R.q1, v);
        float ss = 0.f;
#pragma unroll
        for (int i = 0; i < 16; ++i) ss += v[i] * v[i];
        ss += __shfl_xor(ss, 1); ss += __shfl_xor(ss, 2); ss += __shfl_xor(ss, 4);
        const float r = 1.0f / sqrtf(ss * (1.0f / 128.0f) + EPS);
#pragma unroll
        for (int i = 0; i < 16; ++i) v[i] = v[i] * r * g[i];
#pragma unroll
        for (int i = 0; i < 16; ++i) { const float o = __shfl_xor(v[i], 1); const float rr = v[i] * cA[i] + sg * o * sA[i]; v[i] = rot ? rr : v[i]; }
        st16(p, v);
    }
    { bf16raw* p = row + C_QI + lane * 16; float v[16]; unp16(R.i0, R.i1, v);
      const bool r0 = (lane & 3) == 0;
#pragma unroll
      for (int i = 0; i < 8; ++i) { const float ci = __shfl(cs, 16 + i), si = __shfl(sn, 16 + i); const float x1 = v[i], x2 = v[8 + i];
          v[i] = r0 ? x1 * ci - x2 * si : x1; v[8 + i] = r0 ? x2 * ci + x1 * si : x2; }
      st16(p, v);
      float y = bf2f((unsigned short)R.ki); const float ss = wave_sum(y * y);
      y = y * (1.0f / sqrtf(ss * (1.0f / 64.0f) + EPS)) * P.in[10][lane];
      const float o = __shfl_xor(y, 8), cc = __shfl(cs, 16 + (lane & 7)), s2 = __shfl(sn, 16 + (lane & 7));
      y = lane < 8 ? y * cc - o * s2 : (lane < 16 ? y * cc + o * s2 : y);
      ((bf16raw*)(P.ws + WS_KI))[(size_t)m * 64 + lane] = (bf16raw)(pkbf(y, 0.f) & 0xffffu);
      if (lane < 16) ((float*)(P.ws + WS_WI))[(size_t)m * 16 + lane] = bf2f((unsigned short)R.wi);
    }
    { bf16raw* p = row + C_U + lane * 16; float v[16]; unp16(R.u0, R.u1, v);
#pragma unroll
      for (int i = 0; i < 16; ++i) v[i] = gelu_tanh_f(v[i]);
      st16(p, v); }
    { bf16raw* p = row + C_VS + lane * 16; float v[16]; unp16(R.s0, R.s1, v); float ss = 0.f;
#pragma unroll
      for (int i = 0; i < 16; ++i) { v[i] = gelu_tanh_f(v[i]); ss += v[i] * v[i]; }
      const float r = 1.0f / sqrtf(wave_sum(ss) * (1.0f / 1024.0f) + EPS); const float* g = P.in[11] + lane * 16;
#pragma unroll
      for (int i = 0; i < 16; ++i) v[i] = v[i] * r * g[i];
      st16(p, v); }
}

__device__ __forceinline__ void sgu_phase(const Params& P, LAS unsigned char* lds, int tid, int lane, int wave) {
    bf16raw* proj = (bf16raw*)(P.ws + WS_PROJ); const bf16raw* wsb = (const bf16raw*)(P.ws + WS_WSB); const float* bs = P.in[13];
    LAS bf16raw* VT = (LAS bf16raw*)lds;
    const int r32 = lane & 31, hi = lane >> 5, tr = wave & 3, ch = wave >> 2;
    for (int item = blockIdx.x; item < 2048; item += gridDim.x) {
        const int g = item & 7, tok0 = (item >> 3) * 128;
#pragma unroll
        for (int i = 0; i < 4; ++i) { const int id = tid + 512 * i, s = id & 127, cc = (id >> 7) * 8;
            const u32x4_t w = *(const u32x4_t*)(proj + (size_t)(tok0 + s) * PP + C_VS + g * 128 + cc);
#pragma unroll
            for (int e = 0; e < 4; ++e) { VT[(cc + 2 * e) * 136 + s] = (bf16raw)(w[e] & 0xffffu); VT[(cc + 2 * e + 1) * 136 + s] = (bf16raw)(w[e] >> 16); } }
        __syncthreads();
        f32x16_t acc[2]; acc[0] = f32x16_t{}; acc[1] = f32x16_t{};
#pragma unroll
        for (int ks = 0; ks < 8; ++ks) {
            const bf16x8_t a = *(const bf16x8_t*)(wsb + (size_t)g * 16384 + (32 * tr + r32) * 128 + 16 * ks + 8 * hi);
#pragma unroll
            for (int nt = 0; nt < 2; ++nt) { const bf16x8_t b = *(const LAS bf16x8_t*)(VT + (64 * ch + 32 * nt + r32) * 136 + 16 * ks + 8 * hi);
                acc[nt] = __builtin_amdgcn_mfma_f32_32x32x16_bf16(a, b, acc[nt], 0, 0, 0); }
        }
#pragma unroll
        for (int nt = 0; nt < 2; ++nt)
#pragma unroll
            for (int r = 0; r < 16; ++r) { const int t = 32 * tr + (r & 3) + 8 * (r >> 2) + 4 * hi; bf16raw* up = proj + (size_t)(tok0 + t) * PP + C_U + g * 128 + 64 * ch + 32 * nt + r32;
                const float y = bf2f(*up) * (acc[nt][r] + bs[g * 128 + t]); *up = (bf16raw)(pkbf(y, 0.f) & 0xffffu); }
        __syncthreads();
    }
}

__device__ __forceinline__ bool radix_pick(const LAS unsigned* h, int k, int lane, int& d, int& kn, int& cnt) {
    const u32x4_t c = *(const LAS u32x4_t*)(h + 4 * lane);
    const unsigned t = c.x + c.y + c.z + c.w;
    int pv = (int)t;
    pv += __builtin_amdgcn_update_dpp(0, pv, 0x111, 0xf, 0xf, false);
    pv += __builtin_amdgcn_update_dpp(0, pv, 0x112, 0xf, 0xf, false);
    pv += __builtin_amdgcn_update_dpp(0, pv, 0x114, 0xf, 0xf, false);
    pv += __builtin_amdgcn_update_dpp(0, pv, 0x118, 0xf, 0xf, false);
    pv += __builtin_amdgcn_update_dpp(0, pv, 0x142, 0xa, 0xf, false);
    pv += __builtin_amdgcn_update_dpp(0, pv, 0x143, 0xc, 0xf, false);
    const unsigned total = (unsigned)__builtin_amdgcn_readlane(pv, 63);
    unsigned gt = total - (unsigned)pv; int dsel = -1; unsigned knn = 0u, cc = 0u; const unsigned kr = (unsigned)k;
    { const unsigned ge = gt + c.w; if (gt < kr && kr <= ge) { dsel = 4 * lane + 3; knn = kr - gt; cc = c.w; } gt = ge; }
    { const unsigned ge = gt + c.z; if (gt < kr && kr <= ge) { dsel = 4 * lane + 2; knn = kr - gt; cc = c.z; } gt = ge; }
    { const unsigned ge = gt + c.y; if (gt < kr && kr <= ge) { dsel = 4 * lane + 1; knn = kr - gt; cc = c.y; } gt = ge; }
    { const unsigned ge = gt + c.x; if (gt < kr && kr <= ge) { dsel = 4 * lane + 0; knn = kr - gt; cc = c.x; } gt = ge; }
    const unsigned long long bal = __ballot(dsel >= 0);
    if (bal == 0ull) return false;
    const int src = __builtin_amdgcn_readfirstlane(__ffsll((long long)bal) - 1);
    d = __builtin_amdgcn_readlane(dsel, src); kn = __builtin_amdgcn_readlane((int)knn, src); cnt = __builtin_amdgcn_readlane((int)cc, src);
    return true;
}
constexpr int IDX_LCAP = 2048;
template <int NJ> __device__ __forceinline__ void idx_select(const unsigned* __restrict__ sc, int nj, int wend, unsigned long long* mrow, LAS unsigned* hist, LAS unsigned* list, int lane) {
    unsigned u[NJ];
#pragma unroll
    for (int j = 0; j < NJ; ++j) u[j] = sc[j * 64 + lane];
#pragma unroll
    for (int j = 0; j < NJ; ++j) u[j] = (j < nj) ? u[j] : 0u;
    unsigned prefix = 0u; int krem = 256, d = 0, kn = 0, cnt = 0;
    hist[lane] = 0u; hist[lane + 64] = 0u; hist[lane + 128] = 0u; hist[lane + 192] = 0u;
    LDS_WAIT();
    { int njp = nj; asm volatile("" : "+s"(njp));
#pragma unroll
      for (int j = 0; j < NJ; ++j) { if (j < njp) __hip_atomic_fetch_add(hist + (u[j] >> 24), 1u, __ATOMIC_RELAXED, __HIP_MEMORY_SCOPE_WORKGROUP); } }
    LDS_WAIT();
    if (!radix_pick(hist, krem, lane, d, kn, cnt)) return;
    prefix = (unsigned)d << 24; krem = kn;
    if (cnt <= IDX_LCAP) {
        int base = 0;
        { int njp = nj; asm volatile("" : "+s"(njp));
#pragma unroll
          for (int j = 0; j < NJ; ++j) { if (j < njp) { const bool m = (u[j] >> 24) == (unsigned)d; const unsigned long long bal = __ballot(m);
                if (bal != 0ull) { if (m) list[base + (int)__builtin_amdgcn_mbcnt_hi((unsigned)(bal >> 32), __builtin_amdgcn_mbcnt_lo((unsigned)bal, 0u))] = u[j]; base += __popcll(bal); } } } }
        LDS_WAIT();
#pragma unroll 1
        for (int pass = 1; pass < 4; ++pass) {
            const int shift = 24 - 8 * pass; const unsigned himask = 0xffffffffu << (shift + 8);
            hist[lane] = 0u; hist[lane + 64] = 0u; hist[lane + 128] = 0u; hist[lane + 192] = 0u;
            LDS_WAIT();
            for (int i0 = lane; i0 < base; i0 += 256) {
                unsigned v[4]; bool ok[4];
#pragma unroll
                for (int q4 = 0; q4 < 4; ++q4) { const int i = i0 + 64 * q4; ok[q4] = i < base; v[q4] = list[ok[q4] ? i : 0]; }
#pragma unroll
                for (int q4 = 0; q4 < 4; ++q4) { if (ok[q4] && ((v[q4] ^ prefix) & himask) == 0u) __hip_atomic_fetch_add(hist + ((v[q4] >> shift) & 255u), 1u, __ATOMIC_RELAXED, __HIP_MEMORY_SCOPE_WORKGROUP); }
            }
            LDS_WAIT();
            if (!radix_pick(hist, krem, lane, d, kn, cnt)) break;
            prefix |= (unsigned)d << shift; krem = kn;
        }
    } else {
#pragma unroll 1
        for (int pass = 1; pass < 4; ++pass) {
            const int shift = 24 - 8 * pass; const unsigned himask = 0xffffffffu << (shift + 8);
            int njp = nj; asm volatile("" : "+s"(njp));
            hist[lane] = 0u; hist[lane + 64] = 0u; hist[lane + 128] = 0u; hist[lane + 192] = 0u;
            LDS_WAIT();
#pragma unroll
            for (int j = 0; j < NJ; ++j) { if (j < njp) { if (((u[j] ^ prefix) & himask) == 0u) __hip_atomic_fetch_add(hist + ((u[j] >> shift) & 255u), 1u, __ATOMIC_RELAXED, __HIP_MEMORY_SCOPE_WORKGROUP); } }
            LDS_WAIT();
            if (!radix_pick(hist, krem, lane, d, kn, cnt)) break;
            prefix |= (unsigned)d << shift; krem = kn;
        }
    }
    const unsigned thr = prefix; unsigned wl0 = 0u, wh0 = 0u, wl1 = 0u, wh1 = 0u; int total = 0;
#pragma unroll
    for (int j = 0; j < NJ; ++j) {
        const unsigned long long word = __ballot(u[j] >= thr);
        total += __popcll(word);
        { const unsigned wlo_ = (unsigned)__builtin_amdgcn_readfirstlane((int)(unsigned)word), whi_ = (unsigned)__builtin_amdgcn_readfirstlane((int)(unsigned)(word >> 32));
          if (j < 64) { asm volatile("v_writelane_b32 %0, %1, %2" : "+v"(wl0) : "s"(wlo_), "n"(j & 63)); asm volatile("v_writelane_b32 %0, %1, %2" : "+v"(wh0) : "s"(whi_), "n"(j & 63)); }
          else { asm volatile("v_writelane_b32 %0, %1, %2" : "+v"(wl1) : "s"(wlo_), "n"(j & 63)); asm volatile("v_writelane_b32 %0, %1, %2" : "+v"(wh1) : "s"(whi_), "n"(j & 63)); } }
    }
    if (__builtin_amdgcn_readfirstlane(total) != 256) {
        int taken = 0;
#pragma unroll
        for (int j = 0; j < NJ; ++j) {
            unsigned long long word = __ballot(u[j] > thr);
            unsigned long long e = __ballot(u[j] == thr);
            if (e != 0ull) { const int need = krem - taken;
                if (need > 0) { int n = __popcll(e); unsigned long long sel = e;
                    if (n > need) { sel = 0ull; for (int t2 = 0; t2 < need; ++t2) { const unsigned long long b = e & (~e + 1ull); sel |= b; e ^= b; } n = need; }
                    word |= sel; taken += n; } }
            { const unsigned wlo_ = (unsigned)__builtin_amdgcn_readfirstlane((int)(unsigned)word), whi_ = (unsigned)__builtin_amdgcn_readfirstlane((int)(unsigned)(word >> 32));
              if (j < 64) { asm volatile("v_writelane_b32 %0, %1, %2" : "+v"(wl0) : "s"(wlo_), "n"(j & 63)); asm volatile("v_writelane_b32 %0, %1, %2" : "+v"(wh0) : "s"(whi_), "n"(j & 63)); }
              else { asm volatile("v_writelane_b32 %0, %1, %2" : "+v"(wl1) : "s"(wlo_), "n"(j & 63)); asm volatile("v_writelane_b32 %0, %1, %2" : "+v"(wh1) : "s"(whi_), "n"(j & 63)); } }
        }
    }
    if (lane < wend) mrow[lane] = ((unsigned long long)wh0 << 32) | wl0;
    if (NJ > 64) { if (lane + 64 < wend) mrow[lane + 64] = ((unsigned long long)wh1 << 32) | wl1; }
}

__device__ __forceinline__ float relu_i(float x) { const int b = __float_as_int(x); return __int_as_float(b > 0 ? b : 0); }
__device__ __forceinline__ f32x16_t idx_chain(const bf16x8_t (&Af)[4], const bf16x8_t (&B4)[4]) {
    f32x16_t acc = f32x16_t{};
#pragma unroll
    for (int s = 0; s < 4; ++s) acc = __builtin_amdgcn_mfma_f32_32x32x16_bf16(Af[s], B4[s], acc, 0, 0, 0);
    return acc;
}
__device__ __forceinline__ unsigned idx_score_key(const f32x16_t& acc, const f32x4_t (&wv)[4]) {
    float sc0 = 0.f, sc1 = 0.f;
#pragma unroll
    for (int i = 0; i < 16; i += 2) { sc0 += relu_i(acc[i]) * wv[i >> 2][i & 3]; sc1 += relu_i(acc[i + 1]) * wv[(i + 1) >> 2][(i + 1) & 3]; }
    const unsigned bts = __float_as_uint(sc0 + sc1);
    return bts ^ ((unsigned)((int)bts >> 31) | 0x80000000u);
}
template <bool FULL> __device__ __forceinline__ void idx_rt_block(const bf16x8_t (&Bf)[8][4], const bf16x8_t (&Af)[4], const f32x4_t (&wv)[4], unsigned* srow, int tile0, int ntile) {
    if (FULL) {
        f32x16_t accA = idx_chain(Af, Bf[0]), accB;
#pragma unroll
        for (int kt = 0; kt < 8; ++kt) {
            if (kt + 1 < 8) accB = idx_chain(Af, Bf[kt + 1]);
            srow[(tile0 + kt * 8) * 32] = idx_score_key(accA, wv);
            if (kt + 1 < 8) {
#pragma unroll
                for (int s = 0; s < 4; ++s) { __builtin_amdgcn_sched_group_barrier(0x008, 1, 0); __builtin_amdgcn_sched_group_barrier(0x002, 10, 0); }
            }
            accA = accB;
        }
    } else {
#pragma unroll
        for (int kt = 0; kt < 8; ++kt) { const int tile = tile0 + kt * 8;
            if (tile < ntile) { const f32x16_t acc = idx_chain(Af, Bf[kt]); srow[tile * 32] = idx_score_key(acc, wv); } }
    }
}
__device__ __forceinline__ void indexer_phase(const Params& P, LAS unsigned char* lds, int tid, int lane, int wave) {
    unsigned char* ws = P.ws;
    const bf16raw* proj = (const bf16raw*)(ws + WS_PROJ); const bf16raw* KI = (const bf16raw*)(ws + WS_KI); const float* WIf = (const float*)(ws + WS_WI);
    unsigned long long* MASK = (unsigned long long*)(ws + WS_MASK); unsigned* ctl = (unsigned*)(ws + WS_CTL);
    float* scratch = P.out + (size_t)blockIdx.x * (16 * 8192);
    LAS unsigned* list = (LAS unsigned*)(lds + 45056) + wave * IDX_LCAP;
    LAS float* WL = (LAS float*)(lds + 32768); LAS unsigned* hist = (LAS unsigned*)(lds + 33792) + wave * 256; volatile LAS int* itemw = (volatile LAS int*)(lds + 41984);
    const int r32 = lane & 31, hi = lane >> 5;
    if (blockIdx.x >= 256) return;
    for (;;) {
        if (tid == 0) *itemw = (int)atomicAdd(ctl + CW_IDXQ, 1u);
        __syncthreads();
        const int it = *itemw;
        __syncthreads();
        if (it >= 2048) break;
        const int qt = 511 - (it >> 2), b = it & 3, q0 = qt * 16, n_adm = ((q0 >> 6) + 1) * 64, wend = ((q0 >> 8) + 1) * 4, tok0 = b * SEQ + q0;
        if (n_adm <= 256) {
            if (tid < 64) { const int q = tid >> 2, j = tid & 3; MASK[(size_t)(tok0 + q) * 128 + j] = (j < (n_adm >> 6)) ? ~0ull : 0ull; }
            continue;
        }
        for (int c = tid; c < 2048; c += NTHR) { const int l = c & 63, s = (c >> 6) & 3, rt = c >> 8, rho = l & 31, hf = l >> 5, par = (rho >> 2) & 1, head = (rho & 3) + 4 * (rho >> 3);
            *(LAS u32x4_t*)(lds + c * 16) = *(const u32x4_t*)(proj + (size_t)(tok0 + 2 * rt + par) * PP + C_QI + head * 64 + 16 * s + 8 * hf); }
        if (tid < 256) WL[tid] = WIf[(size_t)tok0 * 16 + tid];
        __syncthreads();
        const int ntile = n_adm >> 5, npass = (ntile + 63) >> 6;
        for (int p = 0; p < npass; ++p) {
            bf16x8_t Bf[8][4];
#pragma unroll
            for (int kt = 0; kt < 8; ++kt) { const int tile = p * 64 + kt * 8 + wave;
                const int tcl = tile < ntile ? tile : ntile - 1;
                const bf16raw* kp = KI + (size_t)(b * SEQ + tcl * 32 + r32) * 64 + 8 * hi;
#pragma unroll
                for (int s = 0; s < 4; ++s) Bf[kt][s] = *(const bf16x8_t*)(kp + 16 * s); }
            const int tile0 = p * 64 + wave; const bool full = tile0 + 56 < ntile;
#pragma unroll 1
            for (int rt = 0; rt < 8; ++rt) {
                bf16x8_t Af[4];
#pragma unroll
                for (int s = 0; s < 4; ++s) Af[s] = *(const LAS bf16x8_t*)(lds + ((rt * 4 + s) * 64 + lane) * 16);
                f32x4_t wv[4];
#pragma unroll
                for (int e = 0; e < 4; ++e) wv[e] = *(const LAS f32x4_t*)(WL + (2 * rt + hi) * 16 + 4 * e);
                unsigned* srow = (unsigned*)scratch + (2 * rt + hi) * 8192 + r32;
                if (full) idx_rt_block<true>(Bf, Af, wv, srow, tile0, ntile); else idx_rt_block<false>(Bf, Af, wv, srow, tile0, ntile);
            }
        }
        __syncthreads();
        const int nj = n_adm >> 6;
#pragma unroll 1
        for (int qq = 2 * wave; qq < 2 * wave + 2; ++qq) {
            const unsigned* sc = (const unsigned*)scratch + qq * 8192; unsigned long long* mrow = MASK + (size_t)(tok0 + qq) * 128;
            int njq = nj; asm volatile("" : "+s"(njq));
            if (njq <= 16) idx_select<16>(sc, njq, wend, mrow, hist, list, lane);
            else if (njq <= 32) idx_select<32>(sc, njq, wend, mrow, hist, list, lane);
            else if (njq <= 64) idx_select<64>(sc, njq, wend, mrow, hist, list, lane);
            else idx_select<128>(sc, njq, wend, mrow, hist, list, lane);
        }
        __syncthreads();
    }
}

__device__ __forceinline__ attn::BlockRef<attn::bf16, attn::bf16> att_ref(unsigned char* ws, int bi) {
    const int G_ = (int)gridDim.x, bx_ = (int)blockIdx.x, vg = (G_ % 8 == 0) ? (bx_ & 7) * (G_ >> 3) + (bx_ >> 3) : bx_;
    const int item = vg + (bi >> 1) * G_, bh = item >> 4, pr = item & 15, qb = (bi & 1) ? 31 - pr : pr, b = bh >> 3, h = bh & 7;
    attn::bf16* proj = (attn::bf16*)(ws + WS_PROJ); const size_t tokb = (size_t)b * SEQ;
    attn::BlockRef<attn::bf16, attn::bf16> r;
    r.Q = proj + (tokb + qb * 256) * PP + C_Q + h * 128; r.K = proj + tokb * PP + C_K + h * 128; r.V = proj + tokb * PP + C_V + h * 128;
    r.O = proj + (tokb + qb * 256) * PP + C_Q + h * 128; r.MK = (const unsigned long long*)(ws + WS_MASK) + (tokb + qb * 256) * 128; r.P0 = qb * 256;
    return r;
}
__device__ __forceinline__ void attn_phase(unsigned char* ws, char* lds) {
    const int nitems = (int)blockIdx.x < 512 ? (512 - (int)blockIdx.x + (int)gridDim.x - 1) / (int)gridDim.x : 0, nb = 2 * nitems;
    if (nb == 0) return;
    attn::Seam<attn::bf16> S;
    { const auto r0 = att_ref(ws, 0); attn::causal_swa_prime<attn::bf16, attn::bf16>(r0, SEQ, lds, S); }
    for (int bi = 0; bi < nb; ++bi) {
        const auto cur = att_ref(ws, bi); const auto nxt = att_ref(ws, bi + 1 < nb ? bi + 1 : bi);
        attn::causal_swa_block<attn::bf16, attn::bf16>(cur, nxt, SEQ, SEQ, lds, S);
    }
}

#define XB_TMO      128
#define XB_XCNT(j)  (256  + 64 * (j))
#define XB_XSUB(j)  (1280 + 64 * (j))
#define XB_XGEN(j)  (2304 + 64 * (j))
#define XB_TOP      3328
#define XB_TOPGEN   3392
#define XB_SPIN_CAP (1u << 18)

__device__ __forceinline__ unsigned xb_ld(unsigned* p)              { return __hip_atomic_load(p, __ATOMIC_RELAXED, __HIP_MEMORY_SCOPE_AGENT); }
__device__ __forceinline__ unsigned xb_add(unsigned* p, unsigned v) { return __hip_atomic_fetch_add(p, v, __ATOMIC_RELAXED, __HIP_MEMORY_SCOPE_AGENT); }
__device__ __forceinline__ unsigned xb_xcc_id() { return (unsigned)__builtin_amdgcn_s_getreg((3 << 11) | 20) & 0xFu; }
#define XB_SPIN(cond, bar) do { unsigned _sp = 0; while (cond) { __builtin_amdgcn_s_sleep(1); \
    if ((++_sp & 255u) == 0u) { if (xb_ld(&(bar)[XB_TMO])) break; if (_sp > XB_SPIN_CAP) { atomicAdd(&(bar)[XB_TMO], 1u); break; } } } } while (0)

struct XcdBarrier {
    unsigned* bar; unsigned x;
    volatile LAS unsigned* st;
};

__device__ __forceinline__ XcdBarrier xcd_barrier_post(unsigned* bar, volatile LAS unsigned* st) {
    XcdBarrier b; b.bar = bar; b.x = xb_xcc_id(); b.st = st;
    if (threadIdx.x == 0) (void)xb_add(&bar[XB_XCNT(b.x)], 1u);
    return b;
}
__device__ __forceinline__ void xcd_barrier_complete(unsigned* bar, unsigned x, unsigned& nloc, unsigned& nx) {
    const unsigned G = gridDim.x * gridDim.y * gridDim.z;
    unsigned sum, cnt, mine, sp = 0u;
    for (;;) {
        sum = 0u; cnt = 0u; mine = 0u;
#pragma unroll
        for (unsigned j = 0; j < 16; ++j) { const unsigned c = xb_ld(&bar[XB_XCNT(j)]); sum += c; cnt += (c > 0u) ? 1u : 0u; mine = (j == x) ? c : mine; }
        if (sum == G) break;
        __builtin_amdgcn_s_sleep(1);
        if ((++sp & 255u) == 0u) { if (xb_ld(&bar[XB_TMO])) break; if (sp > XB_SPIN_CAP) { atomicAdd(&bar[XB_TMO], 1u); break; } }
    }
    nloc = mine > 0u ? mine : 1u; nx = cnt > 0u ? cnt : 1u;
}

__device__ __forceinline__ void xcd_barrier(const XcdBarrier& b) {
    asm volatile("s_waitcnt vmcnt(0)" ::: "memory");
    __syncthreads();
    if (threadIdx.x == 0) {
        unsigned* bar = b.bar;
        __builtin_amdgcn_s_waitcnt(0);
        unsigned nloc = b.st[0], nx = b.st[1];
        if (nloc == 0u) { xcd_barrier_complete(bar, b.x, nloc, nx); b.st[0] = nloc; b.st[1] = nx; }
        const unsigned old = xb_add(&bar[XB_XSUB(b.x)], 1u);
        const unsigned gen = old / nloc;
        if (old + 1u == (gen + 1u) * nloc) {
            __builtin_amdgcn_fence(__ATOMIC_RELEASE, "agent");
            asm volatile("s_waitcnt vmcnt(0)" ::: "memory");
            const unsigned og = xb_add(&bar[XB_TOP], 1u);
            const unsigned tg = og / nx;
            if (og + 1u == (tg + 1u) * nx) xb_add(&bar[XB_TOPGEN], 1u);
            else XB_SPIN(xb_ld(&bar[XB_TOPGEN]) == tg, bar);
            __builtin_amdgcn_fence(__ATOMIC_ACQUIRE, "agent");
            xb_add(&bar[XB_XGEN(b.x)], 1u);
            asm volatile("s_waitcnt vmcnt(0)" ::: "memory");
        } else {
            XB_SPIN(xb_ld(&bar[XB_XGEN(b.x)]) == gen, bar);
            __builtin_amdgcn_fence(__ATOMIC_ACQUIRE, "agent");
            asm volatile("s_waitcnt vmcnt(0)" ::: "memory");
        }
    }
    __syncthreads();
}

__global__ void __launch_bounds__(NTHR, 2) fwd_kernel(Params P) {
    extern __shared__ __attribute__((aligned(16))) unsigned char lds_raw[];
    cg::grid_group grid = cg::this_grid();
    LAS unsigned char* lds = (LAS unsigned char*)lds_raw;
    const int tid = threadIdx.x, lane = tid & 63, wave = __builtin_amdgcn_readfirstlane(tid >> 6);
    const int gw = blockIdx.x * NWAVES + wave, ngw = gridDim.x * NWAVES;
    unsigned char* ws = P.ws;
    bf16raw* XN = (bf16raw*)(ws + WS_XN); bf16raw* PROJ = (bf16raw*)(ws + WS_PROJ); bf16raw* HB = PROJ;
    float* out = P.out; float* SS1 = (float*)(ws + WS_SS1); float* SS2 = SS1 + MTOK;

    volatile LAS unsigned* bst = (volatile LAS unsigned*)(lds + LDS_BYTES - 64);
    if (tid == 0) { bst[0] = 0u; bst[1] = 0u; }
    __syncthreads();
    p0_prologue(P, lds, tid, lane, wave);
    grid.sync();
    const XcdBarrier xbar = xcd_barrier_post((unsigned*)(ws + WS_CTL) + CW_BAR, bst);
#define GSYNC() xcd_barrier(xbar)
    { pg8::EpiSwiglu E{HB, DFF, nullptr}; run_gemm(lds, XN, DM, (const bf16raw*)(ws + WS_WGU1), DM, 2 * DFF, DM, E); }
    GSYNC();
    { pg8::EpiResid<false, false, true> E{P.in[0], nullptr, DM, 0.5f, XN, SS1}; run_gemm(lds, HB, DFF, (const bf16raw*)(ws + WS_WD1), DFF, DM, DFF, E); }
    GSYNC();
    { pg8::EpiStore E{PROJ, PP, SS1}; run_gemm(lds, XN, DM, (const bf16raw*)(ws + WS_WIN), DM, PP, DM, E); }
    GSYNC();
    if (gw < MTOK) { PrepRaw cur = prep_load(P, gw, lane);
#pragma unroll 1
      for (int m = gw; m < MTOK; m += ngw) { const int mn = m + ngw; const PrepRaw nxt = prep_load(P, mn < MTOK ? mn : m, lane); prep_token(P, m, cur, lane); cur = nxt; } }
    GSYNC();
    sgu_phase(P, lds, tid, lane, wave);
    indexer_phase(P, lds, tid, lane, wave);
    GSYNC();
    attn_phase(ws, (char*)lds_raw);
    GSYNC();
    { pg8::EpiGate<1> E{PROJ + C_GA, PROJ + C_GA, PP}; run_gemm(lds, PROJ + C_Q, PP, (const bf16raw*)(ws + WS_WUA), 1024, DM, 1024, E); }
    { pg8::EpiGate<2> E{PROJ + C_GB, PROJ + C_GA, PP}; run_gemm(lds, PROJ + C_U, PP, (const bf16raw*)(ws + WS_WUS), 1024, DM, 1024, E); }
    GSYNC();
    { pg8::EpiResid<true, false, true> E{XN, nullptr, DM, 1.0f, XN, SS2}; run_gemm(lds, PROJ + C_GA, PP, (const bf16raw*)(ws + WS_WOUT), DM, DM, DM, E); }
    GSYNC();
    { pg8::EpiSwiglu E{HB, DFF, SS2}; run_gemm(lds, XN, DM, (const bf16raw*)(ws + WS_WGU2), DM, 2 * DFF, DM, E); }
    GSYNC();
    { pg8::EpiResid<true, true, false> E{XN, out, DM, 0.5f, nullptr, nullptr}; run_gemm(lds, HB, DFF, (const bf16raw*)(ws + WS_WD2), DFF, DM, DFF, E); }
}

extern "C" void kernel_launch(void* const* d_in, const int* in_sizes, int n_in, void* d_out, int out_size, void* d_ws, size_t ws_size, hipStream_t stream) {
    static int grid = 0;
    if (grid == 0) {
        if (n_in != 21 || ws_size < WS_END) { fprintf(stderr, "kernel_launch: unexpected n_in %d / ws %zu\n", n_in, ws_size); grid = -1; return; }
        int dev = 0, cus = 0, per_cu = 0;
        (void)hipGetDevice(&dev); (void)hipDeviceGetAttribute(&cus, hipDeviceAttributeMultiprocessorCount, dev);
        if (hipFuncSetAttribute((const void*)fwd_kernel, hipFuncAttributeMaxDynamicSharedMemorySize, LDS_BYTES) != hipSuccess) fprintf(stderr, "kernel_launch: hipFuncSetAttribute failed\n");
        if (hipOccupancyMaxActiveBlocksPerMultiprocessor(&per_cu, (const void*)fwd_kernel, NTHR, LDS_BYTES) != hipSuccess || per_cu < 1) fprintf(stderr, "kernel_launch: occupancy query says %d\n", per_cu);
        (void)hipGetLastError();
        grid = cus > 256 ? 256 : cus; if (grid < 1) grid = 256;
    }
    if (grid < 0) return;
    Params p{};
    for (int i = 0; i < 21; ++i) p.in[i] = (const float*)d_in[i];
    p.out = (float*)d_out; p.ws = (unsigned char*)d_ws;
    void* args[] = {&p};
    const hipError_t e = hipLaunchCooperativeKernel((const void*)fwd_kernel, dim3(grid), dim3(NTHR), args, LDS_BYTES, stream);
    if (e != hipSuccess) fprintf(stderr, "cooperative launch failed: %s (grid %d)\n", hipGetErrorString(e), grid);
}
```

```cpp
#include <hip/hip_runtime.h>
#include <hip/hip_cooperative_groups.h>
#include <hip/hip_bf16.h>
#include <cstdio>
#include <cstdint>
#include <cmath>
namespace cg = cooperative_groups;

constexpr int BATCH = 4, SEQ = 8192, DM = 2048, MTOK = BATCH * SEQ, DFF = 5632;
constexpr int PP = 10496;
constexpr int C_Q = 0, C_K = 1024, C_V = 2048, C_QI = 3072, C_KI = 4096, C_WI = 4160, C_U = 4352, C_VS = 5376, C_GA = 6400, C_GB = 8448;
constexpr float EPS = 1e-6f;
constexpr int NWAVES = 8, NTHR = 512;
constexpr size_t MiB = 1u << 20;
constexpr size_t WS_CTL = 0, WS_SS1 = 256 * 1024  , WS_WSB = 1 * MiB, WS_KI = 2 * MiB, WS_WI = 6 * MiB, WS_WGU1 = 8 * MiB, WS_WD1 = 52 * MiB, WS_WGU2 = 74 * MiB, WS_WD2 = 118 * MiB,
                 WS_WIN = 140 * MiB, WS_WUA = 181 * MiB, WS_WUS = 185 * MiB, WS_WOUT = 189 * MiB, WS_MASK = 197 * MiB, WS_XN = 229 * MiB, WS_PROJ = 357 * MiB, WS_END = 1013 * MiB;
static_assert(WS_PROJ + (size_t)MTOK * PP * 2 <= WS_END && WS_XN + (size_t)MTOK * DM * 2 <= WS_PROJ && WS_MASK + (size_t)MTOK * 128 * 8 <= WS_XN, "ws map");
constexpr int LDS_BYTES = 147456;

typedef unsigned short bf16raw;
typedef unsigned u32x4_t __attribute__((ext_vector_type(4)));
typedef unsigned u32x2_t __attribute__((ext_vector_type(2)));
typedef float f32x4_t __attribute__((ext_vector_type(4)));
typedef float f32x16_t __attribute__((ext_vector_type(16)));
typedef short bf16x8_t __attribute__((ext_vector_type(8)));
#define LAS __attribute__((address_space(3)))

__device__ __forceinline__ float bf2f(unsigned short b) { return __uint_as_float((unsigned)b << 16); }
__device__ __forceinline__ float bflo(unsigned w) { return __uint_as_float(w << 16); }
__device__ __forceinline__ float bfhi(unsigned w) { return __uint_as_float(w & 0xffff0000u); }
__device__ __forceinline__ unsigned pkbf(float lo, float hi) { unsigned r; asm volatile("v_cvt_pk_bf16_f32 %0, %1, %2" : "=v"(r) : "v"(lo), "v"(hi)); return r; }
__device__ __forceinline__ float fast_sigmoid(float x) { return __builtin_amdgcn_rcpf(1.0f + __builtin_amdgcn_exp2f(-1.4426950408889634f * x)); }
__device__ __forceinline__ float silu_f(float x) { return x * fast_sigmoid(x); }
__device__ __forceinline__ float gelu_tanh_f(float x) { const float z2 = 1.5957691216057308f * (x + 0.044715f * x * x * x); return x * fast_sigmoid(z2); }
__device__ __forceinline__ float wave_sum(float v) {
#pragma unroll
    for (int o = 1; o < 64; o <<= 1) v += __shfl_xor(v, o);
    return v;
}
namespace pg8 {
#define PG8_LAS __attribute__((address_space(3)))
typedef unsigned short bf16_t;
typedef short bf16x8 __attribute__((ext_vector_type(8)));
typedef float f32x4 __attribute__((ext_vector_type(4)));
typedef unsigned u32x4 __attribute__((ext_vector_type(4)));
constexpr int BM = 256, BK = 64, HALF = 128, HTB = HALF * BK * 2  , STAGE_BYTES = 8 * HTB, NXCD = 8, WGM = 8;

__host__ __device__ __forceinline__ int lds_byte(int r, int c) { const int st = (r >> 4) * 2 + (c >> 5), rr = r & 15, cc = c & 31, ob = rr * 64 + cc * 2; return st * 1024 + (ob ^ (((ob >> 9) & 1) << 5)); }
__host__ __device__ __forceinline__ void stage_rc(int b, int& R, int& C) { const int st = b / 1024, sb = b % 1024, swz = sb ^ (((sb >> 9) & 1) << 5); R = (st >> 1) * 16 + swz / 64; C = (st & 1) * 32 + (swz % 64) / 2; }
__host__ __device__ __forceinline__ int perm32(int rho) { const int n = rho >> 4, i = rho & 15; return 8 * (i >> 2) + 4 * n + (i & 3); }

struct Unit { int pm, pn; };
struct Gemm { const bf16_t* A; const bf16_t* Bt; int M, N, K, lda, ldb; };

struct StaticOrder {
    int nM, nN, nwg, G, c, wgm;
    __host__ __device__ void init(int M, int N, int G_, int c_) { nM = M / BM; nN = N / BM; nwg = nM * nN; G = G_; c = c_; wgm = nN <= 8 ? 4 : WGM; }
    __host__ __device__ bool next(int i, Unit& u) const {
        const long L = (long)i * G + c; if (L >= nwg) return false;
        int wgid = (int)L; { const int q = nwg / NXCD, r = nwg % NXCD, xcd = wgid % NXCD, off = wgid / NXCD; wgid = (xcd < r ? xcd * (q + 1) : r * (q + 1) + (xcd - r) * q) + off; }
        const int nig = wgm * nN, gid = wgid / nig, fm = gid * wgm, gsz = (nM - fm) < wgm ? (nM - fm) : wgm;
        u.pm = fm + ((wgid % nig) % gsz); u.pn = (wgid % nig) / gsz; return true;
    }
    __device__ __forceinline__ void a_ready(const Unit&) const {}
    __device__ __forceinline__ void done(const Unit&) const {}
};

__device__ __forceinline__ unsigned cvt_pk_bf16(float lo, float hi) { unsigned r; asm volatile("v_cvt_pk_bf16_f32 %0, %1, %2" : "=v"(r) : "v"(lo), "v"(hi)); return r; }
typedef float f32x2 __attribute__((ext_vector_type(2)));

__device__ __forceinline__ float sigm(float x) { return __builtin_amdgcn_rcpf(1.0f + __builtin_amdgcn_exp2f(-1.4426950408889634f * x)); }
struct EpiStore {
    static constexpr bool PERM = true, AFTER_DRAIN = false;
    bf16_t* O; int ldc; const float* ss;
    __device__ __forceinline__ void operator()(const f32x4 (&acc)[2][2][4][2], const Unit& u, int wr, int wc, int fr, int fq) const {
        const int row0 = u.pm * BM + wr * 64 + fr, col0 = u.pn * BM + wc * 32 + 8 * fq;
#pragma unroll
        for (int ai = 0; ai < 2; ++ai)
#pragma unroll
            for (int m = 0; m < 4; ++m) { bf16_t* rowp = O + (size_t)(row0 + ai * HALF + m * 16) * ldc + col0;
                const float rs = ss ? __builtin_amdgcn_rsqf(ss[row0 + ai * HALF + m * 16] * (1.0f / 2048.0f) + 1e-6f) : 1.0f;
#pragma unroll
                for (int bj = 0; bj < 2; ++bj) { const f32x4 v0 = acc[ai][bj][m][0] * rs, v1 = acc[ai][bj][m][1] * rs;
                    u32x4 w; w.x = cvt_pk_bf16(v0[0], v0[1]); w.y = cvt_pk_bf16(v0[2], v0[3]); w.z = cvt_pk_bf16(v1[0], v1[1]); w.w = cvt_pk_bf16(v1[2], v1[3]);
                    *(u32x4*)(rowp + bj * HALF) = w; } }
    }
};
struct EpiSwiglu {
    static constexpr bool PERM = true, AFTER_DRAIN = false;
    bf16_t* H; int ldc; const float* ss;
    __device__ __forceinline__ void operator()(const f32x4 (&acc)[2][2][4][2], const Unit& u, int wr, int wc, int fr, int fq) const {
        const int row0 = u.pm * BM + wr * 64 + fr, col0 = u.pn * HALF + wc * 32 + 8 * fq;
#pragma unroll
        for (int ai = 0; ai < 2; ++ai)
#pragma unroll
            for (int m = 0; m < 4; ++m) { bf16_t* rowp = H + (size_t)(row0 + ai * HALF + m * 16) * ldc + col0;
                const float rs = ss ? __builtin_amdgcn_rsqf(ss[row0 + ai * HALF + m * 16] * (1.0f / 2048.0f) + 1e-6f) : 1.0f;
                float h[8];
#pragma unroll
                for (int n = 0; n < 2; ++n)
#pragma unroll
                    for (int j = 0; j < 4; ++j) { const float g = acc[ai][0][m][n][j] * rs, up = acc[ai][1][m][n][j] * rs; h[n * 4 + j] = g * sigm(g) * up; }
                u32x4 w; w.x = cvt_pk_bf16(h[0], h[1]); w.y = cvt_pk_bf16(h[2], h[3]); w.z = cvt_pk_bf16(h[4], h[5]); w.w = cvt_pk_bf16(h[6], h[7]);
                *(u32x4*)rowp = w; }
    }
};
template <bool BASEBF, bool OUTF32, bool OUTBF> struct EpiResid {
    static constexpr bool PERM = true, AFTER_DRAIN = false;
    const void* base; float* out; int ldc; float alpha; bf16_t* xb; float* ss;
    __device__ __forceinline__ void operator()(const f32x4 (&acc)[2][2][4][2], const Unit& u, int wr, int wc, int fr, int fq) const {
        const int row0 = u.pm * BM + wr * 64 + fr, col0 = u.pn * BM + wc * 32 + 8 * fq;
#pragma unroll
        for (int ai = 0; ai < 2; ++ai)
#pragma unroll
            for (int m = 0; m < 4; ++m) { const size_t off = (size_t)(row0 + ai * HALF + m * 16) * ldc + col0; float sq = 0.f;
#pragma unroll
                for (int bj = 0; bj < 2; ++bj) { f32x4 b0, b1;
                    if (BASEBF) { const u32x4 w = *(const u32x4*)((const bf16_t*)base + off + bj * HALF);
                        b0 = (f32x4){__uint_as_float(w.x << 16), __uint_as_float(w.x & 0xffff0000u), __uint_as_float(w.y << 16), __uint_as_float(w.y & 0xffff0000u)};
                        b1 = (f32x4){__uint_as_float(w.z << 16), __uint_as_float(w.z & 0xffff0000u), __uint_as_float(w.w << 16), __uint_as_float(w.w & 0xffff0000u)}; }
                    else { b0 = *(const f32x4*)((const float*)base + off + bj * HALF); b1 = *(const f32x4*)((const float*)base + off + bj * HALF + 4); }
                    const f32x4 o0 = b0 + acc[ai][bj][m][0] * alpha, o1 = b1 + acc[ai][bj][m][1] * alpha;
                    if (OUTF32) { *(f32x4*)(out + off + bj * HALF) = o0; *(f32x4*)(out + off + bj * HALF + 4) = o1; }
                    if (OUTBF) { sq += ((o0[0] * o0[0] + o0[1] * o0[1]) + (o0[2] * o0[2] + o0[3] * o0[3])) + ((o1[0] * o1[0] + o1[1] * o1[1]) + (o1[2] * o1[2] + o1[3] * o1[3]));
                        u32x4 w; w.x = cvt_pk_bf16(o0[0], o0[1]); w.y = cvt_pk_bf16(o0[2], o0[3]); w.z = cvt_pk_bf16(o1[0], o1[1]); w.w = cvt_pk_bf16(o1[2], o1[3]); *(u32x4*)(xb + off + bj * HALF) = w; } }
                if (OUTBF) { sq += __shfl_xor(sq, 16); sq += __shfl_xor(sq, 32); if (fq == 0) atomicAdd(ss + row0 + ai * HALF + m * 16, sq); } }
    }
};
template <int MODE> struct EpiGate {
    static constexpr bool PERM = true, AFTER_DRAIN = false;
    const bf16_t* G; bf16_t* T; int ldc;
    __device__ __forceinline__ void operator()(const f32x4 (&acc)[2][2][4][2], const Unit& u, int wr, int wc, int fr, int fq) const {
        const int row0 = u.pm * BM + wr * 64 + fr, col0 = u.pn * BM + wc * 32 + 8 * fq;
#pragma unroll
        for (int ai = 0; ai < 2; ++ai)
#pragma unroll
            for (int m = 0; m < 4; ++m) { const size_t off = (size_t)(row0 + ai * HALF + m * 16) * ldc + col0;
#pragma unroll
                for (int bj = 0; bj < 2; ++bj) { const u32x4 gw = *(const u32x4*)(G + off + bj * HALF); u32x4 tw = {0u, 0u, 0u, 0u}; if (MODE == 2) tw = *(const u32x4*)(T + off + bj * HALF);
                    float o[8];
#pragma unroll
                    for (int e = 0; e < 4; ++e) { const unsigned g2 = gw[e], t2 = tw[e]; const int n = e >> 1, j = (e & 1) * 2;
                        float a0 = sigm(__uint_as_float(g2 << 16)) * acc[ai][bj][m][n][j], a1 = sigm(__uint_as_float(g2 & 0xffff0000u)) * acc[ai][bj][m][n][j + 1];
                        if (MODE == 2) { a0 += __uint_as_float(t2 << 16); a1 += __uint_as_float(t2 & 0xffff0000u); }
                        o[2 * e] = a0; o[2 * e + 1] = a1; }
                    u32x4 w; w.x = cvt_pk_bf16(o[0], o[1]); w.y = cvt_pk_bf16(o[2], o[3]); w.z = cvt_pk_bf16(o[4], o[5]); w.w = cvt_pk_bf16(o[6], o[7]);
                    *(u32x4*)(T + off + bj * HALF) = w; } }
    }
};
template <class Epi, class Sched, bool ALIGN_EPI = false, bool SP2 = false>
__device__ __forceinline__ void gemm_phase(PG8_LAS unsigned char* lds, const Gemm g, const Sched& S, const Epi& E) {
    int tid_o = threadIdx.x; asm volatile("" : "+v"(tid_o));
    const int tid = tid_o, wid = __builtin_amdgcn_readfirstlane(tid >> 6), lane = tid & 63, wr = wid >> 2, wc = wid & 3, fr = lane & 15, fq = lane >> 4;
    const int K = g.K, nt = K / BK;
    unsigned voffA[2], voffB[2];
#pragma unroll
    for (int i = 0; i < 2; ++i) { int R, C; stage_rc(tid * 16 + i * 8192, R, C); const int Rb = Epi::PERM ? ((R & ~31) + perm32(R & 31)) : R;
        voffA[i] = (unsigned)(R * g.lda + C) * 2u; voffB[i] = (unsigned)(Rb * g.ldb + C) * 2u; }
    const size_t kstep = (size_t)(BK * 2);
    const size_t hstepA = (size_t)HALF * g.lda * 2, hstepB = (size_t)HALF * g.ldb * 2;
    const size_t tstepA = 2 * hstepA, tstepB = 2 * hstepB;
    const unsigned ldsw = (unsigned)wid * 1024u;
    const int aoff = lds_byte(wr * 64 + fr, fq * 8), boff = lds_byte(wc * 32 + fr, fq * 8);
#define PG8_SA(b, h) (((b) * 2 + (h)) * HTB)
#define PG8_SB(b, h) ((4 + (b) * 2 + (h)) * HTB)
#define PG8_STAGE(bufoff, gbase, voff) do { _Pragma("unroll") for (int _i = 0; _i < 2; ++_i) \
        __builtin_amdgcn_global_load_lds((const unsigned*)((const char*)(gbase) + (voff)[_i]), (PG8_LAS unsigned*)(lds + (bufoff) + ldsw + _i * 8192), 16, 0, 0); } while (0)
#define PG8_LDA(dst, b, h) do { _Pragma("unroll") for (int m = 0; m < 4; ++m) _Pragma("unroll") for (int k = 0; k < 2; ++k) dst[m][k] = *(const PG8_LAS bf16x8*)(lds + PG8_SA(b, h) + aoff + m * 2048 + k * 1024); } while (0)
#define PG8_LDB(dst, b, h) do { _Pragma("unroll") for (int n = 0; n < 2; ++n) _Pragma("unroll") for (int k = 0; k < 2; ++k) dst[n][k] = *(const PG8_LAS bf16x8*)(lds + PG8_SB(b, h) + boff + n * 2048 + k * 1024); } while (0)
#define PG8_MMA(ai, bj, At, Bt) do { __builtin_amdgcn_s_setprio(1); _Pragma("unroll") for (int m = 0; m < 4; ++m) _Pragma("unroll") for (int n = 0; n < 2; ++n) _Pragma("unroll") for (int k = 0; k < 2; ++k) \
        acc[ai][bj][m][n] = __builtin_amdgcn_mfma_f32_16x16x32_bf16(Bt[n][k], At[m][k], acc[ai][bj][m][n], 0, 0, 0); __builtin_amdgcn_s_setprio(0); } while (0)
#define PG8_WAIT_V(n) asm volatile("s_waitcnt vmcnt(" #n ")" ::: "memory")
#define PG8_WAIT_L(n) asm volatile("s_waitcnt lgkmcnt(" #n ")" ::: "memory")
#define PG8_BAR __builtin_amdgcn_s_barrier()
#define PG8_SCHED __builtin_amdgcn_sched_barrier(0)
    Unit cur, nxt; int ui = 0;
    if (!S.next(0, cur)) return;
    f32x4 acc[2][2][4][2];
#pragma unroll
    for (int a = 0; a < 2; ++a)
#pragma unroll
        for (int b = 0; b < 2; ++b)
#pragma unroll
            for (int m = 0; m < 4; ++m)
#pragma unroll
                for (int n = 0; n < 2; ++n) acc[a][b][m][n] = (f32x4){0.f, 0.f, 0.f, 0.f};
    bf16x8 At[4][2], B0[2][2], B1[2][2];
    const char* cA = (const char*)g.A + (size_t)cur.pm * tstepA; const char* cB = (const char*)g.Bt + (size_t)cur.pn * tstepB;
    S.a_ready(cur);
    if constexpr (SP2) {
        PG8_STAGE(PG8_SB(0, 0), cB, voffB); PG8_STAGE(PG8_SB(0, 1), cB + hstepB, voffB); PG8_STAGE(PG8_SA(0, 0), cA, voffA); PG8_STAGE(PG8_SA(0, 1), cA + hstepA, voffA);
        if (wr == 1) PG8_BAR;
        PG8_WAIT_V(2); PG8_BAR;
        PG8_STAGE(PG8_SB(1, 0), cB + kstep, voffB); PG8_STAGE(PG8_SA(1, 0), cA + kstep, voffA); PG8_STAGE(PG8_SB(1, 1), cB + hstepB + kstep, voffB);
        PG8_WAIT_V(6); PG8_BAR;
    } else {
        PG8_STAGE(PG8_SB(0, 0), cB, voffB); PG8_STAGE(PG8_SA(0, 0), cA, voffA); PG8_STAGE(PG8_SB(0, 1), cB + hstepB, voffB); PG8_STAGE(PG8_SA(0, 1), cA + hstepA, voffA);
        if (wr == 1) PG8_BAR;
        PG8_WAIT_V(4); PG8_BAR;
        PG8_STAGE(PG8_SB(1, 0), cB + kstep, voffB); PG8_STAGE(PG8_SA(1, 0), cA + kstep, voffA); PG8_STAGE(PG8_SB(1, 1), cB + hstepB + kstep, voffB);
        PG8_WAIT_V(6); PG8_BAR;
    }
    for (;;) {
        const bool has_next = S.next(ui + 1, nxt);
        const char* nA = has_next ? (const char*)g.A + (size_t)nxt.pm * tstepA : cA; const char* nB = has_next ? (const char*)g.Bt + (size_t)nxt.pn * tstepB : cB;
        for (int t = 0; t < nt; t += 2) {
            const bool last = (t == nt - 2);
            const char* a1 = cA + (size_t)(t + 1) * kstep;
            const char* a2 = last ? nA : cA + (size_t)(t + 2) * kstep; const char* b2 = last ? nB : cB + (size_t)(t + 2) * kstep;
            const char* a3 = a2 + kstep; const char* b3 = b2 + kstep;
            if (last && has_next) S.a_ready(nxt);
            if constexpr (SP2) {
            PG8_LDB(B0, 0, 0); PG8_LDB(B1, 0, 1); PG8_SCHED; PG8_LDA(At, 0, 0); PG8_STAGE(PG8_SA(1, 1), a1 + hstepA, voffA);
            PG8_WAIT_V(8); PG8_WAIT_L(0); PG8_BAR; PG8_MMA(0, 0, At, B0); PG8_MMA(0, 1, At, B1); PG8_BAR; PG8_SCHED;
            PG8_LDA(At, 0, 1); PG8_STAGE(PG8_SB(0, 0), b2, voffB); PG8_STAGE(PG8_SB(0, 1), b2 + hstepB, voffB); PG8_STAGE(PG8_SA(0, 0), a2, voffA);
            PG8_WAIT_V(8); PG8_WAIT_L(0); PG8_BAR; PG8_MMA(1, 0, At, B0); PG8_MMA(1, 1, At, B1); PG8_BAR; PG8_SCHED;
            PG8_LDB(B0, 1, 0); PG8_LDB(B1, 1, 1); PG8_SCHED; PG8_LDA(At, 1, 0); PG8_STAGE(PG8_SA(0, 1), a2 + hstepA, voffA);
            PG8_WAIT_V(8); PG8_WAIT_L(0); PG8_BAR; PG8_MMA(0, 0, At, B0); PG8_MMA(0, 1, At, B1); PG8_BAR; PG8_SCHED;
            PG8_LDA(At, 1, 1); PG8_STAGE(PG8_SB(1, 0), b3, voffB); PG8_STAGE(PG8_SB(1, 1), b3 + hstepB, voffB); PG8_STAGE(PG8_SA(1, 0), a3, voffA);
            PG8_WAIT_V(8); PG8_WAIT_L(0); PG8_BAR; PG8_MMA(1, 0, At, B0); PG8_MMA(1, 1, At, B1); PG8_BAR; PG8_SCHED;
            } else {
            PG8_LDB(B0, 0, 0); PG8_SCHED; PG8_LDA(At, 0, 0); PG8_STAGE(PG8_SA(1, 1), a1 + hstepA, voffA);
            PG8_WAIT_L(8); PG8_BAR; PG8_WAIT_L(0); PG8_MMA(0, 0, At, B0); PG8_BAR; PG8_SCHED;
            PG8_LDB(B1, 0, 1); PG8_STAGE(PG8_SB(0, 0), b2, voffB);
            PG8_BAR; PG8_WAIT_L(0); PG8_MMA(0, 1, At, B1); PG8_BAR;
            PG8_LDA(At, 0, 1); PG8_STAGE(PG8_SA(0, 0), a2, voffA);
            PG8_BAR; PG8_WAIT_L(0); PG8_MMA(1, 0, At, B0); PG8_BAR; PG8_SCHED;
            PG8_STAGE(PG8_SB(0, 1), b2 + hstepB, voffB);
            PG8_WAIT_V(6); PG8_BAR; PG8_MMA(1, 1, At, B1); PG8_BAR;
            PG8_LDB(B0, 1, 0); PG8_SCHED; PG8_LDA(At, 1, 0); PG8_STAGE(PG8_SA(0, 1), a2 + hstepA, voffA);
            PG8_WAIT_L(8); PG8_BAR; PG8_WAIT_L(0); PG8_MMA(0, 0, At, B0); PG8_BAR; PG8_SCHED;
            PG8_LDB(B1, 1, 1); PG8_STAGE(PG8_SB(1, 0), b3, voffB);
            PG8_BAR; PG8_WAIT_L(0); PG8_MMA(0, 1, At, B1); PG8_BAR;
            PG8_LDA(At, 1, 1); PG8_STAGE(PG8_SA(1, 0), a3, voffA);
            PG8_BAR; PG8_WAIT_L(0); PG8_MMA(1, 0, At, B0); PG8_BAR; PG8_SCHED;
            PG8_STAGE(PG8_SB(1, 1), b3 + hstepB, voffB);
            PG8_WAIT_V(6); PG8_BAR; PG8_MMA(1, 1, At, B1); PG8_BAR;
            }
        }
        if constexpr (ALIGN_EPI) { if (wr == 0) PG8_BAR; }
        if constexpr (!Epi::AFTER_DRAIN) { E(acc, cur, wr, wc, fr, fq); S.done(cur); }
        if (!has_next) break;
#pragma unroll
        for (int a = 0; a < 2; ++a)
#pragma unroll
            for (int b = 0; b < 2; ++b)
#pragma unroll
                for (int m = 0; m < 4; ++m)
#pragma unroll
                    for (int n = 0; n < 2; ++n) acc[a][b][m][n] = (f32x4){0.f, 0.f, 0.f, 0.f};
        cur = nxt; cA = nA; cB = nB; ++ui;
        if constexpr (ALIGN_EPI) { if (wr == 1) PG8_BAR; }
    }
    PG8_WAIT_V(0);
    if constexpr (!ALIGN_EPI) { if (wr == 0) PG8_BAR; }
    PG8_BAR;
    if constexpr (Epi::AFTER_DRAIN) { E.fused(acc, cur, wr, wc, fr, fq, lds, wid, lane); S.done(cur); }
#undef PG8_SA
#undef PG8_SB
#undef PG8_STAGE
#undef PG8_LDA
#undef PG8_LDB
#undef PG8_MMA
#undef PG8_WAIT_V
#undef PG8_WAIT_L
#undef PG8_BAR
#undef PG8_SCHED
}
}
namespace attn {
using bf16 = __hip_bfloat16;
typedef short bf16x8 __attribute__((ext_vector_type(8)));
typedef short s16x4 __attribute__((ext_vector_type(4)));
typedef float f32x16 __attribute__((ext_vector_type(16)));
typedef float f32x4 __attribute__((ext_vector_type(4)));
typedef unsigned u32x4 __attribute__((ext_vector_type(4)));
template <class A, class Bt> struct same_t { static constexpr bool v = false; };
template <class A> struct same_t<A, A> { static constexpr bool v = true; };
constexpr int D = 128, PITCH = PP;
constexpr float THR = 8.f;
constexpr bool WSKIP = false;
constexpr float SCALE = 0.08838834764831845f;
constexpr int NW = 8, QBLK = 32, KVBLK = 64, QB = NW * QBLK;
constexpr int SHM_V = KVBLK * D * 2, SHM_K = KVBLK * D * 2;
constexpr int ATT_LDS_BYTES = 2 * SHM_V + 2 * SHM_K + NW * 64 * 4;
#define KSWZ(row, colB) ((row) * 256 + ((colB) ^ (((row) & 7) << 4)))
#define SBAR() __builtin_amdgcn_sched_barrier(0)
__device__ __forceinline__ int v_st(int k, int c) { const int kk = (k & ~0xC) | ((k & 4) << 1) | ((k & 8) >> 1); return ((kk >> 3) * 4 + (c >> 5)) * 512 + ((kk & 7) * 32 + (c & 31)) * 2; }
__device__ __forceinline__ int v_rd_base(int lane) { return ((lane & 3) << 3) | (((lane >> 2) & 3) << 6) | (((lane >> 4) & 1) << 5) | (((lane >> 5) & 1) << 8); }
constexpr int v_rd_off(int d0, int ks, int half) { return d0 * 512 + ks * 4096 + half * 2048; }
__device__ __forceinline__ int crow(int r, int hi) { return (r & 3) + 8 * (r >> 2) + 4 * hi; }
__device__ __forceinline__ unsigned cvtpk(float lo, float hi) {
    unsigned r; asm volatile("v_cvt_pk_bf16_f32 %0, %1, %2" : "=v"(r) : "v"(lo), "v"(hi)); return r;
}
__device__ __forceinline__ bf16x8 pack8(f32x4 a, f32x4 b) {
    u32x4 w = {cvtpk(a[0], a[1]), cvtpk(a[2], a[3]), cvtpk(b[0], b[1]), cvtpk(b[2], b[3])};
    return *reinterpret_cast<bf16x8*>(&w);
}
template <class T> __device__ __forceinline__ bf16x8 load8(const T* p) {
    if constexpr (same_t<T, float>::v) { return pack8(*(const f32x4*)p, *(const f32x4*)(p + 4)); }
    else { return *reinterpret_cast<const bf16x8*>(p); }
}
__device__ __forceinline__ void mask_bits(f32x16& p0, f32x16& p1, unsigned long long mw, int hi) {
    const float NEG = -__builtin_inff();
    const unsigned a = (unsigned)mw >> (4 * hi), b = (unsigned)(mw >> 32) >> (4 * hi);
#pragma unroll
    for (int r = 0; r < 16; ++r) {
        const int c = (r & 3) + 8 * (r >> 2);
        if (!((a >> c) & 1u)) p0[r] = NEG;
        if (!((b >> c) & 1u)) p1[r] = NEG;
    }
}
__device__ __forceinline__ void partialSM(f32x16& p0, f32x16& p1, float& m_reg, float& mn, float& alpha) {
    float pmax = p0[0]; for (int r = 1; r < 16; ++r) pmax = fmaxf(pmax, p0[r]); for (int r = 0; r < 16; ++r) pmax = fmaxf(pmax, p1[r]);
    { auto rr = __builtin_amdgcn_permlane32_swap(__float_as_uint(pmax), __float_as_uint(pmax), false, false);
      pmax = fmaxf(__uint_as_float(rr[0]), __uint_as_float(rr[1])); }
    constexpr float C2 = 1.4426950408889634f * SCALE;
    if (__builtin_expect(__all((pmax - m_reg) * SCALE <= THR), 1)) { mn = m_reg; alpha = 1.f; }
    else { mn = fmaxf(m_reg, pmax); alpha = __builtin_amdgcn_exp2f((m_reg - mn) * C2); m_reg = mn; }
    const float mnL = -mn * C2;
    for (int r = 0; r < 16; ++r) p0[r] = fmaf(p0[r], C2, mnL); for (int r = 0; r < 16; ++r) p1[r] = fmaf(p1[r], C2, mnL);
    for (int r = 0; r < 16; ++r) p0[r] = __builtin_amdgcn_exp2f(p0[r]);
}
__device__ __forceinline__ void finishSM(f32x16& p0, f32x16& p1, float alpha, float& l_reg, bf16x8& pa0, bf16x8& pa1, bf16x8& pa2, bf16x8& pa3) {
    for (int r = 0; r < 16; ++r) p1[r] = __builtin_amdgcn_exp2f(p1[r]);
    float ps = 0; for (int r = 0; r < 16; ++r) ps += p0[r]; for (int r = 0; r < 16; ++r) ps += p1[r];
    { auto rr = __builtin_amdgcn_permlane32_swap(__float_as_uint(ps), __float_as_uint(ps), false, false);
      ps = __uint_as_float(rr[0]) + __uint_as_float(rr[1]); }
    l_reg = l_reg * alpha + ps;
#define PK4(P, B_, OUT) do { unsigned a0 = cvtpk(P[B_+0], P[B_+1]), a1 = cvtpk(P[B_+2], P[B_+3]);                          \
        unsigned b0 = cvtpk(P[B_+4], P[B_+5]), b1 = cvtpk(P[B_+6], P[B_+7]);                                             \
        auto r0 = __builtin_amdgcn_permlane32_swap(a0, b0, false, false); auto r1 = __builtin_amdgcn_permlane32_swap(a1, b1, false, false); \
        u32x4 w = {r0[0], r1[0], r0[1], r1[1]}; OUT = *reinterpret_cast<bf16x8*>(&w); } while (0)
    PK4(p0, 0, pa0); PK4(p0, 8, pa1); PK4(p1, 0, pa2); PK4(p1, 8, pa3);
#undef PK4
}
template <int KB, bool SK>
__device__ __forceinline__ void qkt(f32x16& p0, f32x16& p1, const char* K_lds, int r32, int hi, const bf16x8* qr, bool act) {
    if (SK && !act) { const float NEG = -__builtin_inff();
#pragma unroll
        for (int r = 0; r < 16; ++r) { p0[r] = NEG; p1[r] = NEG; } return; }
    p0 = f32x16{}; p1 = f32x16{};
    const char* kb[4];
#pragma unroll
    for (int dd = 0; dd < 4; ++dd) kb[dd] = K_lds + KB * SHM_K + KSWZ(r32, (dd * 16 + hi * 8) * 2);
#pragma unroll
    for (int d0 = 0; d0 < 8; ++d0) { const char* a = kb[d0 & 3] + (d0 >> 2) * 128;
        bf16x8 b0 = *reinterpret_cast<const bf16x8*>(a);
        bf16x8 b1 = *reinterpret_cast<const bf16x8*>(a + 32 * 256);
        p0 = __builtin_amdgcn_mfma_f32_32x32x16_bf16(b0, qr[d0], p0, 0, 0, 0);
        p1 = __builtin_amdgcn_mfma_f32_32x32x16_bf16(b1, qr[d0], p1, 0, 0, 0); }
}
template <int VB, bool SK>
__device__ __forceinline__ void pv_tile(f32x16* o, int vb0, bf16x8 pa0, bf16x8 pa1, bf16x8 pa2, bf16x8 pa3, bool act) {
    if (SK && !act) return;
#define TRRD(dst, off) asm volatile("ds_read_b64_tr_b16 %0, %1 offset:%2" : "=&v"(dst) : "v"(vb0), "i"(off) : "memory")
#define PV_D0(d0) do { s16x4 l0, l1, l2, l3, h0, h1, h2, h3; constexpr int b_ = VB * SHM_V + v_rd_off(d0, 0, 0);     \
        TRRD(l0, b_); TRRD(h0, b_ + 2048); TRRD(l1, b_ + 4096); TRRD(h1, b_ + 6144); TRRD(l2, b_ + 8192); TRRD(h2, b_ + 10240); TRRD(l3, b_ + 12288); TRRD(h3, b_ + 14336); \
        asm volatile("s_waitcnt lgkmcnt(0)" ::: "memory"); SBAR();                 \
        o[d0] = __builtin_amdgcn_mfma_f32_32x32x16_bf16(pa0, (bf16x8){l0[0], l0[1], l0[2], l0[3], h0[0], h0[1], h0[2], h0[3]}, o[d0], 0, 0, 0);   \
        o[d0] = __builtin_amdgcn_mfma_f32_32x32x16_bf16(pa1, (bf16x8){l1[0], l1[1], l1[2], l1[3], h1[0], h1[1], h1[2], h1[3]}, o[d0], 0, 0, 0);   \
        o[d0] = __builtin_amdgcn_mfma_f32_32x32x16_bf16(pa2, (bf16x8){l2[0], l2[1], l2[2], l2[3], h2[0], h2[1], h2[2], h2[3]}, o[d0], 0, 0, 0);   \
        o[d0] = __builtin_amdgcn_mfma_f32_32x32x16_bf16(pa3, (bf16x8){l3[0], l3[1], l3[2], l3[3], h3[0], h3[1], h3[2], h3[3]}, o[d0], 0, 0, 0); } while (0)
    PV_D0(0); PV_D0(1); PV_D0(2); PV_D0(3);
#undef PV_D0
#undef TRRD
}
template <class TIn, class TOut> struct BlockRef { const TIn* Q; const TIn* K; const TIn* V; TOut* O; const unsigned long long* MK; int P0; };
template <class TIn> struct Seam {
    bf16x8 qr[8];
    bf16x8 st_v0, st_v1, st_k0, st_k1; f32x4 sf0, sf1, sf2, sf3;
    f32x4 tq[16];
};
__device__ __forceinline__ int swa_jlo(int P0, int W) { const int lowk = P0 - W + 1; return lowk > 0 ? lowk / KVBLK : 0; }
#define ROW(p, k0, rr) ((p) + (size_t)((k0) + (rr)) * PITCH + sc)
#define VMW() asm volatile("s_waitcnt vmcnt(0)" ::: "memory")
#define VMWN(n) asm volatile("s_waitcnt vmcnt(%0)" :: "i"(n) : "memory")
#define SLOAD_H(Kp, Vp, k0) do { S.st_v0 = load8<TIn>(ROW(Vp, k0, sr)); S.st_v1 = load8<TIn>(ROW(Vp, k0, 32 + sr));              \
                         S.st_k0 = load8<TIn>(ROW(Kp, k0, sr)); S.st_k1 = load8<TIn>(ROW(Kp, k0, 32 + sr)); } while (0)
#define SWRITE_HK(bf) do { *(bf16x8*)(K_lds + (bf) * SHM_K + kws) = S.st_k0; *(bf16x8*)(K_lds + (bf) * SHM_K + kws + 32 * 256) = S.st_k1; } while (0)
#define SWRITE_HV(bf) do { *(bf16x8*)(V_lds + (bf) * SHM_V + vst0) = S.st_v0; *(bf16x8*)(V_lds + (bf) * SHM_V + vst1) = S.st_v1; } while (0)
#define SWRITE_H(bf) do { SWRITE_HV(bf); SWRITE_HK(bf); } while (0)
#define SLOAD_F(p, k0) do { S.sf0 = *(const f32x4*)ROW(p, k0, sr); S.sf1 = *(const f32x4*)(ROW(p, k0, sr) + 4);                \
                            S.sf2 = *(const f32x4*)ROW(p, k0, 32 + sr); S.sf3 = *(const f32x4*)(ROW(p, k0, 32 + sr) + 4); } while (0)
#define SWRITE_KF(bf) do { *(bf16x8*)(K_lds + (bf) * SHM_K + kws) = pack8(S.sf0, S.sf1); *(bf16x8*)(K_lds + (bf) * SHM_K + kws + 32 * 256) = pack8(S.sf2, S.sf3); } while (0)
#define SWRITE_VF(bf) do { *(bf16x8*)(V_lds + (bf) * SHM_V + vst0) = pack8(S.sf0, S.sf1); *(bf16x8*)(V_lds + (bf) * SHM_V + vst1) = pack8(S.sf2, S.sf3); } while (0)
template <class TIn, class TOut>
__device__ __forceinline__ void causal_swa_prime(const BlockRef<TIn, TOut>& cur, int W, char* lds, Seam<TIn>& S) {
    constexpr bool F32 = same_t<TIn, float>::v;
    const int tid = threadIdx.x, wid = __builtin_amdgcn_readfirstlane(tid >> 6), lane = tid & 63, r32 = lane & 31, hi = lane >> 5;
    const int sr = tid >> 4, sc = (tid & 15) * 8, kws = KSWZ(sr, sc * 2); char* K_lds = lds + 2 * SHM_V;
    const int kb0 = swa_jlo(cur.P0, W) * KVBLK;
    for (int d0 = 0; d0 < 8; ++d0) S.qr[d0] = load8<TIn>(cur.Q + (size_t)(wid * QBLK + r32) * PITCH + d0 * 16 + hi * 8);
    if constexpr (F32) { SLOAD_F((const float*)cur.K, kb0); VMW(); SWRITE_KF(0); SBAR(); SLOAD_F((const float*)cur.V, kb0); }
    else { SLOAD_H(cur.K, cur.V, kb0); VMW(); SWRITE_HK(0); }
    __syncthreads();
}
template <class TIn, class TOut>
__device__ __forceinline__ void causal_swa_block(const BlockRef<TIn, TOut>& cur, const BlockRef<TIn, TOut>& nxt, int skv, int W, char* lds, Seam<TIn>& S) {
    constexpr bool F32 = same_t<TIn, float>::v;
    const int tid = threadIdx.x, wid = __builtin_amdgcn_readfirstlane(tid >> 6), lane = tid & 63, r32 = lane & 31, hi = lane >> 5;
    const int j_lo = swa_jlo(cur.P0, W);
    int j_hi = (cur.P0 + QB - 1) / KVBLK + 1; if (j_hi > skv / KVBLK) j_hi = skv / KVBLK;
    const int NT = j_hi - j_lo;
    const int kbn = swa_jlo(nxt.P0, W) * KVBLK;
    const int qlo = cur.P0 + wid * QBLK, qm = qlo + r32 - 4 * hi;
    char* V_lds = lds; char* K_lds = lds + 2 * SHM_V;
    float* ws = (float*)(lds + 2 * SHM_V + 2 * SHM_K) + wid * 64; float* li_l = ws, * al_l = ws + 32;
    float m_reg = -1e30f, l_reg = 0; f32x16 o[4] = {};
    const int sr = tid >> 4, sc = (tid & 15) * 8, vst0 = v_st(sr, sc), vst1 = v_st(32 + sr, sc), kws = KSWZ(sr, sc * 2);
    const int vb0 = (int)(uintptr_t)V_lds + v_rd_base(lane);
    const TIn* Kh = cur.K; const TIn* Vh = cur.V;
    const unsigned long long* mrow = cur.MK + (size_t)(wid * QBLK + r32) * 128; unsigned long long mwA, mwB = 0ull;
#define RESC(a) do { if (__any((a) < 1.f)) { if (hi == 0) al_l[r32] = (a); asm volatile("s_waitcnt lgkmcnt(0)" ::: "memory");              \
                     for (int d_ = 0; d_ < 4; ++d_) for (int r = 0; r < 16; ++r) o[d_][r] *= al_l[crow(r, hi)]; } } while (0)
#define KBASE(t) ((j_lo + (t)) * KVBLK)
#define ACT(t) (KBASE(t) <= qlo + QBLK - 1 && KBASE(t) + KVBLK - 1 >= qlo - W + 1)
#define MASKT(P0_, P1_, MW_) mask_bits(P0_, P1_, MW_, hi)
    constexpr int NQL = F32 ? 16 : 8;
    constexpr bool SK = WSKIP && !F32;
#define SEAM_K0() do { VMWN(NQL); if constexpr (F32) { SWRITE_KF(0); SBAR(); SLOAD_F((const float*)nxt.V, kbn); } else { SWRITE_HK(0); } SBAR(); } while (0)
    f32x16 pA0, pA1, pB0, pB1; float mnA, mnB, alA, alB; bf16x8 pa0, pa1, pa2, pa3;
    if constexpr (F32) { VMW(); SWRITE_VF(0); SBAR(); } else { SWRITE_HV(0); SBAR(); }
    if (NT > 1) { if constexpr (F32) SLOAD_F((const float*)Kh, KBASE(1)); else SLOAD_H(Kh, Vh, KBASE(1)); }
    mwA = mrow[0]; SBAR(); qkt<0, SK>(pA0, pA1, K_lds, r32, hi, S.qr, ACT(0));
    if constexpr (F32) { if (NT > 1) { VMW(); SWRITE_KF(1); SBAR(); SLOAD_F((const float*)Vh, KBASE(1)); } }
    MASKT(pA0, pA1, mwA); partialSM(pA0, pA1, m_reg, mnA, alA);
    if (NT > 1) { VMW(); if constexpr (F32) { SWRITE_VF(1); SBAR(); if (NT > 2) SLOAD_F((const float*)Kh, KBASE(2)); } else SWRITE_H(1); }
    __syncthreads();
#define HALF_STEP(PX0, PX1, mnX, alX, PY0, PY1, alY, t, KB, VB, SB, MWX) do {                                                      \
        MWX = mrow[(t)]; SBAR(); qkt<KB, SK>(PX0, PX1, K_lds, r32, hi, S.qr, ACT(t));                                             \
        finishSM(PY0, PY1, alY, l_reg, pa0, pa1, pa2, pa3); SBAR();                                                           \
        if ((t) + 1 < NT) { if constexpr (F32) { VMW(); SWRITE_KF(SB); SBAR(); SLOAD_F((const float*)Vh, KBASE((t) + 1)); }  \
                            else { SLOAD_H(Kh, Vh, KBASE((t) + 1)); } SBAR(); }                                               \
        pv_tile<VB, SK>(o, vb0, pa0, pa1, pa2, pa3, ACT((t) - 1)); MASKT(PX0, PX1, MWX); partialSM(PX0, PX1, m_reg, mnX, alX);                                        \
        __syncthreads();                                                                                                      \
        if ((t) + 1 < NT) { VMW(); if constexpr (F32) { SWRITE_VF(SB); SBAR(); if ((t) + 2 < NT) SLOAD_F((const float*)Kh, KBASE((t) + 2)); } \
                            else { SWRITE_H(SB); } }                                                                          \
        RESC(alX); __syncthreads(); } while (0)
    for (int t = 1; t + 1 < NT; t += 2) {
        HALF_STEP(pB0, pB1, mnB, alB, pA0, pA1, alA, t, 1, 0, 0, mwB);
        HALF_STEP(pA0, pA1, mnA, alA, pB0, pB1, alB, t + 1, 0, 1, 1, mwA);
    }
    const bool even = (NT & 1) == 0;
    if (even) { mwB = mrow[NT - 1]; SBAR(); qkt<1, SK>(pB0, pB1, K_lds, r32, hi, S.qr, ACT(NT - 1)); SBAR(); }
#define QROW(e) (nxt.Q + (size_t)(wid * QBLK + r32) * PITCH + ((e) >> 1) * 16 + hi * 8 + ((e) & 1) * 4)
    if constexpr (F32) { SLOAD_F((const float*)nxt.K, kbn); SBAR();
#pragma unroll
        for (int e = 0; e < 8; ++e) S.tq[e] = *(const f32x4*)QROW(e); }
    else { SLOAD_H(nxt.K, nxt.V, kbn); SBAR();
#pragma unroll
        for (int d0 = 0; d0 < 8; ++d0) S.qr[d0] = load8<TIn>(nxt.Q + (size_t)(wid * QBLK + r32) * PITCH + d0 * 16 + hi * 8); }
    SBAR();
    finishSM(pA0, pA1, alA, l_reg, pa0, pa1, pa2, pa3); SBAR();
    if constexpr (F32) {
#pragma unroll
        for (int e = 8; e < 16; ++e) S.tq[e] = *(const f32x4*)QROW(e); SBAR(); }
#undef QROW
    pv_tile<0, SK>(o, vb0, pa0, pa1, pa2, pa3, ACT(even ? NT - 2 : NT - 1));
    if (even) { MASKT(pB0, pB1, mwB); partialSM(pB0, pB1, m_reg, mnB, alB); __syncthreads(); RESC(alB);
        finishSM(pB0, pB1, alB, l_reg, pa0, pa1, pa2, pa3); SBAR(); pv_tile<1, SK>(o, vb0, pa0, pa1, pa2, pa3, ACT(NT - 1)); }
    SBAR(); SEAM_K0();
    if (hi == 0) li_l[r32] = l_reg; asm volatile("s_waitcnt lgkmcnt(0)" ::: "memory");
    float rli[16];
#pragma unroll
    for (int r = 0; r < 16; ++r) rli[r] = __builtin_amdgcn_rcpf(li_l[crow(r, hi)]);
    TOut* Ow = cur.O + (size_t)(wid * QBLK) * PITCH;
#pragma unroll
    for (int r = 0; r < 16; ++r) { const int orow = crow(r, hi);
#pragma unroll
        for (int d0 = 0; d0 < 4; ++d0) { const float v = o[d0][r] * rli[r];
            if constexpr (same_t<TOut, float>::v) { Ow[(size_t)orow * PITCH + d0 * 32 + r32] = v; }
            else { const float vn = __shfl_xor(v, 1);
                   if ((r32 & 1) == 0) *(unsigned*)(Ow + (size_t)orow * PITCH + d0 * 32 + r32) = cvtpk(v, vn); } } }
    if constexpr (F32) {
#pragma unroll
        for (int d0 = 0; d0 < 8; ++d0) S.qr[d0] = pack8(S.tq[2 * d0], S.tq[2 * d0 + 1]); }
    __syncthreads();
#undef RESC
#undef KBASE
#undef ACT
#undef MASKT
#undef SEAM_K0
#undef HALF_STEP
}
#undef ROW
#undef VMW
#undef VMWN
#undef SLOAD_H
#undef SWRITE_HK
#undef SWRITE_HV
#undef SWRITE_H
#undef SLOAD_F
#undef SWRITE_KF
#undef SWRITE_VF

#undef KSWZ
#undef SBAR
}

struct Params { const float* in[21]; float* out; unsigned char* ws; };
__constant__ float ROPE_INVF[24] = { 1.000000000e+00f, 4.403665960e-01f, 1.939227432e-01f, 8.539710194e-02f, 3.760603070e-02f, 1.656044088e-02f, 7.292664610e-03f, 3.211446106e-03f,
    1.414213562e-03f, 6.227724371e-04f, 2.742481884e-04f, 1.207697351e-04f, 5.318295734e-05f, 2.341999971e-05f, 1.031338525e-05f, 4.541670478e-06f,
    1.000000000e+00f, 1.939227432e-01f, 3.760603070e-02f, 7.292664610e-03f, 1.414213562e-03f, 2.742481884e-04f, 5.318295734e-05f, 1.031338525e-05f };
constexpr int CW_IDXQ = 64;
constexpr int CW_BAR = 4096;
#define XCD_BAR_WORDS 3456

#define LDS_WAIT() asm volatile("s_waitcnt lgkmcnt(0)" ::: "memory")

__device__ __forceinline__ int rowmap(int mode, int c) {
    if (mode == 1) return ((c >> 7) << 8) + (c & 127);
    if (mode == 2) return ((c >> 7) << 8) + 128 + (c & 127);
    if (mode == 3) return c < 4176 ? c : c + 176;
    return c;
}
__device__ __forceinline__ void transpose_item(const float* __restrict__ W, int K, int N, bf16raw* WT, int mode, LAS float* scr, int item, int lane, const float* __restrict__ gain = nullptr) {
    const int nblk = (N + 63) >> 6, kb = item / nblk, nb = item - kb * nblk, k0 = 64 * kb, n0 = 64 * nb;
    const int nn = n0 + (lane & 15) * 4; const bool ok = nn + 3 < N;
#pragma unroll 8
    for (int i = 0; i < 16; ++i) { const int kk = 4 * i + (lane >> 4); f32x4_t v = {0.f, 0.f, 0.f, 0.f}; if (ok) v = *(const f32x4_t*)(W + (size_t)(k0 + kk) * N + nn);
        if (gain) v = v * gain[k0 + kk];
        LAS float* d = scr + kk * 65 + (lane & 15) * 4; d[0] = v.x; d[1] = v.y; d[2] = v.z; d[3] = v.w; }
    LDS_WAIT();
    const int c = lane & 7;
#pragma unroll
    for (int j = 0; j < 8; ++j) { const int n = (lane >> 3) + 8 * j; const LAS float* s = scr + (8 * c) * 65 + n;
        u32x4_t o; o.x = pkbf(s[0 * 65], s[1 * 65]); o.y = pkbf(s[2 * 65], s[3 * 65]); o.z = pkbf(s[4 * 65], s[5 * 65]); o.w = pkbf(s[6 * 65], s[7 * 65]);
        if (n0 + n < N) *(u32x4_t*)(WT + (size_t)rowmap(mode, n0 + n) * K + k0 + 8 * c) = o; }
    LDS_WAIT();
}
__device__ __forceinline__ void rms_row(const float* __restrict__ xrow, const float* __restrict__ g, bf16raw* orow, int lane) {
    f32x4_t v[8]; float s = 0.f;
#pragma unroll
    for (int j = 0; j < 8; ++j) { v[j] = ((const f32x4_t*)xrow)[64 * j + lane]; s += (v[j].x * v[j].x + v[j].y * v[j].y) + (v[j].z * v[j].z + v[j].w * v[j].w); }
    const float r = 1.0f / sqrtf(wave_sum(s) * (1.0f / DM) + EPS);
#pragma unroll
    for (int j = 0; j < 8; ++j) { const f32x4_t gv = ((const f32x4_t*)g)[64 * j + lane]; u32x2_t o; o.x = pkbf(v[j].x * r * gv.x, v[j].y * r * gv.y); o.y = pkbf(v[j].z * r * gv.z, v[j].w * r * gv.w);
        ((u32x2_t*)orow)[64 * j + lane] = o; }
}
__device__ __forceinline__ void rms_phase(const float* x, const float* g, bf16raw* xn, int gw, int ngw, int lane) {
    for (int m = gw; m < MTOK; m += ngw) rms_row(x + (size_t)m * DM, g, xn + (size_t)m * DM, lane);
}
__device__ __forceinline__ void p0_prologue(const Params& P, LAS unsigned char* lds, int tid, int lane, int wave) {
    unsigned char* ws = P.ws;
    LAS float* scr = (LAS float*)(lds + wave * 16640);
    const int gw = blockIdx.x * NWAVES + wave, ngw = gridDim.x * NWAVES;
    constexpr int I_G = 32 * 88, I_D = 88 * 32, I_IN = 32 * 162, I_UA = 16 * 32, I_OUT = 32 * 32;
    constexpr int NITEMS = 4 * I_G + 2 * I_D + I_IN + 2 * I_UA + I_OUT;
    for (int it = gw; it < NITEMS; it += ngw) {
        int r = it;
        if (r < I_G) { transpose_item(P.in[3], DM, DFF, (bf16raw*)(ws + WS_WGU1), 1, scr, r, lane); continue; } r -= I_G;
        if (r < I_G) { transpose_item(P.in[4], DM, DFF, (bf16raw*)(ws + WS_WGU1), 2, scr, r, lane); continue; } r -= I_G;
        if (r < I_D) { transpose_item(P.in[5], DFF, DM, (bf16raw*)(ws + WS_WD1), 0, scr, r, lane); continue; } r -= I_D;
        if (r < I_G) { transpose_item(P.in[18], DM, DFF, (bf16raw*)(ws + WS_WGU2), 1, scr, r, lane, P.in[17]); continue; } r -= I_G;
        if (r < I_G) { transpose_item(P.in[19], DM, DFF, (bf16raw*)(ws + WS_WGU2), 2, scr, r, lane, P.in[17]); continue; } r -= I_G;
        if (r < I_D) { transpose_item(P.in[20], DFF, DM, (bf16raw*)(ws + WS_WD2), 0, scr, r, lane); continue; } r -= I_D;
        if (r < I_IN) { transpose_item(P.in[7], DM, 10320, (bf16raw*)(ws + WS_WIN), 3, scr, r, lane, P.in[6]); continue; } r -= I_IN;
        if (r < I_UA) { transpose_item(P.in[14], 1024, DM, (bf16raw*)(ws + WS_WUA), 0, scr, r, lane); continue; } r -= I_UA;
        if (r < I_UA) { transpose_item(P.in[15], 1024, DM, (bf16raw*)(ws + WS_WUS), 0, scr, r, lane); continue; } r -= I_UA;
        transpose_item(P.in[16], DM, DM, (bf16raw*)(ws + WS_WOUT), 0, scr, r, lane);
    }
    const int gt = blockIdx.x * NTHR + tid, ngt = gridDim.x * NTHR;
    { u32x4_t* padp = (u32x4_t*)((bf16raw*)(ws + WS_WIN) + (size_t)4176 * DM);
      for (int i = gt; i < 176 * DM / 8; i += ngt) padp[i] = (u32x4_t){0u, 0u, 0u, 0u}; }
    { const float* w_s = P.in[12]; bf16raw* wsb = (bf16raw*)(ws + WS_WSB);
      for (int i = gt; i < 8 * 128 * 128; i += ngt) { const int s = i & 127, t = (i >> 7) & 127; const float v = (t < 64 && s >= 64) ? 0.f : w_s[i]; wsb[i] = (bf16raw)(pkbf(v, 0.f) & 0xffffu); } }
    if (blockIdx.x == 0 && tid < 128) ((unsigned*)(ws + WS_CTL))[tid] = 0u;
    if (blockIdx.x == 0) { unsigned* bw = (unsigned*)(ws + WS_CTL) + CW_BAR; for (int i = tid; i < XCD_BAR_WORDS; i += NTHR) bw[i] = 0u; }
    { float* ssz = (float*)(ws + WS_SS1); for (int i = gt; i < 2 * MTOK; i += ngt) ssz[i] = 0.f; }
    rms_phase(P.in[0], P.in[2], (bf16raw*)(ws + WS_XN), gw, ngw, lane);
}

template <class Epi> __device__ __forceinline__ void run_gemm(LAS unsigned char* lds, const bf16raw* A, int lda, const bf16raw* Bt, int ldb, int N, int K, const Epi& E) {
    pg8::Gemm g{A, Bt, MTOK, N, K, lda, ldb}; pg8::StaticOrder S; S.init(MTOK, N, (int)gridDim.x, (int)blockIdx.x);
    pg8::gemm_phase<Epi, pg8::StaticOrder, true, true>(lds, g, S, E);
}

__device__ __forceinline__ void ld16(const bf16raw* p, float (&v)[16]) {
    const u32x4_t a = *(const u32x4_t*)p, b = *(const u32x4_t*)(p + 8);
#pragma unroll
    for (int e = 0; e < 4; ++e) { v[2 * e] = bflo(a[e]); v[2 * e + 1] = bfhi(a[e]); v[8 + 2 * e] = bflo(b[e]); v[8 + 2 * e + 1] = bfhi(b[e]); }
}
__device__ __forceinline__ void st16(bf16raw* p, const float (&v)[16]) {
    u32x4_t a, b;
#pragma unroll
    for (int e = 0; e < 4; ++e) { a[e] = pkbf(v[2 * e], v[2 * e + 1]); b[e] = pkbf(v[8 + 2 * e], v[8 + 2 * e + 1]); }
    *(u32x4_t*)p = a; *(u32x4_t*)(p + 8) = b;
}
__device__ __forceinline__ void unp16(const u32x4_t a, const u32x4_t b, float (&v)[16]) {
#pragma unroll
    for (int e = 0; e < 4; ++e) { v[2 * e] = bflo(a[e]); v[2 * e + 1] = bfhi(a[e]); v[8 + 2 * e] = bflo(b[e]); v[8 + 2 * e + 1] = bfhi(b[e]); }
}
struct PrepRaw { u32x4_t q0, q1, k0, k1, i0, i1, s0, s1, u0, u1; unsigned ki, wi; int pos; };
__device__ __forceinline__ PrepRaw prep_load(const Params& P, int m, int lane) {
    const bf16raw* row = (const bf16raw*)(P.ws + WS_PROJ) + (size_t)m * PP; PrepRaw r;
    r.q0 = *(const u32x4_t*)(row + C_Q + lane * 16); r.q1 = *(const u32x4_t*)(row + C_Q + lane * 16 + 8);
    r.k0 = *(const u32x4_t*)(row + C_K + lane * 16); r.k1 = *(const u32x4_t*)(row + C_K + lane * 16 + 8);
    r.i0 = *(const u32x4_t*)(row + C_QI + lane * 16); r.i1 = *(const u32x4_t*)(row + C_QI + lane * 16 + 8);
    r.s0 = *(const u32x4_t*)(row + C_VS + lane * 16); r.s1 = *(const u32x4_t*)(row + C_VS + lane * 16 + 8);
    r.u0 = *(const u32x4_t*)(row + C_U + lane * 16); r.u1 = *(const u32x4_t*)(row + C_U + lane * 16 + 8);
    r.ki = row[C_KI + lane]; r.wi = row[C_WI + (lane & 15)]; r.pos = ((const int*)P.in[1])[m];
    return r;
}
__device__ __forceinline__ void prep_token(const Params& P, int m, const PrepRaw& R, int lane) {
    bf16raw* row = (bf16raw*)(P.ws + WS_PROJ) + (size_t)m * PP;
    float cs = 1.f, sn = 0.f;
    { const float ang = (float)R.pos * ROPE_INVF[lane < 24 ? lane : 0]; double rev = (double)ang * 0.15915494309189535; rev -= rint(rev); const float fr = (float)rev;
      sn = __builtin_amdgcn_sinf(fr); cs = __builtin_amdgcn_cosf(fr); }
    float cA[16], sA[16];
#pragma unroll
    for (int i = 0; i < 16; ++i) { cA[i] = __shfl(cs, i); sA[i] = __shfl(sn, i); }
    const int sub = lane & 7; const bool rot = sub < 2; const float sg = sub == 0 ? -1.f : 1.f;
#pragma unroll
    for (int which = 0; which < 2; ++which) {
        bf16raw* p = row + (which ? C_K : C_Q) + lane * 16; const float* g = (which ? P.in[9] : P.in[8]) + sub * 16;
        float v[16]; if (which) unp16(R.k0, R.k1, v); else unp16(R.q0, R.q1, v);
        float ss = 0.f;
#pragma unroll
        for (int i = 0; i < 16; ++i) ss += v[i] * v[i];
        ss += __shfl_xor(ss, 1); ss += __shfl_xor(ss, 2); ss += __shfl_xor(ss, 4);
        const float r = 1.0f / sqrtf(ss * (1.0f / 128.0f) + EPS);
#pragma unroll
        for (int i = 0; i < 16; ++i) v[i] = v[i] * r * g[i];
#pragma unroll
        for (int i = 0; i < 16; ++i) { const float o = __shfl_xor(v[i], 1); const float rr = v[i] * cA[i] + sg * o * sA[i]; v[i] = rot ? rr : v[i]; }
        st16(p, v);
    }
    { bf16raw* p = row + C_QI + lane * 16; float v[16]; unp16(R.i0, R.i1, v);
      const bool r0 = (lane & 3) == 0;
#pragma unroll
      for (int i = 0; i < 8; ++i) { const float ci = __shfl(cs, 16 + i), si = __shfl(sn, 16 + i); const float x1 = v[i], x2 = v[8 + i];
          v[i] = r0 ? x1 * ci - x2 * si : x1; v[8 + i] = r0 ? x2 * ci + x1 * si : x2; }
      st16(p, v);
      float y = bf2f((unsigned short)R.ki); const float ss = wave_sum(y * y);
      y = y * (1.0f / sqrtf(ss * (1.0f / 64.0f) + EPS)) * P.in[10][lane];
      const float o = __shfl_xor(y, 8), cc = __shfl(cs, 16 + (lane & 7)), s2 = __shfl(sn, 16 + (lane & 7));
      y = lane < 8 ? y * cc - o * s2 : (lane < 16 ? y * cc + o * s2 : y);
      ((bf16raw*)(P.ws + WS_KI))[((size_t)(m >> 5) * 256 + (lane >> 4) * 64 + ((lane >> 3) & 1) * 32 + (m & 31)) * 8 + (lane & 7)] = (bf16raw)(pkbf(y, 0.f) & 0xffffu);
      if (lane < 16) ((float*)(P.ws + WS_WI))[(size_t)m * 16 + lane] = bf2f((unsigned short)R.wi);
    }
    { bf16raw* p = row + C_U + lane * 16; float v[16]; unp16(R.u0, R.u1, v);
#pragma unroll
      for (int i = 0; i < 16; ++i) v[i] = gelu_tanh_f(v[i]);
      st16(p, v); }
    { bf16raw* p = row + C_VS + lane * 16; float v[16]; unp16(R.s0, R.s1, v); float ss = 0.f;
#pragma unroll
      for (int i = 0; i < 16; ++i) { v[i] = gelu_tanh_f(v[i]); ss += v[i] * v[i]; }
      const float r = 1.0f / sqrtf(wave_sum(ss) * (1.0f / 1024.0f) + EPS); const float* g = P.in[11] + lane * 16;
#pragma unroll
      for (int i = 0; i < 16; ++i) v[i] = v[i] * r * g[i];
      st16(p, v); }
}

__device__ __forceinline__ void sgu_phase(const Params& P, LAS unsigned char* lds, int tid, int lane, int wave) {
    bf16raw* proj = (bf16raw*)(P.ws + WS_PROJ); const bf16raw* wsb = (const bf16raw*)(P.ws + WS_WSB); const float* bs = P.in[13];
    LAS bf16raw* VT = (LAS bf16raw*)lds;
    const int r32 = lane & 31, hi = lane >> 5, tr = wave & 3, ch = wave >> 2;
    for (int item = blockIdx.x; item < 2048; item += gridDim.x) {
        const int g = item & 7, tok0 = (item >> 3) * 128;
#pragma unroll
        for (int i = 0; i < 4; ++i) { const int id = tid + 512 * i, s = id & 127, cc = (id >> 7) * 8;
            const u32x4_t w = *(const u32x4_t*)(proj + (size_t)(tok0 + s) * PP + C_VS + g * 128 + cc);
#pragma unroll
            for (int e = 0; e < 4; ++e) { VT[(cc + 2 * e) * 136 + s] = (bf16raw)(w[e] & 0xffffu); VT[(cc + 2 * e + 1) * 136 + s] = (bf16raw)(w[e] >> 16); } }
        __syncthreads();
        f32x16_t acc[2]; acc[0] = f32x16_t{}; acc[1] = f32x16_t{};
#pragma unroll
        for (int ks = 0; ks < 8; ++ks) {
            const bf16x8_t a = *(const bf16x8_t*)(wsb + (size_t)g * 16384 + (32 * tr + r32) * 128 + 16 * ks + 8 * hi);
#pragma unroll
            for (int nt = 0; nt < 2; ++nt) { const bf16x8_t b = *(const LAS bf16x8_t*)(VT + (64 * ch + 32 * nt + r32) * 136 + 16 * ks + 8 * hi);
                acc[nt] = __builtin_amdgcn_mfma_f32_32x32x16_bf16(a, b, acc[nt], 0, 0, 0); }
        }
#pragma unroll
        for (int nt = 0; nt < 2; ++nt)
#pragma unroll
            for (int r = 0; r < 16; ++r) { const int t = 32 * tr + (r & 3) + 8 * (r >> 2) + 4 * hi; bf16raw* up = proj + (size_t)(tok0 + t) * PP + C_U + g * 128 + 64 * ch + 32 * nt + r32;
                const float y = bf2f(*up) * (acc[nt][r] + bs[g * 128 + t]); *up = (bf16raw)(pkbf(y, 0.f) & 0xffffu); }
        __syncthreads();
    }
}

__device__ __forceinline__ bool radix_pick(const LAS unsigned* h, int k, int lane, int& d, int& kn, int& cnt) {
    const u32x4_t c = *(const LAS u32x4_t*)(h + 4 * lane);
    const unsigned t = c.x + c.y + c.z + c.w;
    int pv = (int)t;
    pv += __builtin_amdgcn_update_dpp(0, pv, 0x111, 0xf, 0xf, false);
    pv += __builtin_amdgcn_update_dpp(0, pv, 0x112, 0xf, 0xf, false);
    pv += __builtin_amdgcn_update_dpp(0, pv, 0x114, 0xf, 0xf, false);
    pv += __builtin_amdgcn_update_dpp(0, pv, 0x118, 0xf, 0xf, false);
    pv += __builtin_amdgcn_update_dpp(0, pv, 0x142, 0xa, 0xf, false);
    pv += __builtin_amdgcn_update_dpp(0, pv, 0x143, 0xc, 0xf, false);
    const unsigned total = (unsigned)__builtin_amdgcn_readlane(pv, 63);
    unsigned gt = total - (unsigned)pv; int dsel = -1; unsigned knn = 0u, cc = 0u; const unsigned kr = (unsigned)k;
    { const unsigned ge = gt + c.w; if (gt < kr && kr <= ge) { dsel = 4 * lane + 3; knn = kr - gt; cc = c.w; } gt = ge; }
    { const unsigned ge = gt + c.z; if (gt < kr && kr <= ge) { dsel = 4 * lane + 2; knn = kr - gt; cc = c.z; } gt = ge; }
    { const unsigned ge = gt + c.y; if (gt < kr && kr <= ge) { dsel = 4 * lane + 1; knn = kr - gt; cc = c.y; } gt = ge; }
    { const unsigned ge = gt + c.x; if (gt < kr && kr <= ge) { dsel = 4 * lane + 0; knn = kr - gt; cc = c.x; } gt = ge; }
    const unsigned long long bal = __ballot(dsel >= 0);
    if (bal == 0ull) return false;
    const int src = __builtin_amdgcn_readfirstlane(__ffsll((long long)bal) - 1);
    d = __builtin_amdgcn_readlane(dsel, src); kn = __builtin_amdgcn_readlane((int)knn, src); cnt = __builtin_amdgcn_readlane((int)cc, src);
    return true;
}
constexpr int IDX_LCAP = 2048;
template <int NJ> __device__ __forceinline__ void idx_select(const unsigned* __restrict__ sc, int nj, int wend, unsigned long long* mrow, LAS unsigned* hist, LAS unsigned* list, int lane) {
    unsigned u[NJ];
#pragma unroll
    for (int j = 0; j < NJ; ++j) u[j] = sc[j * 64 + lane];
#pragma unroll
    for (int j = 0; j < NJ; ++j) u[j] = (j < nj) ? u[j] : 0u;
    unsigned prefix = 0u; int krem = 256, d = 0, kn = 0, cnt = 0;
    hist[lane] = 0u; hist[lane + 64] = 0u; hist[lane + 128] = 0u; hist[lane + 192] = 0u;
    LDS_WAIT();
    { int njp = nj; asm volatile("" : "+s"(njp));
#pragma unroll
      for (int j = 0; j < NJ; ++j) { if (j < njp) __hip_atomic_fetch_add(hist + (u[j] >> 24), 1u, __ATOMIC_RELAXED, __HIP_MEMORY_SCOPE_WORKGROUP); } }
    LDS_WAIT();
    if (!radix_pick(hist, krem, lane, d, kn, cnt)) return;
    prefix = (unsigned)d << 24; krem = kn;
    if (cnt <= IDX_LCAP) {
        int base = 0;
        { int njp = nj; asm volatile("" : "+s"(njp));
#pragma unroll
          for (int j = 0; j < NJ; ++j) { if (j < njp) { const bool m = (u[j] >> 24) == (unsigned)d; const unsigned long long bal = __ballot(m);
                if (bal != 0ull) { if (m) list[base + (int)__builtin_amdgcn_mbcnt_hi((unsigned)(bal >> 32), __builtin_amdgcn_mbcnt_lo((unsigned)bal, 0u))] = u[j]; base += __popcll(bal); } } } }
        LDS_WAIT();
#pragma unroll 1
        for (int pass = 1; pass < 4; ++pass) {
            const int shift = 24 - 8 * pass; const unsigned himask = 0xffffffffu << (shift + 8);
            hist[lane] = 0u; hist[lane + 64] = 0u; hist[lane + 128] = 0u; hist[lane + 192] = 0u;
            LDS_WAIT();
            for (int i0 = lane; i0 < base; i0 += 256) {
                unsigned v[4]; bool ok[4];
#pragma unroll
                for (int q4 = 0; q4 < 4; ++q4) { const int i = i0 + 64 * q4; ok[q4] = i < base; v[q4] = list[ok[q4] ? i : 0]; }
#pragma unroll
                for (int q4 = 0; q4 < 4; ++q4) { if (ok[q4] && ((v[q4] ^ prefix) & himask) == 0u) __hip_atomic_fetch_add(hist + ((v[q4] >> shift) & 255u), 1u, __ATOMIC_RELAXED, __HIP_MEMORY_SCOPE_WORKGROUP); }
            }
            LDS_WAIT();
            if (!radix_pick(hist, krem, lane, d, kn, cnt)) break;
            prefix |= (unsigned)d << shift; krem = kn;
        }
    } else {
#pragma unroll 1
        for (int pass = 1; pass < 4; ++pass) {
            const int shift = 24 - 8 * pass; const unsigned himask = 0xffffffffu << (shift + 8);
            int njp = nj; asm volatile("" : "+s"(njp));
            hist[lane] = 0u; hist[lane + 64] = 0u; hist[lane + 128] = 0u; hist[lane + 192] = 0u;
            LDS_WAIT();
#pragma unroll
            for (int j = 0; j < NJ; ++j) { if (j < njp) { if (((u[j] ^ prefix) & himask) == 0u) __hip_atomic_fetch_add(hist + ((u[j] >> shift) & 255u), 1u, __ATOMIC_RELAXED, __HIP_MEMORY_SCOPE_WORKGROUP); } }
            LDS_WAIT();
            if (!radix_pick(hist, krem, lane, d, kn, cnt)) break;
            prefix |= (unsigned)d << shift; krem = kn;
        }
    }
    const unsigned thr = prefix; unsigned wl0 = 0u, wh0 = 0u, wl1 = 0u, wh1 = 0u; int total = 0;
#pragma unroll
    for (int j = 0; j < NJ; ++j) {
        const unsigned long long word = __ballot(u[j] >= thr);
        total += __popcll(word);
        { const unsigned wlo_ = (unsigned)__builtin_amdgcn_readfirstlane((int)(unsigned)word), whi_ = (unsigned)__builtin_amdgcn_readfirstlane((int)(unsigned)(word >> 32));
          if (j < 64) { asm volatile("v_writelane_b32 %0, %1, %2" : "+v"(wl0) : "s"(wlo_), "n"(j & 63)); asm volatile("v_writelane_b32 %0, %1, %2" : "+v"(wh0) : "s"(whi_), "n"(j & 63)); }
          else { asm volatile("v_writelane_b32 %0, %1, %2" : "+v"(wl1) : "s"(wlo_), "n"(j & 63)); asm volatile("v_writelane_b32 %0, %1, %2" : "+v"(wh1) : "s"(whi_), "n"(j & 63)); } }
    }
    if (__builtin_amdgcn_readfirstlane(total) != 256) {
        int taken = 0;
#pragma unroll
        for (int j = 0; j < NJ; ++j) {
            unsigned long long word = __ballot(u[j] > thr);
            unsigned long long e = __ballot(u[j] == thr);
            if (e != 0ull) { const int need = krem - taken;
                if (need > 0) { int n = __popcll(e); unsigned long long sel = e;
                    if (n > need) { sel = 0ull; for (int t2 = 0; t2 < need; ++t2) { const unsigned long long b = e & (~e + 1ull); sel |= b; e ^= b; } n = need; }
                    word |= sel; taken += n; } }
            { const unsigned wlo_ = (unsigned)__builtin_amdgcn_readfirstlane((int)(unsigned)word), whi_ = (unsigned)__builtin_amdgcn_readfirstlane((int)(unsigned)(word >> 32));
              if (j < 64) { asm volatile("v_writelane_b32 %0, %1, %2" : "+v"(wl0) : "s"(wlo_), "n"(j & 63)); asm volatile("v_writelane_b32 %0, %1, %2" : "+v"(wh0) : "s"(whi_), "n"(j & 63)); }
              else { asm volatile("v_writelane_b32 %0, %1, %2" : "+v"(wl1) : "s"(wlo_), "n"(j & 63)); asm volatile("v_writelane_b32 %0, %1, %2" : "+v"(wh1) : "s"(whi_), "n"(j & 63)); } }
        }
    }
    if (lane < wend) mrow[lane] = ((unsigned long long)wh0 << 32) | wl0;
    if (NJ > 64) { if (lane + 64 < wend) mrow[lane + 64] = ((unsigned long long)wh1 << 32) | wl1; }
}

__device__ __forceinline__ float relu_i(float x) { const int b = __float_as_int(x); return __int_as_float(b > 0 ? b : 0); }
__device__ __forceinline__ f32x16_t idx_chain(const bf16x8_t (&Af)[4], const bf16x8_t (&B4)[4]) {
    f32x16_t acc = f32x16_t{};
#pragma unroll
    for (int s = 0; s < 4; ++s) acc = __builtin_amdgcn_mfma_f32_32x32x16_bf16(Af[s], B4[s], acc, 0, 0, 0);
    return acc;
}
__device__ __forceinline__ unsigned idx_score_key(const f32x16_t& acc, const f32x4_t (&wv)[4]) {
    float sc0 = 0.f, sc1 = 0.f;
#pragma unroll
    for (int i = 0; i < 16; i += 2) { sc0 += relu_i(acc[i]) * wv[i >> 2][i & 3]; sc1 += relu_i(acc[i + 1]) * wv[(i + 1) >> 2][(i + 1) & 3]; }
    const unsigned bts = __float_as_uint(sc0 + sc1);
    return bts ^ ((unsigned)((int)bts >> 31) | 0x80000000u);
}
template <bool FULL> __device__ __forceinline__ void idx_rt_block(const bf16x8_t (&Bf)[8][4], const bf16x8_t (&Af)[4], const f32x4_t (&wv)[4], unsigned* srow, int tile0, int ntile) {
    if (FULL) {
        f32x16_t accA = idx_chain(Af, Bf[0]), accB;
#pragma unroll
        for (int kt = 0; kt < 8; ++kt) {
            if (kt + 1 < 8) accB = idx_chain(Af, Bf[kt + 1]);
            srow[(tile0 + kt * 8) * 32] = idx_score_key(accA, wv);
            if (kt + 1 < 8) {
#pragma unroll
                for (int s = 0; s < 4; ++s) { __builtin_amdgcn_sched_group_barrier(0x008, 1, 0); __builtin_amdgcn_sched_group_barrier(0x002, 10, 0); }
            }
            accA = accB;
        }
    } else {
#pragma unroll
        for (int kt = 0; kt < 8; ++kt) { const int tile = tile0 + kt * 8;
            if (tile < ntile) { const f32x16_t acc = idx_chain(Af, Bf[kt]); srow[tile * 32] = idx_score_key(acc, wv); } }
    }
}
__device__ __forceinline__ void indexer_phase(const Params& P, LAS unsigned char* lds, int tid, int lane, int wave) {
    unsigned char* ws = P.ws;
    const bf16raw* proj = (const bf16raw*)(ws + WS_PROJ); const bf16raw* KI = (const bf16raw*)(ws + WS_KI); const float* WIf = (const float*)(ws + WS_WI);
    unsigned long long* MASK = (unsigned long long*)(ws + WS_MASK); unsigned* ctl = (unsigned*)(ws + WS_CTL);
    float* scratch = P.out + (size_t)blockIdx.x * (16 * 8192);
    LAS unsigned* list = (LAS unsigned*)(lds + 45056) + wave * IDX_LCAP;
    LAS float* WL = (LAS float*)(lds + 32768); LAS unsigned* hist = (LAS unsigned*)(lds + 33792) + wave * 256; volatile LAS int* itemw = (volatile LAS int*)(lds + 41984);
    const int r32 = lane & 31, hi = lane >> 5;
    if (blockIdx.x >= 256) return;
    for (;;) {
        if (tid == 0) *itemw = (int)atomicAdd(ctl + CW_IDXQ, 1u);
        __syncthreads();
        const int it = *itemw;
        __syncthreads();
        if (it >= 2048) break;
        const int qt = 511 - (it >> 2), b = it & 3, q0 = qt * 16, n_adm = ((q0 >> 6) + 1) * 64, wend = ((q0 >> 8) + 1) * 4, tok0 = b * SEQ + q0;
        if (n_adm <= 256) {
            if (tid < 64) { const int q = tid >> 2, j = tid & 3; MASK[(size_t)(tok0 + q) * 128 + j] = (j < (n_adm >> 6)) ? ~0ull : 0ull; }
            continue;
        }
        for (int c = tid; c < 2048; c += NTHR) { const int l = c & 63, s = (c >> 6) & 3, rt = c >> 8, rho = l & 31, hf = l >> 5, par = (rho >> 2) & 1, head = (rho & 3) + 4 * (rho >> 3);
            *(LAS u32x4_t*)(lds + c * 16) = *(const u32x4_t*)(proj + (size_t)(tok0 + 2 * rt + par) * PP + C_QI + head * 64 + 16 * s + 8 * hf); }
        if (tid < 256) WL[tid] = WIf[(size_t)tok0 * 16 + tid];
        __syncthreads();
        const int ntile = n_adm >> 5, npass = (ntile + 63) >> 6;
        for (int p = 0; p < npass; ++p) {
            bf16x8_t Bf[8][4];
#pragma unroll
            for (int kt = 0; kt < 8; ++kt) { const int tile = p * 64 + kt * 8 + wave;
                const int tcl = tile < ntile ? tile : ntile - 1;
                const bf16raw* kp = KI + ((size_t)((b * SEQ >> 5) + tcl) * 256 + lane) * 8;
#pragma unroll
                for (int s = 0; s < 4; ++s) Bf[kt][s] = *(const bf16x8_t*)(kp + 512 * s); }
            const int tile0 = p * 64 + wave; const bool full = tile0 + 56 < ntile;
#pragma unroll 1
            for (int rt = 0; rt < 8; ++rt) {
                bf16x8_t Af[4];
#pragma unroll
                for (int s = 0; s < 4; ++s) Af[s] = *(const LAS bf16x8_t*)(lds + ((rt * 4 + s) * 64 + lane) * 16);
                f32x4_t wv[4];
#pragma unroll
                for (int e = 0; e < 4; ++e) wv[e] = *(const LAS f32x4_t*)(WL + (2 * rt + hi) * 16 + 4 * e);
                unsigned* srow = (unsigned*)scratch + (2 * rt + hi) * 8192 + r32;
                if (full) idx_rt_block<true>(Bf, Af, wv, srow, tile0, ntile); else idx_rt_block<false>(Bf, Af, wv, srow, tile0, ntile);
            }
        }
        __syncthreads();
        const int nj = n_adm >> 6;
#pragma unroll 1
        for (int qq = 2 * wave; qq < 2 * wave + 2; ++qq) {
            const unsigned* sc = (const unsigned*)scratch + qq * 8192; unsigned long long* mrow = MASK + (size_t)(tok0 + qq) * 128;
            int njq = nj; asm volatile("" : "+s"(njq));
            if (njq <= 16) idx_select<16>(sc, njq, wend, mrow, hist, list, lane);
            else if (njq <= 32) idx_select<32>(sc, njq, wend, mrow, hist, list, lane);
            else if (njq <= 64) idx_select<64>(sc, njq, wend, mrow, hist, list, lane);
            else idx_select<128>(sc, njq, wend, mrow, hist, list, lane);
        }
        __syncthreads();
    }
}

__device__ __forceinline__ attn::BlockRef<attn::bf16, attn::bf16> att_ref(unsigned char* ws, int bi) {
    const int G_ = (int)gridDim.x, bx_ = (int)blockIdx.x, vg = (G_ % 8 == 0) ? (bx_ & 7) * (G_ >> 3) + (bx_ >> 3) : bx_;
    const int item = vg + (bi >> 1) * G_, bh = item >> 4, pr = item & 15, qb = (bi & 1) ? 31 - pr : pr, b = bh >> 3, h = bh & 7;
    attn::bf16* proj = (attn::bf16*)(ws + WS_PROJ); const size_t tokb = (size_t)b * SEQ;
    attn::BlockRef<attn::bf16, attn::bf16> r;
    r.Q = proj + (tokb + qb * 256) * PP + C_Q + h * 128; r.K = proj + tokb * PP + C_K + h * 128; r.V = proj + tokb * PP + C_V + h * 128;
    r.O = proj + (tokb + qb * 256) * PP + C_Q + h * 128; r.MK = (const unsigned long long*)(ws + WS_MASK) + (tokb + qb * 256) * 128; r.P0 = qb * 256;
    return r;
}
__device__ __forceinline__ void attn_phase(unsigned char* ws, char* lds) {
    const int nitems = (int)blockIdx.x < 512 ? (512 - (int)blockIdx.x + (int)gridDim.x - 1) / (int)gridDim.x : 0, nb = 2 * nitems;
    if (nb == 0) return;
    attn::Seam<attn::bf16> S;
    { const auto r0 = att_ref(ws, 0); attn::causal_swa_prime<attn::bf16, attn::bf16>(r0, SEQ, lds, S); }
    for (int bi = 0; bi < nb; ++bi) {
        const auto cur = att_ref(ws, bi); const auto nxt = att_ref(ws, bi + 1 < nb ? bi + 1 : bi);
        attn::causal_swa_block<attn::bf16, attn::bf16>(cur, nxt, SEQ, SEQ, lds, S);
    }
}

#define XB_TMO      128
#define XB_XCNT(j)  (256  + 64 * (j))
#define XB_XSUB(j)  (1280 + 64 * (j))
#define XB_XGEN(j)  (2304 + 64 * (j))
#define XB_TOP      3328
#define XB_TOPGEN   3392
#define XB_SPIN_CAP (1u << 18)

__device__ __forceinline__ unsigned xb_ld(unsigned* p)              { return __hip_atomic_load(p, __ATOMIC_RELAXED, __HIP_MEMORY_SCOPE_AGENT); }
__device__ __forceinline__ unsigned xb_add(unsigned* p, unsigned v) { return __hip_atomic_fetch_add(p, v, __ATOMIC_RELAXED, __HIP_MEMORY_SCOPE_AGENT); }
__device__ __forceinline__ unsigned xb_xcc_id() { return (unsigned)__builtin_amdgcn_s_getreg((3 << 11) | 20) & 0xFu; }
#define XB_SPIN(cond, bar) do { unsigned _sp = 0; while (cond) { __builtin_amdgcn_s_sleep(1); \
    if ((++_sp & 255u) == 0u) { if (xb_ld(&(bar)[XB_TMO])) break; if (_sp > XB_SPIN_CAP) { atomicAdd(&(bar)[XB_TMO], 1u); break; } } } } while (0)

struct XcdBarrier {
    unsigned* bar; unsigned x;
    volatile LAS unsigned* st;
};

__device__ __forceinline__ XcdBarrier xcd_barrier_post(unsigned* bar, volatile LAS unsigned* st) {
    XcdBarrier b; b.bar = bar; b.x = xb_xcc_id(); b.st = st;
    if (threadIdx.x == 0) (void)xb_add(&bar[XB_XCNT(b.x)], 1u);
    return b;
}
__device__ __forceinline__ void xcd_barrier_complete(unsigned* bar, unsigned x, unsigned& nloc, unsigned& nx) {
    const unsigned G = gridDim.x * gridDim.y * gridDim.z;
    unsigned sum, cnt, mine, sp = 0u;
    for (;;) {
        sum = 0u; cnt = 0u; mine = 0u;
#pragma unroll
        for (unsigned j = 0; j < 16; ++j) { const unsigned c = xb_ld(&bar[XB_XCNT(j)]); sum += c; cnt += (c > 0u) ? 1u : 0u; mine = (j == x) ? c : mine; }
        if (sum == G) break;
        __builtin_amdgcn_s_sleep(1);
        if ((++sp & 255u) == 0u) { if (xb_ld(&bar[XB_TMO])) break; if (sp > XB_SPIN_CAP) { atomicAdd(&bar[XB_TMO], 1u); break; } }
    }
    nloc = mine > 0u ? mine : 1u; nx = cnt > 0u ? cnt : 1u;
}

__device__ __forceinline__ void xcd_barrier(const XcdBarrier& b) {
    asm volatile("s_waitcnt vmcnt(0)" ::: "memory");
    __syncthreads();
    if (threadIdx.x == 0) {
        unsigned* bar = b.bar;
        __builtin_amdgcn_s_waitcnt(0);
        unsigned nloc = b.st[0], nx = b.st[1];
        if (nloc == 0u) { xcd_barrier_complete(bar, b.x, nloc, nx); b.st[0] = nloc; b.st[1] = nx; }
        const unsigned old = xb_add(&bar[XB_XSUB(b.x)], 1u);
        const unsigned gen = old / nloc;
        if (old + 1u == (gen + 1u) * nloc) {
            __builtin_amdgcn_fence(__ATOMIC_RELEASE, "agent");
            asm volatile("s_waitcnt vmcnt(0)" ::: "memory");
            const unsigned og = xb_add(&bar[XB_TOP], 1u);
            const unsigned tg = og / nx;
            if (og + 1u == (tg + 1u) * nx) xb_add(&bar[XB_TOPGEN], 1u);
            else XB_SPIN(xb_ld(&bar[XB_TOPGEN]) == tg, bar);
            __builtin_amdgcn_fence(__ATOMIC_ACQUIRE, "agent");
            xb_add(&bar[XB_XGEN(b.x)], 1u);
            asm volatile("s_waitcnt vmcnt(0)" ::: "memory");
        } else {
            XB_SPIN(xb_ld(&bar[XB_XGEN(b.x)]) == gen, bar);
            __builtin_amdgcn_fence(__ATOMIC_ACQUIRE, "agent");
            asm volatile("s_waitcnt vmcnt(0)" ::: "memory");
        }
    }
    __syncthreads();
}

__global__ void __launch_bounds__(NTHR, 2) fwd_kernel(Params P) {
    extern __shared__ __attribute__((aligned(16))) unsigned char lds_raw[];
    cg::grid_group grid = cg::this_grid();
    LAS unsigned char* lds = (LAS unsigned char*)lds_raw;
    const int tid = threadIdx.x, lane = tid & 63, wave = __builtin_amdgcn_readfirstlane(tid >> 6);
    const int gw = blockIdx.x * NWAVES + wave, ngw = gridDim.x * NWAVES;
    unsigned char* ws = P.ws;
    bf16raw* XN = (bf16raw*)(ws + WS_XN); bf16raw* PROJ = (bf16raw*)(ws + WS_PROJ); bf16raw* HB = PROJ;
    float* out = P.out; float* SS1 = (float*)(ws + WS_SS1); float* SS2 = SS1 + MTOK;

    volatile LAS unsigned* bst = (volatile LAS unsigned*)(lds + LDS_BYTES - 64);
    if (tid == 0) { bst[0] = 0u; bst[1] = 0u; }
    __syncthreads();
    p0_prologue(P, lds, tid, lane, wave);
    grid.sync();
    const XcdBarrier xbar = xcd_barrier_post((unsigned*)(ws + WS_CTL) + CW_BAR, bst);
#define GSYNC() xcd_barrier(xbar)
    { pg8::EpiSwiglu E{HB, DFF, nullptr}; run_gemm(lds, XN, DM, (const bf16raw*)(ws + WS_WGU1), DM, 2 * DFF, DM, E); }
    GSYNC();
    { pg8::EpiResid<false, false, true> E{P.in[0], nullptr, DM, 0.5f, XN, SS1}; run_gemm(lds, HB, DFF, (const bf16raw*)(ws + WS_WD1), DFF, DM, DFF, E); }
    GSYNC();
    { pg8::EpiStore E{PROJ, PP, SS1}; run_gemm(lds, XN, DM, (const bf16raw*)(ws + WS_WIN), DM, PP, DM, E); }
    GSYNC();
    if (gw < MTOK) { PrepRaw cur = prep_load(P, gw, lane);
#pragma unroll 1
      for (int m = gw; m < MTOK; m += ngw) { const int mn = m + ngw; const PrepRaw nxt = prep_load(P, mn < MTOK ? mn : m, lane); prep_token(P, m, cur, lane); cur = nxt; } }
    GSYNC();
    sgu_phase(P, lds, tid, lane, wave);
    indexer_phase(P, lds, tid, lane, wave);
    GSYNC();
    attn_phase(ws, (char*)lds_raw);
    GSYNC();
    { pg8::EpiGate<1> E{PROJ + C_GA, PROJ + C_GA, PP}; run_gemm(lds, PROJ + C_Q, PP, (const bf16raw*)(ws + WS_WUA), 1024, DM, 1024, E); }
    { pg8::EpiGate<2> E{PROJ + C_GB, PROJ + C_GA, PP}; run_gemm(lds, PROJ + C_U, PP, (const bf16raw*)(ws + WS_WUS), 1024, DM, 1024, E); }
    GSYNC();
    { pg8::EpiResid<true, false, true> E{XN, nullptr, DM, 1.0f, XN, SS2}; run_gemm(lds, PROJ + C_GA, PP, (const bf16raw*)(ws + WS_WOUT), DM, DM, DM, E); }
    GSYNC();
    { pg8::EpiSwiglu E{HB, DFF, SS2}; run_gemm(lds, XN, DM, (const bf16raw*)(ws + WS_WGU2), DM, 2 * DFF, DM, E); }
    GSYNC();
    { pg8::EpiResid<true, true, false> E{XN, out, DM, 0.5f, nullptr, nullptr}; run_gemm(lds, HB, DFF, (const bf16raw*)(ws + WS_WD2), DFF, DM, DFF, E); }
}

extern "C" void kernel_launch(void* const* d_in, const int* in_sizes, int n_in, void* d_out, int out_size, void* d_ws, size_t ws_size, hipStream_t stream) {
    static int grid = 0;
    if (grid == 0) {
        if (n_in != 21 || ws_size < WS_END) { fprintf(stderr, "kernel_launch: unexpected n_in %d / ws %zu\n", n_in, ws_size); grid = -1; return; }
        int dev = 0, cus = 0, per_cu = 0;
        (void)hipGetDevice(&dev); (void)hipDeviceGetAttribute(&cus, hipDeviceAttributeMultiprocessorCount, dev);
        if (hipFuncSetAttribute((const void*)fwd_kernel, hipFuncAttributeMaxDynamicSharedMemorySize, LDS_BYTES) != hipSuccess) fprintf(stderr, "kernel_launch: hipFuncSetAttribute failed\n");
        if (hipOccupancyMaxActiveBlocksPerMultiprocessor(&per_cu, (const void*)fwd_kernel, NTHR, LDS_BYTES) != hipSuccess || per_cu < 1) fprintf(stderr, "kernel_launch: occupancy query says %d\n", per_cu);
        (void)hipGetLastError();
        grid = cus > 256 ? 256 : cus; if (grid < 1) grid = 256;
    }
    if (grid < 0) return;
    Params p{};
    for (int i = 0; i < 21; ++i) p.in[i] = (const float*)d_in[i];
    p.out = (float*)d_out; p.ws = (unsigned char*)d_ws;
    void* args[] = {&p};
    const hipError_t e = hipLaunchCooperativeKernel((const void*)fwd_kernel, dim3(grid), dim3(NTHR), args, LDS_BYTES, stream);
    if (e != hipSuccess) fprintf(stderr, "cooperative launch failed: %s (grid %d)\n", hipGetErrorString(e), grid);
}
```

```cpp
#include <hip/hip_runtime.h>
#include <hip/hip_cooperative_groups.h>
#include <hip/hip_bf16.h>
#include <cstdio>
#include <cstdint>
#include <cmath>
namespace cg = cooperative_groups;

constexpr int BATCH = 4, SEQ = 8192, DM = 2048, MTOK = BATCH * SEQ, DFF = 5632;
constexpr int PP = 10496;
constexpr int C_Q = 0, C_K = 1024, C_V = 2048, C_QI = 3072, C_KI = 4096, C_WI = 4160, C_U = 4352, C_VS = 5376, C_GA = 6400, C_GB = 8448;
constexpr float EPS = 1e-6f;
constexpr int NWAVES = 8, NTHR = 512;
constexpr size_t MiB = 1u << 20;
constexpr size_t WS_CTL = 0, WS_SS1 = 256 * 1024  , WS_WSB = 1 * MiB, WS_KI = 2 * MiB, WS_WI = 6 * MiB, WS_WGU1 = 8 * MiB, WS_WD1 = 52 * MiB, WS_WGU2 = 74 * MiB, WS_WD2 = 118 * MiB,
                 WS_WIN = 140 * MiB, WS_WUA = 181 * MiB, WS_WUS = 185 * MiB, WS_WOUT = 189 * MiB, WS_MASK = 197 * MiB, WS_XN = 229 * MiB, WS_PROJ = 357 * MiB, WS_END = 1013 * MiB;
static_assert(WS_PROJ + (size_t)MTOK * PP * 2 <= WS_END && WS_XN + (size_t)MTOK * DM * 2 <= WS_PROJ && WS_MASK + (size_t)MTOK * 128 * 8 <= WS_XN, "ws map");
constexpr int LDS_BYTES = 147456;

typedef unsigned short bf16raw;
typedef unsigned u32x4_t __attribute__((ext_vector_type(4)));
typedef unsigned u32x2_t __attribute__((ext_vector_type(2)));
typedef float f32x4_t __attribute__((ext_vector_type(4)));
typedef float f32x16_t __attribute__((ext_vector_type(16)));
typedef short bf16x8_t __attribute__((ext_vector_type(8)));
#define LAS __attribute__((address_space(3)))

__device__ __forceinline__ float bf2f(unsigned short b) { return __uint_as_float((unsigned)b << 16); }
__device__ __forceinline__ float bflo(unsigned w) { return __uint_as_float(w << 16); }
__device__ __forceinline__ float bfhi(unsigned w) { return __uint_as_float(w & 0xffff0000u); }
__device__ __forceinline__ unsigned pkbf(float lo, float hi) { unsigned r; asm volatile("v_cvt_pk_bf16_f32 %0, %1, %2" : "=v"(r) : "v"(lo), "v"(hi)); return r; }
__device__ __forceinline__ float fast_sigmoid(float x) { return __builtin_amdgcn_rcpf(1.0f + __builtin_amdgcn_exp2f(-1.4426950408889634f * x)); }
__device__ __forceinline__ float silu_f(float x) { return x * fast_sigmoid(x); }
__device__ __forceinline__ float gelu_tanh_f(float x) { const float z2 = 1.5957691216057308f * (x + 0.044715f * x * x * x); return x * fast_sigmoid(z2); }
__device__ __forceinline__ float wave_sum(float v) {
#pragma unroll
    for (int o = 1; o < 64; o <<= 1) v += __shfl_xor(v, o);
    return v;
}
namespace pg8 {
#define PG8_LAS __attribute__((address_space(3)))
typedef unsigned short bf16_t;
typedef short bf16x8 __attribute__((ext_vector_type(8)));
typedef float f32x4 __attribute__((ext_vector_type(4)));
typedef unsigned u32x4 __attribute__((ext_vector_type(4)));
constexpr int BM = 256, BK = 64, HALF = 128, HTB = HALF * BK * 2  , STAGE_BYTES = 8 * HTB, NXCD = 8, WGM = 8;

__host__ __device__ __forceinline__ int lds_byte(int r, int c) { const int st = (r >> 4) * 2 + (c >> 5), rr = r & 15, cc = c & 31, ob = rr * 64 + cc * 2; return st * 1024 + (ob ^ (((ob >> 9) & 1) << 5)); }
__host__ __device__ __forceinline__ void stage_rc(int b, int& R, int& C) { const int st = b / 1024, sb = b % 1024, swz = sb ^ (((sb >> 9) & 1) << 5); R = (st >> 1) * 16 + swz / 64; C = (st & 1) * 32 + (swz % 64) / 2; }
__host__ __device__ __forceinline__ int perm32(int rho) { const int n = rho >> 4, i = rho & 15; return 8 * (i >> 2) + 4 * n + (i & 3); }

struct Unit { int pm, pn; };
struct Gemm { const bf16_t* A; const bf16_t* Bt; int M, N, K, lda, ldb; };

struct StaticOrder {
    int nM, nN, nwg, G, c, wgm;
    __host__ __device__ void init(int M, int N, int G_, int c_) { nM = M / BM; nN = N / BM; nwg = nM * nN; G = G_; c = c_; wgm = nN <= 8 ? 4 : WGM; }
    __host__ __device__ bool next(int i, Unit& u) const {
        const long L = (long)i * G + c; if (L >= nwg) return false;
        int wgid = (int)L; { const int q = nwg / NXCD, r = nwg % NXCD, xcd = wgid % NXCD, off = wgid / NXCD; wgid = (xcd < r ? xcd * (q + 1) : r * (q + 1) + (xcd - r) * q) + off; }
        const int nig = wgm * nN, gid = wgid / nig, fm = gid * wgm, gsz = (nM - fm) < wgm ? (nM - fm) : wgm;
        u.pm = fm + ((wgid % nig) % gsz); u.pn = (wgid % nig) / gsz; return true;
    }
    __device__ __forceinline__ void a_ready(const Unit&) const {}
    __device__ __forceinline__ void done(const Unit&) const {}
};

__device__ __forceinline__ unsigned cvt_pk_bf16(float lo, float hi) { unsigned r; asm volatile("v_cvt_pk_bf16_f32 %0, %1, %2" : "=v"(r) : "v"(lo), "v"(hi)); return r; }
typedef float f32x2 __attribute__((ext_vector_type(2)));

__device__ __forceinline__ float sigm(float x) { return __builtin_amdgcn_rcpf(1.0f + __builtin_amdgcn_exp2f(-1.4426950408889634f * x)); }
struct EpiStore {
    static constexpr bool PERM = true, AFTER_DRAIN = false;
    bf16_t* O; int ldc; const float* ss;
    __device__ __forceinline__ void operator()(const f32x4 (&acc)[2][2][4][2], const Unit& u, int wr, int wc, int fr, int fq) const {
        const int row0 = u.pm * BM + wr * 64 + fr, col0 = u.pn * BM + wc * 32 + 8 * fq;
#pragma unroll
        for (int ai = 0; ai < 2; ++ai)
#pragma unroll
            for (int m = 0; m < 4; ++m) { bf16_t* rowp = O + (size_t)(row0 + ai * HALF + m * 16) * ldc + col0;
                const float rs = ss ? __builtin_amdgcn_rsqf(ss[row0 + ai * HALF + m * 16] * (1.0f / 2048.0f) + 1e-6f) : 1.0f;
#pragma unroll
                for (int bj = 0; bj < 2; ++bj) { const f32x4 v0 = acc[ai][bj][m][0] * rs, v1 = acc[ai][bj][m][1] * rs;
                    u32x4 w; w.x = cvt_pk_bf16(v0[0], v0[1]); w.y = cvt_pk_bf16(v0[2], v0[3]); w.z = cvt_pk_bf16(v1[0], v1[1]); w.w = cvt_pk_bf16(v1[2], v1[3]);
                    *(u32x4*)(rowp + bj * HALF) = w; } }
    }
};
struct EpiSwiglu {
    static constexpr bool PERM = true, AFTER_DRAIN = false;
    bf16_t* H; int ldc; const float* ss;
    __device__ __forceinline__ void operator()(const f32x4 (&acc)[2][2][4][2], const Unit& u, int wr, int wc, int fr, int fq) const {
        const int row0 = u.pm * BM + wr * 64 + fr, col0 = u.pn * HALF + wc * 32 + 8 * fq;
#pragma unroll
        for (int ai = 0; ai < 2; ++ai)
#pragma unroll
            for (int m = 0; m < 4; ++m) { bf16_t* rowp = H + (size_t)(row0 + ai * HALF + m * 16) * ldc + col0;
                const float rs = ss ? __builtin_amdgcn_rsqf(ss[row0 + ai * HALF + m * 16] * (1.0f / 2048.0f) + 1e-6f) : 1.0f;
                float h[8];
#pragma unroll
                for (int n = 0; n < 2; ++n)
#pragma unroll
                    for (int j = 0; j < 4; ++j) { const float g = acc[ai][0][m][n][j] * rs, up = acc[ai][1][m][n][j] * rs; h[n * 4 + j] = g * sigm(g) * up; }
                u32x4 w; w.x = cvt_pk_bf16(h[0], h[1]); w.y = cvt_pk_bf16(h[2], h[3]); w.z = cvt_pk_bf16(h[4], h[5]); w.w = cvt_pk_bf16(h[6], h[7]);
                *(u32x4*)rowp = w; }
    }
};
template <bool BASEBF, bool OUTF32, bool OUTBF> struct EpiResid {
    static constexpr bool PERM = true, AFTER_DRAIN = false;
    const void* base; float* out; int ldc; float alpha; bf16_t* xb; float* ss;
    __device__ __forceinline__ void operator()(const f32x4 (&acc)[2][2][4][2], const Unit& u, int wr, int wc, int fr, int fq) const {
        const int row0 = u.pm * BM + wr * 64 + fr, col0 = u.pn * BM + wc * 32 + 8 * fq;
#pragma unroll
        for (int ai = 0; ai < 2; ++ai)
#pragma unroll
            for (int m = 0; m < 4; ++m) { const size_t off = (size_t)(row0 + ai * HALF + m * 16) * ldc + col0; float sq = 0.f;
#pragma unroll
                for (int bj = 0; bj < 2; ++bj) { f32x4 b0, b1;
                    if (BASEBF) { const u32x4 w = *(const u32x4*)((const bf16_t*)base + off + bj * HALF);
                        b0 = (f32x4){__uint_as_float(w.x << 16), __uint_as_float(w.x & 0xffff0000u), __uint_as_float(w.y << 16), __uint_as_float(w.y & 0xffff0000u)};
                        b1 = (f32x4){__uint_as_float(w.z << 16), __uint_as_float(w.z & 0xffff0000u), __uint_as_float(w.w << 16), __uint_as_float(w.w & 0xffff0000u)}; }
                    else { b0 = *(const f32x4*)((const float*)base + off + bj * HALF); b1 = *(const f32x4*)((const float*)base + off + bj * HALF + 4); }
                    const f32x4 o0 = b0 + acc[ai][bj][m][0] * alpha, o1 = b1 + acc[ai][bj][m][1] * alpha;
                    if (OUTF32) { *(f32x4*)(out + off + bj * HALF) = o0; *(f32x4*)(out + off + bj * HALF + 4) = o1; }
                    if (OUTBF) { sq += ((o0[0] * o0[0] + o0[1] * o0[1]) + (o0[2] * o0[2] + o0[3] * o0[3])) + ((o1[0] * o1[0] + o1[1] * o1[1]) + (o1[2] * o1[2] + o1[3] * o1[3]));
                        u32x4 w; w.x = cvt_pk_bf16(o0[0], o0[1]); w.y = cvt_pk_bf16(o0[2], o0[3]); w.z = cvt_pk_bf16(o1[0], o1[1]); w.w = cvt_pk_bf16(o1[2], o1[3]); *(u32x4*)(xb + off + bj * HALF) = w; } }
                if (OUTBF) { sq += __shfl_xor(sq, 16); sq += __shfl_xor(sq, 32); if (fq == 0) atomicAdd(ss + row0 + ai * HALF + m * 16, sq); } }
    }
};
template <int MODE> struct EpiGate {
    static constexpr bool PERM = true, AFTER_DRAIN = false;
    const bf16_t* G; bf16_t* T; int ldc;
    __device__ __forceinline__ void operator()(const f32x4 (&acc)[2][2][4][2], const Unit& u, int wr, int wc, int fr, int fq) const {
        const int row0 = u.pm * BM + wr * 64 + fr, col0 = u.pn * BM + wc * 32 + 8 * fq;
#pragma unroll
        for (int ai = 0; ai < 2; ++ai)
#pragma unroll
            for (int m = 0; m < 4; ++m) { const size_t off = (size_t)(row0 + ai * HALF + m * 16) * ldc + col0;
#pragma unroll
                for (int bj = 0; bj < 2; ++bj) { const u32x4 gw = *(const u32x4*)(G + off + bj * HALF); u32x4 tw = {0u, 0u, 0u, 0u}; if (MODE == 2) tw = *(const u32x4*)(T + off + bj * HALF);
                    float o[8];
#pragma unroll
                    for (int e = 0; e < 4; ++e) { const unsigned g2 = gw[e], t2 = tw[e]; const int n = e >> 1, j = (e & 1) * 2;
                        float a0 = sigm(__uint_as_float(g2 << 16)) * acc[ai][bj][m][n][j], a1 = sigm(__uint_as_float(g2 & 0xffff0000u)) * acc[ai][bj][m][n][j + 1];
                        if (MODE == 2) { a0 += __uint_as_float(t2 << 16); a1 += __uint_as_float(t2 & 0xffff0000u); }
                        o[2 * e] = a0; o[2 * e + 1] = a1; }
                    u32x4 w; w.x = cvt_pk_bf16(o[0], o[1]); w.y = cvt_pk_bf16(o[2], o[3]); w.z = cvt_pk_bf16(o[4], o[5]); w.w = cvt_pk_bf16(o[6], o[7]);
                    *(u32x4*)(T + off + bj * HALF) = w; } }
    }
};
template <class Epi, class Sched, bool ALIGN_EPI = false, bool SP2 = false>
__device__ __forceinline__ void gemm_phase(PG8_LAS unsigned char* lds, const Gemm g, const Sched& S, const Epi& E) {
    int tid_o = threadIdx.x; asm volatile("" : "+v"(tid_o));
    const int tid = tid_o, wid = __builtin_amdgcn_readfirstlane(tid >> 6), lane = tid & 63, wr = wid >> 2, wc = wid & 3, fr = lane & 15, fq = lane >> 4;
    const int K = g.K, nt = K / BK;
    unsigned voffA[2], voffB[2];
#pragma unroll
    for (int i = 0; i < 2; ++i) { int R, C; stage_rc(tid * 16 + i * 8192, R, C); const int Rb = Epi::PERM ? ((R & ~31) + perm32(R & 31)) : R;
        voffA[i] = (unsigned)(R * g.lda + C) * 2u; voffB[i] = (unsigned)(tid * 16 + i * 8192); (void)Rb; }
    const size_t kstep = (size_t)(BK * 2), kstepB = 16384;
    const size_t hstepA = (size_t)HALF * g.lda * 2, hstepB = (size_t)nt * 16384;
    const size_t tstepA = 2 * hstepA, tstepB = 2 * hstepB;
    const unsigned ldsw = (unsigned)wid * 1024u;
    const int aoff = lds_byte(wr * 64 + fr, fq * 8), boff = lds_byte(wc * 32 + fr, fq * 8);
#define PG8_SA(b, h) (((b) * 2 + (h)) * HTB)
#define PG8_SB(b, h) ((4 + (b) * 2 + (h)) * HTB)
#define PG8_STAGE(bufoff, gbase, voff) do { _Pragma("unroll") for (int _i = 0; _i < 2; ++_i) \
        __builtin_amdgcn_global_load_lds((const unsigned*)((const char*)(gbase) + (voff)[_i]), (PG8_LAS unsigned*)(lds + (bufoff) + ldsw + _i * 8192), 16, 0, 0); } while (0)
#define PG8_LDA(dst, b, h) do { _Pragma("unroll") for (int m = 0; m < 4; ++m) _Pragma("unroll") for (int k = 0; k < 2; ++k) dst[m][k] = *(const PG8_LAS bf16x8*)(lds + PG8_SA(b, h) + aoff + m * 2048 + k * 1024); } while (0)
#define PG8_LDB(dst, b, h) do { _Pragma("unroll") for (int n = 0; n < 2; ++n) _Pragma("unroll") for (int k = 0; k < 2; ++k) dst[n][k] = *(const PG8_LAS bf16x8*)(lds + PG8_SB(b, h) + boff + n * 2048 + k * 1024); } while (0)
#define PG8_MMA(ai, bj, At, Bt) do { __builtin_amdgcn_s_setprio(1); _Pragma("unroll") for (int m = 0; m < 4; ++m) _Pragma("unroll") for (int n = 0; n < 2; ++n) _Pragma("unroll") for (int k = 0; k < 2; ++k) \
        acc[ai][bj][m][n] = __builtin_amdgcn_mfma_f32_16x16x32_bf16(Bt[n][k], At[m][k], acc[ai][bj][m][n], 0, 0, 0); __builtin_amdgcn_s_setprio(0); } while (0)
#define PG8_WAIT_V(n) asm volatile("s_waitcnt vmcnt(" #n ")" ::: "memory")
#define PG8_WAIT_L(n) asm volatile("s_waitcnt lgkmcnt(" #n ")" ::: "memory")
#define PG8_BAR __builtin_amdgcn_s_barrier()
#define PG8_SCHED __builtin_amdgcn_sched_barrier(0)
    Unit cur, nxt; int ui = 0;
    if (!S.next(0, cur)) return;
    f32x4 acc[2][2][4][2];
#pragma unroll
    for (int a = 0; a < 2; ++a)
#pragma unroll
        for (int b = 0; b < 2; ++b)
#pragma unroll
            for (int m = 0; m < 4; ++m)
#pragma unroll
                for (int n = 0; n < 2; ++n) acc[a][b][m][n] = (f32x4){0.f, 0.f, 0.f, 0.f};
    bf16x8 At[4][2], B0[2][2], B1[2][2];
    const char* cA = (const char*)g.A + (size_t)cur.pm * tstepA; const char* cB = (const char*)g.Bt + (size_t)cur.pn * tstepB;
    S.a_ready(cur);
    if constexpr (SP2) {
        PG8_STAGE(PG8_SB(0, 0), cB, voffB); PG8_STAGE(PG8_SB(0, 1), cB + hstepB, voffB); PG8_STAGE(PG8_SA(0, 0), cA, voffA); PG8_STAGE(PG8_SA(0, 1), cA + hstepA, voffA);
        if (wr == 1) PG8_BAR;
        PG8_WAIT_V(2); PG8_BAR;
        PG8_STAGE(PG8_SB(1, 0), cB + kstepB, voffB); PG8_STAGE(PG8_SA(1, 0), cA + kstep, voffA); PG8_STAGE(PG8_SB(1, 1), cB + hstepB + kstepB, voffB);
        PG8_WAIT_V(6); PG8_BAR;
    } else {
        PG8_STAGE(PG8_SB(0, 0), cB, voffB); PG8_STAGE(PG8_SA(0, 0), cA, voffA); PG8_STAGE(PG8_SB(0, 1), cB + hstepB, voffB); PG8_STAGE(PG8_SA(0, 1), cA + hstepA, voffA);
        if (wr == 1) PG8_BAR;
        PG8_WAIT_V(4); PG8_BAR;
        PG8_STAGE(PG8_SB(1, 0), cB + kstepB, voffB); PG8_STAGE(PG8_SA(1, 0), cA + kstep, voffA); PG8_STAGE(PG8_SB(1, 1), cB + hstepB + kstepB, voffB);
        PG8_WAIT_V(6); PG8_BAR;
    }
    for (;;) {
        const bool has_next = S.next(ui + 1, nxt);
        const char* nA = has_next ? (const char*)g.A + (size_t)nxt.pm * tstepA : cA; const char* nB = has_next ? (const char*)g.Bt + (size_t)nxt.pn * tstepB : cB;
        for (int t = 0; t < nt; t += 2) {
            const bool last = (t == nt - 2);
            const char* a1 = cA + (size_t)(t + 1) * kstep;
            const char* a2 = last ? nA : cA + (size_t)(t + 2) * kstep; const char* b2 = last ? nB : cB + (size_t)(t + 2) * kstepB;
            const char* a3 = a2 + kstep; const char* b3 = b2 + kstepB;
            if (last && has_next) S.a_ready(nxt);
            if constexpr (SP2) {
            PG8_LDB(B0, 0, 0); PG8_LDB(B1, 0, 1); PG8_SCHED; PG8_LDA(At, 0, 0); PG8_STAGE(PG8_SA(1, 1), a1 + hstepA, voffA);
            PG8_WAIT_V(8); PG8_WAIT_L(0); PG8_BAR; PG8_MMA(0, 0, At, B0); PG8_MMA(0, 1, At, B1); PG8_BAR; PG8_SCHED;
            PG8_LDA(At, 0, 1); PG8_STAGE(PG8_SB(0, 0), b2, voffB); PG8_STAGE(PG8_SB(0, 1), b2 + hstepB, voffB); PG8_STAGE(PG8_SA(0, 0), a2, voffA);
            PG8_WAIT_V(8); PG8_WAIT_L(0); PG8_BAR; PG8_MMA(1, 0, At, B0); PG8_MMA(1, 1, At, B1); PG8_BAR; PG8_SCHED;
            PG8_LDB(B0, 1, 0); PG8_LDB(B1, 1, 1); PG8_SCHED; PG8_LDA(At, 1, 0); PG8_STAGE(PG8_SA(0, 1), a2 + hstepA, voffA);
            PG8_WAIT_V(8); PG8_WAIT_L(0); PG8_BAR; PG8_MMA(0, 0, At, B0); PG8_MMA(0, 1, At, B1); PG8_BAR; PG8_SCHED;
            PG8_LDA(At, 1, 1); PG8_STAGE(PG8_SB(1, 0), b3, voffB); PG8_STAGE(PG8_SB(1, 1), b3 + hstepB, voffB); PG8_STAGE(PG8_SA(1, 0), a3, voffA);
            PG8_WAIT_V(8); PG8_WAIT_L(0); PG8_BAR; PG8_MMA(1, 0, At, B0); PG8_MMA(1, 1, At, B1); PG8_BAR; PG8_SCHED;
            } else {
            PG8_LDB(B0, 0, 0); PG8_SCHED; PG8_LDA(At, 0, 0); PG8_STAGE(PG8_SA(1, 1), a1 + hstepA, voffA);
            PG8_WAIT_L(8); PG8_BAR; PG8_WAIT_L(0); PG8_MMA(0, 0, At, B0); PG8_BAR; PG8_SCHED;
            PG8_LDB(B1, 0, 1); PG8_STAGE(PG8_SB(0, 0), b2, voffB);
            PG8_BAR; PG8_WAIT_L(0); PG8_MMA(0, 1, At, B1); PG8_BAR;
            PG8_LDA(At, 0, 1); PG8_STAGE(PG8_SA(0, 0), a2, voffA);
            PG8_BAR; PG8_WAIT_L(0); PG8_MMA(1, 0, At, B0); PG8_BAR; PG8_SCHED;
            PG8_STAGE(PG8_SB(0, 1), b2 + hstepB, voffB);
            PG8_WAIT_V(6); PG8_BAR; PG8_MMA(1, 1, At, B1); PG8_BAR;
            PG8_LDB(B0, 1, 0); PG8_SCHED; PG8_LDA(At, 1, 0); PG8_STAGE(PG8_SA(0, 1), a2 + hstepA, voffA);
            PG8_WAIT_L(8); PG8_BAR; PG8_WAIT_L(0); PG8_MMA(0, 0, At, B0); PG8_BAR; PG8_SCHED;
            PG8_LDB(B1, 1, 1); PG8_STAGE(PG8_SB(1, 0), b3, voffB);
            PG8_BAR; PG8_WAIT_L(0); PG8_MMA(0, 1, At, B1); PG8_BAR;
            PG8_LDA(At, 1, 1); PG8_STAGE(PG8_SA(1, 0), a3, voffA);
            PG8_BAR; PG8_WAIT_L(0); PG8_MMA(1, 0, At, B0); PG8_BAR; PG8_SCHED;
            PG8_STAGE(PG8_SB(1, 1), b3 + hstepB, voffB);
            PG8_WAIT_V(6); PG8_BAR; PG8_MMA(1, 1, At, B1); PG8_BAR;
            }
        }
        if constexpr (ALIGN_EPI) { if (wr == 0) PG8_BAR; }
        if constexpr (!Epi::AFTER_DRAIN) { E(acc, cur, wr, wc, fr, fq); S.done(cur); }
        if (!has_next) break;
#pragma unroll
        for (int a = 0; a < 2; ++a)
#pragma unroll
            for (int b = 0; b < 2; ++b)
#pragma unroll
                for (int m = 0; m < 4; ++m)
#pragma unroll
                    for (int n = 0; n < 2; ++n) acc[a][b][m][n] = (f32x4){0.f, 0.f, 0.f, 0.f};
        cur = nxt; cA = nA; cB = nB; ++ui;
        if constexpr (ALIGN_EPI) { if (wr == 1) PG8_BAR; }
    }
    PG8_WAIT_V(0);
    if constexpr (!ALIGN_EPI) { if (wr == 0) PG8_BAR; }
    PG8_BAR;
    if constexpr (Epi::AFTER_DRAIN) { E.fused(acc, cur, wr, wc, fr, fq, lds, wid, lane); S.done(cur); }
#undef PG8_SA
#undef PG8_SB
#undef PG8_STAGE
#undef PG8_LDA
#undef PG8_LDB
#undef PG8_MMA
#undef PG8_WAIT_V
#undef PG8_WAIT_L
#undef PG8_BAR
#undef PG8_SCHED
}
}
namespace attn {
using bf16 = __hip_bfloat16;
typedef short bf16x8 __attribute__((ext_vector_type(8)));
typedef short s16x4 __attribute__((ext_vector_type(4)));
typedef float f32x16 __attribute__((ext_vector_type(16)));
typedef float f32x4 __attribute__((ext_vector_type(4)));
typedef unsigned u32x4 __attribute__((ext_vector_type(4)));
template <class A, class Bt> struct same_t { static constexpr bool v = false; };
template <class A> struct same_t<A, A> { static constexpr bool v = true; };
constexpr int D = 128, PITCH = PP;
constexpr float THR = 8.f;
constexpr bool WSKIP = false;
constexpr float SCALE = 0.08838834764831845f;
constexpr int NW = 8, QBLK = 32, KVBLK = 64, QB = NW * QBLK;
constexpr int SHM_V = KVBLK * D * 2, SHM_K = KVBLK * D * 2;
constexpr int ATT_LDS_BYTES = 2 * SHM_V + 2 * SHM_K + NW * 64 * 4;
#define KSWZ(row, colB) ((row) * 256 + ((colB) ^ (((row) & 7) << 4)))
#define SBAR() __builtin_amdgcn_sched_barrier(0)
__device__ __forceinline__ int v_st(int k, int c) { const int kk = (k & ~0xC) | ((k & 4) << 1) | ((k & 8) >> 1); return ((kk >> 3) * 4 + (c >> 5)) * 512 + ((kk & 7) * 32 + (c & 31)) * 2; }
__device__ __forceinline__ int v_rd_base(int lane) { return ((lane & 3) << 3) | (((lane >> 2) & 3) << 6) | (((lane >> 4) & 1) << 5) | (((lane >> 5) & 1) << 8); }
constexpr int v_rd_off(int d0, int ks, int half) { return d0 * 512 + ks * 4096 + half * 2048; }
__device__ __forceinline__ int crow(int r, int hi) { return (r & 3) + 8 * (r >> 2) + 4 * hi; }
__device__ __forceinline__ unsigned cvtpk(float lo, float hi) {
    unsigned r; asm volatile("v_cvt_pk_bf16_f32 %0, %1, %2" : "=v"(r) : "v"(lo), "v"(hi)); return r;
}
__device__ __forceinline__ bf16x8 pack8(f32x4 a, f32x4 b) {
    u32x4 w = {cvtpk(a[0], a[1]), cvtpk(a[2], a[3]), cvtpk(b[0], b[1]), cvtpk(b[2], b[3])};
    return *reinterpret_cast<bf16x8*>(&w);
}
template <class T> __device__ __forceinline__ bf16x8 load8(const T* p) {
    if constexpr (same_t<T, float>::v) { return pack8(*(const f32x4*)p, *(const f32x4*)(p + 4)); }
    else { return *reinterpret_cast<const bf16x8*>(p); }
}
__device__ __forceinline__ void mask_bits(f32x16& p0, f32x16& p1, unsigned long long mw, int hi) {
    const float NEG = -__builtin_inff();
    const unsigned a = (unsigned)mw >> (4 * hi), b = (unsigned)(mw >> 32) >> (4 * hi);
#pragma unroll
    for (int r = 0; r < 16; ++r) {
        const int c = (r & 3) + 8 * (r >> 2);
        if (!((a >> c) & 1u)) p0[r] = NEG;
        if (!((b >> c) & 1u)) p1[r] = NEG;
    }
}
__device__ __forceinline__ void partialSM(f32x16& p0, f32x16& p1, float& m_reg, float& mn, float& alpha) {
    float pmax = p0[0]; for (int r = 1; r < 16; ++r) pmax = fmaxf(pmax, p0[r]); for (int r = 0; r < 16; ++r) pmax = fmaxf(pmax, p1[r]);
    { auto rr = __builtin_amdgcn_permlane32_swap(__float_as_uint(pmax), __float_as_uint(pmax), false, false);
      pmax = fmaxf(__uint_as_float(rr[0]), __uint_as_float(rr[1])); }
    constexpr float C2 = 1.4426950408889634f * SCALE;
    if (__builtin_expect(__all((pmax - m_reg) * SCALE <= THR), 1)) { mn = m_reg; alpha = 1.f; }
    else { mn = fmaxf(m_reg, pmax); alpha = __builtin_amdgcn_exp2f((m_reg - mn) * C2); m_reg = mn; }
    const float mnL = -mn * C2;
    for (int r = 0; r < 16; ++r) p0[r] = fmaf(p0[r], C2, mnL); for (int r = 0; r < 16; ++r) p1[r] = fmaf(p1[r], C2, mnL);
    for (int r = 0; r < 16; ++r) p0[r] = __builtin_amdgcn_exp2f(p0[r]);
}
__device__ __forceinline__ void finishSM(f32x16& p0, f32x16& p1, float alpha, float& l_reg, bf16x8& pa0, bf16x8& pa1, bf16x8& pa2, bf16x8& pa3) {
    for (int r = 0; r < 16; ++r) p1[r] = __builtin_amdgcn_exp2f(p1[r]);
    float ps = 0; for (int r = 0; r < 16; ++r) ps += p0[r]; for (int r = 0; r < 16; ++r) ps += p1[r];
    { auto rr = __builtin_amdgcn_permlane32_swap(__float_as_uint(ps), __float_as_uint(ps), false, false);
      ps = __uint_as_float(rr[0]) + __uint_as_float(rr[1]); }
    l_reg = l_reg * alpha + ps;
#define PK4(P, B_, OUT) do { unsigned a0 = cvtpk(P[B_+0], P[B_+1]), a1 = cvtpk(P[B_+2], P[B_+3]);                          \
        unsigned b0 = cvtpk(P[B_+4], P[B_+5]), b1 = cvtpk(P[B_+6], P[B_+7]);                                             \
        auto r0 = __builtin_amdgcn_permlane32_swap(a0, b0, false, false); auto r1 = __builtin_amdgcn_permlane32_swap(a1, b1, false, false); \
        u32x4 w = {r0[0], r1[0], r0[1], r1[1]}; OUT = *reinterpret_cast<bf16x8*>(&w); } while (0)
    PK4(p0, 0, pa0); PK4(p0, 8, pa1); PK4(p1, 0, pa2); PK4(p1, 8, pa3);
#undef PK4
}
template <int KB, bool SK>
__device__ __forceinline__ void qkt(f32x16& p0, f32x16& p1, const char* K_lds, int r32, int hi, const bf16x8* qr, bool act) {
    if (SK && !act) { const float NEG = -__builtin_inff();
#pragma unroll
        for (int r = 0; r < 16; ++r) { p0[r] = NEG; p1[r] = NEG; } return; }
    p0 = f32x16{}; p1 = f32x16{};
    const char* kb[4];
#pragma unroll
    for (int dd = 0; dd < 4; ++dd) kb[dd] = K_lds + KB * SHM_K + KSWZ(r32, (dd * 16 + hi * 8) * 2);
#pragma unroll
    for (int d0 = 0; d0 < 8; ++d0) { const char* a = kb[d0 & 3] + (d0 >> 2) * 128;
        bf16x8 b0 = *reinterpret_cast<const bf16x8*>(a);
        bf16x8 b1 = *reinterpret_cast<const bf16x8*>(a + 32 * 256);
        p0 = __builtin_amdgcn_mfma_f32_32x32x16_bf16(b0, qr[d0], p0, 0, 0, 0);
        p1 = __builtin_amdgcn_mfma_f32_32x32x16_bf16(b1, qr[d0], p1, 0, 0, 0); }
}
template <int VB, bool SK>
__device__ __forceinline__ void pv_tile(f32x16* o, int vb0, bf16x8 pa0, bf16x8 pa1, bf16x8 pa2, bf16x8 pa3, bool act) {
    if (SK && !act) return;
#define TRRD(dst, off) asm volatile("ds_read_b64_tr_b16 %0, %1 offset:%2" : "=&v"(dst) : "v"(vb0), "i"(off) : "memory")
#define PV_D0(d0) do { s16x4 l0, l1, l2, l3, h0, h1, h2, h3; constexpr int b_ = VB * SHM_V + v_rd_off(d0, 0, 0);     \
        TRRD(l0, b_); TRRD(h0, b_ + 2048); TRRD(l1, b_ + 4096); TRRD(h1, b_ + 6144); TRRD(l2, b_ + 8192); TRRD(h2, b_ + 10240); TRRD(l3, b_ + 12288); TRRD(h3, b_ + 14336); \
        asm volatile("s_waitcnt lgkmcnt(0)" ::: "memory"); SBAR();                 \
        o[d0] = __builtin_amdgcn_mfma_f32_32x32x16_bf16(pa0, (bf16x8){l0[0], l0[1], l0[2], l0[3], h0[0], h0[1], h0[2], h0[3]}, o[d0], 0, 0, 0);   \
        o[d0] = __builtin_amdgcn_mfma_f32_32x32x16_bf16(pa1, (bf16x8){l1[0], l1[1], l1[2], l1[3], h1[0], h1[1], h1[2], h1[3]}, o[d0], 0, 0, 0);   \
        o[d0] = __builtin_amdgcn_mfma_f32_32x32x16_bf16(pa2, (bf16x8){l2[0], l2[1], l2[2], l2[3], h2[0], h2[1], h2[2], h2[3]}, o[d0], 0, 0, 0);   \
        o[d0] = __builtin_amdgcn_mfma_f32_32x32x16_bf16(pa3, (bf16x8){l3[0], l3[1], l3[2], l3[3], h3[0], h3[1], h3[2], h3[3]}, o[d0], 0, 0, 0); } while (0)
    PV_D0(0); PV_D0(1); PV_D0(2); PV_D0(3);
#undef PV_D0
#undef TRRD
}
template <class TIn, class TOut> struct BlockRef { const TIn* Q; const TIn* K; const TIn* V; TOut* O; const unsigned long long* MK; int P0; };
template <class TIn> struct Seam {
    bf16x8 qr[8];
    bf16x8 st_v0, st_v1, st_k0, st_k1; f32x4 sf0, sf1, sf2, sf3;
    f32x4 tq[16];
};
__device__ __forceinline__ int swa_jlo(int P0, int W) { const int lowk = P0 - W + 1; return lowk > 0 ? lowk / KVBLK : 0; }
#define ROW(p, k0, rr) ((p) + (size_t)((k0) + (rr)) * PITCH + sc)
#define VMW() asm volatile("s_waitcnt vmcnt(0)" ::: "memory")
#define VMWN(n) asm volatile("s_waitcnt vmcnt(%0)" :: "i"(n) : "memory")
#define SLOAD_H(Kp, Vp, k0) do { S.st_v0 = load8<TIn>(ROW(Vp, k0, sr)); S.st_v1 = load8<TIn>(ROW(Vp, k0, 32 + sr));              \
                         S.st_k0 = load8<TIn>(ROW(Kp, k0, sr)); S.st_k1 = load8<TIn>(ROW(Kp, k0, 32 + sr)); } while (0)
#define SWRITE_HK(bf) do { *(bf16x8*)(K_lds + (bf) * SHM_K + kws) = S.st_k0; *(bf16x8*)(K_lds + (bf) * SHM_K + kws + 32 * 256) = S.st_k1; } while (0)
#define SWRITE_HV(bf) do { *(bf16x8*)(V_lds + (bf) * SHM_V + vst0) = S.st_v0; *(bf16x8*)(V_lds + (bf) * SHM_V + vst1) = S.st_v1; } while (0)
#define SWRITE_H(bf) do { SWRITE_HV(bf); SWRITE_HK(bf); } while (0)
#define SLOAD_F(p, k0) do { S.sf0 = *(const f32x4*)ROW(p, k0, sr); S.sf1 = *(const f32x4*)(ROW(p, k0, sr) + 4);                \
                            S.sf2 = *(const f32x4*)ROW(p, k0, 32 + sr); S.sf3 = *(const f32x4*)(ROW(p, k0, 32 + sr) + 4); } while (0)
#define SWRITE_KF(bf) do { *(bf16x8*)(K_lds + (bf) * SHM_K + kws) = pack8(S.sf0, S.sf1); *(bf16x8*)(K_lds + (bf) * SHM_K + kws + 32 * 256) = pack8(S.sf2, S.sf3); } while (0)
#define SWRITE_VF(bf) do { *(bf16x8*)(V_lds + (bf) * SHM_V + vst0) = pack8(S.sf0, S.sf1); *(bf16x8*)(V_lds + (bf) * SHM_V + vst1) = pack8(S.sf2, S.sf3); } while (0)
template <class TIn, class TOut>
__device__ __forceinline__ void causal_swa_prime(const BlockRef<TIn, TOut>& cur, int W, char* lds, Seam<TIn>& S) {
    constexpr bool F32 = same_t<TIn, float>::v;
    const int tid = threadIdx.x, wid = __builtin_amdgcn_readfirstlane(tid >> 6), lane = tid & 63, r32 = lane & 31, hi = lane >> 5;
    const int sr = tid >> 4, sc = (tid & 15) * 8, kws = KSWZ(sr, sc * 2); char* K_lds = lds + 2 * SHM_V;
    const int kb0 = swa_jlo(cur.P0, W) * KVBLK;
    for (int d0 = 0; d0 < 8; ++d0) S.qr[d0] = load8<TIn>(cur.Q + (size_t)(wid * QBLK + r32) * PITCH + d0 * 16 + hi * 8);
    if constexpr (F32) { SLOAD_F((const float*)cur.K, kb0); VMW(); SWRITE_KF(0); SBAR(); SLOAD_F((const float*)cur.V, kb0); }
    else { SLOAD_H(cur.K, cur.V, kb0); VMW(); SWRITE_HK(0); }
    __syncthreads();
}
template <class TIn, class TOut>
__device__ __forceinline__ void causal_swa_block(const BlockRef<TIn, TOut>& cur, const BlockRef<TIn, TOut>& nxt, int skv, int W, char* lds, Seam<TIn>& S) {
    constexpr bool F32 = same_t<TIn, float>::v;
    const int tid = threadIdx.x, wid = __builtin_amdgcn_readfirstlane(tid >> 6), lane = tid & 63, r32 = lane & 31, hi = lane >> 5;
    const int j_lo = swa_jlo(cur.P0, W);
    int j_hi = (cur.P0 + QB - 1) / KVBLK + 1; if (j_hi > skv / KVBLK) j_hi = skv / KVBLK;
    const int NT = j_hi - j_lo;
    const int kbn = swa_jlo(nxt.P0, W) * KVBLK;
    const int qlo = cur.P0 + wid * QBLK, qm = qlo + r32 - 4 * hi;
    char* V_lds = lds; char* K_lds = lds + 2 * SHM_V;
    float* ws = (float*)(lds + 2 * SHM_V + 2 * SHM_K) + wid * 64; float* li_l = ws, * al_l = ws + 32;
    float m_reg = -1e30f, l_reg = 0; f32x16 o[4] = {};
    const int sr = tid >> 4, sc = (tid & 15) * 8, vst0 = v_st(sr, sc), vst1 = v_st(32 + sr, sc), kws = KSWZ(sr, sc * 2);
    const int vb0 = (int)(uintptr_t)V_lds + v_rd_base(lane);
    const TIn* Kh = cur.K; const TIn* Vh = cur.V;
    const unsigned long long* mrow = cur.MK + (size_t)(wid * QBLK + r32) * 128; unsigned long long mwA, mwB = 0ull;
#define RESC(a) do { if (__any((a) < 1.f)) { if (hi == 0) al_l[r32] = (a); asm volatile("s_waitcnt lgkmcnt(0)" ::: "memory");              \
                     for (int d_ = 0; d_ < 4; ++d_) for (int r = 0; r < 16; ++r) o[d_][r] *= al_l[crow(r, hi)]; } } while (0)
#define KBASE(t) ((j_lo + (t)) * KVBLK)
#define ACT(t) (KBASE(t) <= qlo + QBLK - 1 && KBASE(t) + KVBLK - 1 >= qlo - W + 1)
#define MASKT(P0_, P1_, MW_) mask_bits(P0_, P1_, MW_, hi)
    constexpr int NQL = F32 ? 16 : 8;
    constexpr bool SK = WSKIP && !F32;
#define SEAM_K0() do { VMWN(NQL); if constexpr (F32) { SWRITE_KF(0); SBAR(); SLOAD_F((const float*)nxt.V, kbn); } else { SWRITE_HK(0); } SBAR(); } while (0)
    f32x16 pA0, pA1, pB0, pB1; float mnA, mnB, alA, alB; bf16x8 pa0, pa1, pa2, pa3;
    if constexpr (F32) { VMW(); SWRITE_VF(0); SBAR(); } else { SWRITE_HV(0); SBAR(); }
    if (NT > 1) { if constexpr (F32) SLOAD_F((const float*)Kh, KBASE(1)); else SLOAD_H(Kh, Vh, KBASE(1)); }
    mwA = mrow[0]; SBAR(); qkt<0, SK>(pA0, pA1, K_lds, r32, hi, S.qr, ACT(0));
    if constexpr (F32) { if (NT > 1) { VMW(); SWRITE_KF(1); SBAR(); SLOAD_F((const float*)Vh, KBASE(1)); } }
    MASKT(pA0, pA1, mwA); partialSM(pA0, pA1, m_reg, mnA, alA);
    if (NT > 1) { VMW(); if constexpr (F32) { SWRITE_VF(1); SBAR(); if (NT > 2) SLOAD_F((const float*)Kh, KBASE(2)); } else SWRITE_H(1); }
    __syncthreads();
#define HALF_STEP(PX0, PX1, mnX, alX, PY0, PY1, alY, t, KB, VB, SB, MWX) do {                                                      \
        MWX = mrow[(t)]; SBAR(); qkt<KB, SK>(PX0, PX1, K_lds, r32, hi, S.qr, ACT(t));                                             \
        finishSM(PY0, PY1, alY, l_reg, pa0, pa1, pa2, pa3); SBAR();                                                           \
        if ((t) + 1 < NT) { if constexpr (F32) { VMW(); SWRITE_KF(SB); SBAR(); SLOAD_F((const float*)Vh, KBASE((t) + 1)); }  \
                            else { SLOAD_H(Kh, Vh, KBASE((t) + 1)); } SBAR(); }                                               \
        pv_tile<VB, SK>(o, vb0, pa0, pa1, pa2, pa3, ACT((t) - 1)); MASKT(PX0, PX1, MWX); partialSM(PX0, PX1, m_reg, mnX, alX);                                        \
        __syncthreads();                                                                                                      \
        if ((t) + 1 < NT) { VMW(); if constexpr (F32) { SWRITE_VF(SB); SBAR(); if ((t) + 2 < NT) SLOAD_F((const float*)Kh, KBASE((t) + 2)); } \
                            else { SWRITE_H(SB); } }                                                                          \
        RESC(alX); __syncthreads(); } while (0)
    for (int t = 1; t + 1 < NT; t += 2) {
        HALF_STEP(pB0, pB1, mnB, alB, pA0, pA1, alA, t, 1, 0, 0, mwB);
        HALF_STEP(pA0, pA1, mnA, alA, pB0, pB1, alB, t + 1, 0, 1, 1, mwA);
    }
    const bool even = (NT & 1) == 0;
    if (even) { mwB = mrow[NT - 1]; SBAR(); qkt<1, SK>(pB0, pB1, K_lds, r32, hi, S.qr, ACT(NT - 1)); SBAR(); }
#define QROW(e) (nxt.Q + (size_t)(wid * QBLK + r32) * PITCH + ((e) >> 1) * 16 + hi * 8 + ((e) & 1) * 4)
    if constexpr (F32) { SLOAD_F((const float*)nxt.K, kbn); SBAR();
#pragma unroll
        for (int e = 0; e < 8; ++e) S.tq[e] = *(const f32x4*)QROW(e); }
    else { SLOAD_H(nxt.K, nxt.V, kbn); SBAR();
#pragma unroll
        for (int d0 = 0; d0 < 8; ++d0) S.qr[d0] = load8<TIn>(nxt.Q + (size_t)(wid * QBLK + r32) * PITCH + d0 * 16 + hi * 8); }
    SBAR();
    finishSM(pA0, pA1, alA, l_reg, pa0, pa1, pa2, pa3); SBAR();
    if constexpr (F32) {
#pragma unroll
        for (int e = 8; e < 16; ++e) S.tq[e] = *(const f32x4*)QROW(e); SBAR(); }
#undef QROW
    pv_tile<0, SK>(o, vb0, pa0, pa1, pa2, pa3, ACT(even ? NT - 2 : NT - 1));
    if (even) { MASKT(pB0, pB1, mwB); partialSM(pB0, pB1, m_reg, mnB, alB); __syncthreads(); RESC(alB);
        finishSM(pB0, pB1, alB, l_reg, pa0, pa1, pa2, pa3); SBAR(); pv_tile<1, SK>(o, vb0, pa0, pa1, pa2, pa3, ACT(NT - 1)); }
    SBAR(); SEAM_K0();
    if (hi == 0) li_l[r32] = l_reg; asm volatile("s_waitcnt lgkmcnt(0)" ::: "memory");
    float rli[16];
#pragma unroll
    for (int r = 0; r < 16; ++r) rli[r] = __builtin_amdgcn_rcpf(li_l[crow(r, hi)]);
    TOut* Ow = cur.O + (size_t)(wid * QBLK) * PITCH;
#pragma unroll
    for (int r = 0; r < 16; ++r) { const int orow = crow(r, hi);
#pragma unroll
        for (int d0 = 0; d0 < 4; ++d0) { const float v = o[d0][r] * rli[r];
            if constexpr (same_t<TOut, float>::v) { Ow[(size_t)orow * PITCH + d0 * 32 + r32] = v; }
            else { const float vn = __shfl_xor(v, 1);
                   if ((r32 & 1) == 0) *(unsigned*)(Ow + (size_t)orow * PITCH + d0 * 32 + r32) = cvtpk(v, vn); } } }
    if constexpr (F32) {
#pragma unroll
        for (int d0 = 0; d0 < 8; ++d0) S.qr[d0] = pack8(S.tq[2 * d0], S.tq[2 * d0 + 1]); }
    __syncthreads();
#undef RESC
#undef KBASE
#undef ACT
#undef MASKT
#undef SEAM_K0
#undef HALF_STEP
}
#undef ROW
#undef VMW
#undef VMWN
#undef SLOAD_H
#undef SWRITE_HK
#undef SWRITE_HV
#undef SWRITE_H
#undef SLOAD_F
#undef SWRITE_KF
#undef SWRITE_VF

#undef KSWZ
#undef SBAR
}

struct Params { const float* in[21]; float* out; unsigned char* ws; };
__constant__ float ROPE_INVF[24] = { 1.000000000e+00f, 4.403665960e-01f, 1.939227432e-01f, 8.539710194e-02f, 3.760603070e-02f, 1.656044088e-02f, 7.292664610e-03f, 3.211446106e-03f,
    1.414213562e-03f, 6.227724371e-04f, 2.742481884e-04f, 1.207697351e-04f, 5.318295734e-05f, 2.341999971e-05f, 1.031338525e-05f, 4.541670478e-06f,
    1.000000000e+00f, 1.939227432e-01f, 3.760603070e-02f, 7.292664610e-03f, 1.414213562e-03f, 2.742481884e-04f, 5.318295734e-05f, 1.031338525e-05f };
constexpr int CW_IDXQ = 64;
constexpr int CW_BAR = 4096;
#define XCD_BAR_WORDS 3456

#define LDS_WAIT() asm volatile("s_waitcnt lgkmcnt(0)" ::: "memory")

__device__ __forceinline__ size_t wt_off(int n_dst, int k, int K) {
    const int rw = n_dst & 127, w = rw & 31, R = (rw & ~31) + ((w >> 2) & 1) * 16 + (((w >> 3) << 2) | (w & 3));
    return ((size_t)(n_dst >> 7) * (K >> 6) + (k >> 6)) * 8192 + (size_t)(pg8::lds_byte(R, k & 63) >> 1);
}
__device__ __forceinline__ int rowmap(int mode, int c) {
    if (mode == 1) return ((c >> 7) << 8) + (c & 127);
    if (mode == 2) return ((c >> 7) << 8) + 128 + (c & 127);
    if (mode == 3) return c < 4176 ? c : c + 176;
    return c;
}
__device__ __forceinline__ void transpose_item(const float* __restrict__ W, int K, int N, bf16raw* WT, int mode, LAS float* scr, int item, int lane, const float* __restrict__ gain = nullptr) {
    const int nblk = (N + 63) >> 6, kb = item / nblk, nb = item - kb * nblk, k0 = 64 * kb, n0 = 64 * nb;
    const int nn = n0 + (lane & 15) * 4; const bool ok = nn + 3 < N;
#pragma unroll 8
    for (int i = 0; i < 16; ++i) { const int kk = 4 * i + (lane >> 4); f32x4_t v = {0.f, 0.f, 0.f, 0.f}; if (ok) v = *(const f32x4_t*)(W + (size_t)(k0 + kk) * N + nn);
        if (gain) v = v * gain[k0 + kk];
        LAS float* d = scr + kk * 65 + (lane & 15) * 4; d[0] = v.x; d[1] = v.y; d[2] = v.z; d[3] = v.w; }
    LDS_WAIT();
    const int c = lane & 7;
#pragma unroll
    for (int j = 0; j < 8; ++j) { const int n = (lane >> 3) + 8 * j; const LAS float* s = scr + (8 * c) * 65 + n;
        u32x4_t o; o.x = pkbf(s[0 * 65], s[1 * 65]); o.y = pkbf(s[2 * 65], s[3 * 65]); o.z = pkbf(s[4 * 65], s[5 * 65]); o.w = pkbf(s[6 * 65], s[7 * 65]);
        if (n0 + n < N) *(u32x4_t*)(WT + wt_off(rowmap(mode, n0 + n), k0 + 8 * c, K)) = o; }
    LDS_WAIT();
}
__device__ __forceinline__ void rms_row(const float* __restrict__ xrow, const float* __restrict__ g, bf16raw* orow, int lane) {
    f32x4_t v[8]; float s = 0.f;
#pragma unroll
    for (int j = 0; j < 8; ++j) { v[j] = ((const f32x4_t*)xrow)[64 * j + lane]; s += (v[j].x * v[j].x + v[j].y * v[j].y) + (v[j].z * v[j].z + v[j].w * v[j].w); }
    const float r = 1.0f / sqrtf(wave_sum(s) * (1.0f / DM) + EPS);
#pragma unroll
    for (int j = 0; j < 8; ++j) { const f32x4_t gv = ((const f32x4_t*)g)[64 * j + lane]; u32x2_t o; o.x = pkbf(v[j].x * r * gv.x, v[j].y * r * gv.y); o.y = pkbf(v[j].z * r * gv.z, v[j].w * r * gv.w);
        ((u32x2_t*)orow)[64 * j + lane] = o; }
}
__device__ __forceinline__ void rms_phase(const float* x, const float* g, bf16raw* xn, int gw, int ngw, int lane) {
    for (int m = gw; m < MTOK; m += ngw) rms_row(x + (size_t)m * DM, g, xn + (size_t)m * DM, lane);
}
__device__ __forceinline__ void p0_prologue(const Params& P, LAS unsigned char* lds, int tid, int lane, int wave) {
    unsigned char* ws = P.ws;
    LAS float* scr = (LAS float*)(lds + wave * 16640);
    const int gw = blockIdx.x * NWAVES + wave, ngw = gridDim.x * NWAVES;
    constexpr int I_G = 32 * 88, I_D = 88 * 32, I_IN = 32 * 162, I_UA = 16 * 32, I_OUT = 32 * 32;
    constexpr int NITEMS = 4 * I_G + 2 * I_D + I_IN + 2 * I_UA + I_OUT;
    for (int it = gw; it < NITEMS; it += ngw) {
        int r = it;
        if (r < I_G) { transpose_item(P.in[3], DM, DFF, (bf16raw*)(ws + WS_WGU1), 1, scr, r, lane); continue; } r -= I_G;
        if (r < I_G) { transpose_item(P.in[4], DM, DFF, (bf16raw*)(ws + WS_WGU1), 2, scr, r, lane); continue; } r -= I_G;
        if (r < I_D) { transpose_item(P.in[5], DFF, DM, (bf16raw*)(ws + WS_WD1), 0, scr, r, lane); continue; } r -= I_D;
        if (r < I_G) { transpose_item(P.in[18], DM, DFF, (bf16raw*)(ws + WS_WGU2), 1, scr, r, lane, P.in[17]); continue; } r -= I_G;
        if (r < I_G) { transpose_item(P.in[19], DM, DFF, (bf16raw*)(ws + WS_WGU2), 2, scr, r, lane, P.in[17]); continue; } r -= I_G;
        if (r < I_D) { transpose_item(P.in[20], DFF, DM, (bf16raw*)(ws + WS_WD2), 0, scr, r, lane); continue; } r -= I_D;
        if (r < I_IN) { transpose_item(P.in[7], DM, 10320, (bf16raw*)(ws + WS_WIN), 3, scr, r, lane, P.in[6]); continue; } r -= I_IN;
        if (r < I_UA) { transpose_item(P.in[14], 1024, DM, (bf16raw*)(ws + WS_WUA), 0, scr, r, lane); continue; } r -= I_UA;
        if (r < I_UA) { transpose_item(P.in[15], 1024, DM, (bf16raw*)(ws + WS_WUS), 0, scr, r, lane); continue; } r -= I_UA;
        transpose_item(P.in[16], DM, DM, (bf16raw*)(ws + WS_WOUT), 0, scr, r, lane);
    }
    const int gt = blockIdx.x * NTHR + tid, ngt = gridDim.x * NTHR;
    { bf16raw* wt = (bf16raw*)(ws + WS_WIN);
      for (int i = gt; i < 176 * DM / 8; i += ngt) { const int n = 4176 + i / (DM / 8), k = (i % (DM / 8)) * 8; *(u32x4_t*)(wt + wt_off(n, k, DM)) = (u32x4_t){0u, 0u, 0u, 0u}; } }
    { const float* w_s = P.in[12]; bf16raw* wsb = (bf16raw*)(ws + WS_WSB);
      for (int i = gt; i < 8 * 128 * 128; i += ngt) { const int s = i & 127, t = (i >> 7) & 127; const float v = (t < 64 && s >= 64) ? 0.f : w_s[i]; wsb[i] = (bf16raw)(pkbf(v, 0.f) & 0xffffu); } }
    if (blockIdx.x == 0 && tid < 128) ((unsigned*)(ws + WS_CTL))[tid] = 0u;
    if (blockIdx.x == 0) { unsigned* bw = (unsigned*)(ws + WS_CTL) + CW_BAR; for (int i = tid; i < XCD_BAR_WORDS; i += NTHR) bw[i] = 0u; }
    { float* ssz = (float*)(ws + WS_SS1); for (int i = gt; i < 2 * MTOK; i += ngt) ssz[i] = 0.f; }
    rms_phase(P.in[0], P.in[2], (bf16raw*)(ws + WS_XN), gw, ngw, lane);
}

template <class Epi> __device__ __forceinline__ void run_gemm(LAS unsigned char* lds, const bf16raw* A, int lda, const bf16raw* Bt, int ldb, int N, int K, const Epi& E) {
    pg8::Gemm g{A, Bt, MTOK, N, K, lda, ldb}; pg8::StaticOrder S; S.init(MTOK, N, (int)gridDim.x, (int)blockIdx.x);
    pg8::gemm_phase<Epi, pg8::StaticOrder, true, true>(lds, g, S, E);
}

__device__ __forceinline__ void ld16(const bf16raw* p, float (&v)[16]) {
    const u32x4_t a = *(const u32x4_t*)p, b = *(const u32x4_t*)(p + 8);
#pragma unroll
    for (int e = 0; e < 4; ++e) { v[2 * e] = bflo(a[e]); v[2 * e + 1] = bfhi(a[e]); v[8 + 2 * e] = bflo(b[e]); v[8 + 2 * e + 1] = bfhi(b[e]); }
}
__device__ __forceinline__ void st16(bf16raw* p, const float (&v)[16]) {
    u32x4_t a, b;
#pragma unroll
    for (int e = 0; e < 4; ++e) { a[e] = pkbf(v[2 * e], v[2 * e + 1]); b[e] = pkbf(v[8 + 2 * e], v[8 + 2 * e + 1]); }
    *(u32x4_t*)p = a; *(u32x4_t*)(p + 8) = b;
}
__device__ __forceinline__ void unp16(const u32x4_t a, const u32x4_t b, float (&v)[16]) {
#pragma unroll
    for (int e = 0; e < 4; ++e) { v[2 * e] = bflo(a[e]); v[2 * e + 1] = bfhi(a[e]); v[8 + 2 * e] = bflo(b[e]); v[8 + 2 * e + 1] = bfhi(b[e]); }
}
struct PrepRaw { u32x4_t q0, q1, k0, k1, i0, i1, s0, s1, u0, u1; unsigned ki, wi; int pos; };
__device__ __forceinline__ PrepRaw prep_load(const Params& P, int m, int lane) {
    const bf16raw* row = (const bf16raw*)(P.ws + WS_PROJ) + (size_t)m * PP; PrepRaw r;
    r.q0 = *(const u32x4_t*)(row + C_Q + lane * 16); r.q1 = *(const u32x4_t*)(row + C_Q + lane * 16 + 8);
    r.k0 = *(const u32x4_t*)(row + C_K + lane * 16); r.k1 = *(const u32x4_t*)(row + C_K + lane * 16 + 8);
    r.i0 = *(const u32x4_t*)(row + C_QI + lane * 16); r.i1 = *(const u32x4_t*)(row + C_QI + lane * 16 + 8);
    r.s0 = *(const u32x4_t*)(row + C_VS + lane * 16); r.s1 = *(const u32x4_t*)(row + C_VS + lane * 16 + 8);
    r.u0 = *(const u32x4_t*)(row + C_U + lane * 16); r.u1 = *(const u32x4_t*)(row + C_U + lane * 16 + 8);
    r.ki = row[C_KI + lane]; r.wi = row[C_WI + (lane & 15)]; r.pos = ((const int*)P.in[1])[m];
    return r;
}
__device__ __forceinline__ void prep_token(const Params& P, int m, const PrepRaw& R, int lane) {
    bf16raw* row = (bf16raw*)(P.ws + WS_PROJ) + (size_t)m * PP;
    float cs = 1.f, sn = 0.f;
    { const float ang = (float)R.pos * ROPE_INVF[lane < 24 ? lane : 0]; double rev = (double)ang * 0.15915494309189535; rev -= rint(rev); const float fr = (float)rev;
      sn = __builtin_amdgcn_sinf(fr); cs = __builtin_amdgcn_cosf(fr); }
    float cA[16], sA[16];
#pragma unroll
    for (int i = 0; i < 16; ++i) { cA[i] = __shfl(cs, i); sA[i] = __shfl(sn, i); }
    const int sub = lane & 7; const bool rot = sub < 2; const float sg = sub == 0 ? -1.f : 1.f;
#pragma unroll
    for (int which = 0; which < 2; ++which) {
        bf16raw* p = row + (which ? C_K : C_Q) + lane * 16; const float* g = (which ? P.in[9] : P.in[8]) + sub * 16;
        float v[16]; if (which) unp16(R.k0, R.k1, v); else unp16(R.q0, R.q1, v);
        float ss = 0.f;
#pragma unroll
        for (int i = 0; i < 16; ++i) ss += v[i] * v[i];
        ss += __shfl_xor(ss, 1); ss += __shfl_xor(ss, 2); ss += __shfl_xor(ss, 4);
        const float r = 1.0f / sqrtf(ss * (1.0f / 128.0f) + EPS);
#pragma unroll
        for (int i = 0; i < 16; ++i) v[i] = v[i] * r * g[i];
#pragma unroll
        for (int i = 0; i < 16; ++i) { const float o = __shfl_xor(v[i], 1); const float rr = v[i] * cA[i] + sg * o * sA[i]; v[i] = rot ? rr : v[i]; }
        st16(p, v);
    }
    { bf16raw* p = row + C_QI + lane * 16; float v[16]; unp16(R.i0, R.i1, v);
      const bool r0 = (lane & 3) == 0;
#pragma unroll
      for (int i = 0; i < 8; ++i) { const float ci = __shfl(cs, 16 + i), si = __shfl(sn, 16 + i); const float x1 = v[i], x2 = v[8 + i];
          v[i] = r0 ? x1 * ci - x2 * si : x1; v[8 + i] = r0 ? x2 * ci + x1 * si : x2; }
      st16(p, v);
      float y = bf2f((unsigned short)R.ki); const float ss = wave_sum(y * y);
      y = y * (1.0f / sqrtf(ss * (1.0f / 64.0f) + EPS)) * P.in[10][lane];
      const float o = __shfl_xor(y, 8), cc = __shfl(cs, 16 + (lane & 7)), s2 = __shfl(sn, 16 + (lane & 7));
      y = lane < 8 ? y * cc - o * s2 : (lane < 16 ? y * cc + o * s2 : y);
      ((bf16raw*)(P.ws + WS_KI))[((size_t)(m >> 5) * 256 + (lane >> 4) * 64 + ((lane >> 3) & 1) * 32 + (m & 31)) * 8 + (lane & 7)] = (bf16raw)(pkbf(y, 0.f) & 0xffffu);
      if (lane < 16) ((float*)(P.ws + WS_WI))[(size_t)m * 16 + lane] = bf2f((unsigned short)R.wi);
    }
    { bf16raw* p = row + C_U + lane * 16; float v[16]; unp16(R.u0, R.u1, v);
#pragma unroll
      for (int i = 0; i < 16; ++i) v[i] = gelu_tanh_f(v[i]);
      st16(p, v); }
    { bf16raw* p = row + C_VS + lane * 16; float v[16]; unp16(R.s0, R.s1, v); float ss = 0.f;
#pragma unroll
      for (int i = 0; i < 16; ++i) { v[i] = gelu_tanh_f(v[i]); ss += v[i] * v[i]; }
      const float r = 1.0f / sqrtf(wave_sum(ss) * (1.0f / 1024.0f) + EPS); const float* g = P.in[11] + lane * 16;
#pragma unroll
      for (int i = 0; i < 16; ++i) v[i] = v[i] * r * g[i];
      st16(p, v); }
}

__device__ __forceinline__ void sgu_phase(const Params& P, LAS unsigned char* lds, int tid, int lane, int wave) {
    bf16raw* proj = (bf16raw*)(P.ws + WS_PROJ); const bf16raw* wsb = (const bf16raw*)(P.ws + WS_WSB); const float* bs = P.in[13];
    LAS bf16raw* VT = (LAS bf16raw*)lds;
    const int r32 = lane & 31, hi = lane >> 5, tr = wave & 3, ch = wave >> 2;
    for (int item = blockIdx.x; item < 2048; item += gridDim.x) {
        const int g = item & 7, tok0 = (item >> 3) * 128;
#pragma unroll
        for (int i = 0; i < 4; ++i) { const int id = tid + 512 * i, s = id & 127, cc = (id >> 7) * 8;
            const u32x4_t w = *(const u32x4_t*)(proj + (size_t)(tok0 + s) * PP + C_VS + g * 128 + cc);
#pragma unroll
            for (int e = 0; e < 4; ++e) { VT[(cc + 2 * e) * 136 + s] = (bf16raw)(w[e] & 0xffffu); VT[(cc + 2 * e + 1) * 136 + s] = (bf16raw)(w[e] >> 16); } }
        __syncthreads();
        f32x16_t acc[2]; acc[0] = f32x16_t{}; acc[1] = f32x16_t{};
#pragma unroll
        for (int ks = 0; ks < 8; ++ks) {
            const bf16x8_t a = *(const bf16x8_t*)(wsb + (size_t)g * 16384 + (32 * tr + r32) * 128 + 16 * ks + 8 * hi);
#pragma unroll
            for (int nt = 0; nt < 2; ++nt) { const bf16x8_t b = *(const LAS bf16x8_t*)(VT + (64 * ch + 32 * nt + r32) * 136 + 16 * ks + 8 * hi);
                acc[nt] = __builtin_amdgcn_mfma_f32_32x32x16_bf16(a, b, acc[nt], 0, 0, 0); }
        }
#pragma unroll
        for (int nt = 0; nt < 2; ++nt)
#pragma unroll
            for (int r = 0; r < 16; ++r) { const int t = 32 * tr + (r & 3) + 8 * (r >> 2) + 4 * hi; bf16raw* up = proj + (size_t)(tok0 + t) * PP + C_U + g * 128 + 64 * ch + 32 * nt + r32;
                const float y = bf2f(*up) * (acc[nt][r] + bs[g * 128 + t]); *up = (bf16raw)(pkbf(y, 0.f) & 0xffffu); }
        __syncthreads();
    }
}

__device__ __forceinline__ bool radix_pick(const LAS unsigned* h, int k, int lane, int& d, int& kn, int& cnt) {
    const u32x4_t c = *(const LAS u32x4_t*)(h + 4 * lane);
    const unsigned t = c.x + c.y + c.z + c.w;
    int pv = (int)t;
    pv += __builtin_amdgcn_update_dpp(0, pv, 0x111, 0xf, 0xf, false);
    pv += __builtin_amdgcn_update_dpp(0, pv, 0x112, 0xf, 0xf, false);
    pv += __builtin_amdgcn_update_dpp(0, pv, 0x114, 0xf, 0xf, false);
    pv += __builtin_amdgcn_update_dpp(0, pv, 0x118, 0xf, 0xf, false);
    pv += __builtin_amdgcn_update_dpp(0, pv, 0x142, 0xa, 0xf, false);
    pv += __builtin_amdgcn_update_dpp(0, pv, 0x143, 0xc, 0xf, false);
    const unsigned total = (unsigned)__builtin_amdgcn_readlane(pv, 63);
    unsigned gt = total - (unsigned)pv; int dsel = -1; unsigned knn = 0u, cc = 0u; const unsigned kr = (unsigned)k;
    { const unsigned ge = gt + c.w; if (gt < kr && kr <= ge) { dsel = 4 * lane + 3; knn = kr - gt; cc = c.w; } gt = ge; }
    { const unsigned ge = gt + c.z; if (gt < kr && kr <= ge) { dsel = 4 * lane + 2; knn = kr - gt; cc = c.z; } gt = ge; }
    { const unsigned ge = gt + c.y; if (gt < kr && kr <= ge) { dsel = 4 * lane + 1; knn = kr - gt; cc = c.y; } gt = ge; }
    { const unsigned ge = gt + c.x; if (gt < kr && kr <= ge) { dsel = 4 * lane + 0; knn = kr - gt; cc = c.x; } gt = ge; }
    const unsigned long long bal = __ballot(dsel >= 0);
    if (bal == 0ull) return false;
    const int src = __builtin_amdgcn_readfirstlane(__ffsll((long long)bal) - 1);
    d = __builtin_amdgcn_readlane(dsel, src); kn = __builtin_amdgcn_readlane((int)knn, src); cnt = __builtin_amdgcn_readlane((int)cc, src);
    return true;
}
constexpr int IDX_LCAP = 2048;
template <int NJ> __device__ __forceinline__ void idx_select(const unsigned* __restrict__ sc, int nj, int wend, unsigned long long* mrow, LAS unsigned* hist, LAS unsigned* list, int lane) {
    unsigned u[NJ];
#pragma unroll
    for (int j = 0; j < NJ; ++j) u[j] = sc[j * 64 + lane];
#pragma unroll
    for (int j = 0; j < NJ; ++j) u[j] = (j < nj) ? u[j] : 0u;
    unsigned prefix = 0u; int krem = 256, d = 0, kn = 0, cnt = 0;
    hist[lane] = 0u; hist[lane + 64] = 0u; hist[lane + 128] = 0u; hist[lane + 192] = 0u;
    LDS_WAIT();
    { int njp = nj; asm volatile("" : "+s"(njp));
#pragma unroll
      for (int j = 0; j < NJ; ++j) { if (j < njp) __hip_atomic_fetch_add(hist + (u[j] >> 24), 1u, __ATOMIC_RELAXED, __HIP_MEMORY_SCOPE_WORKGROUP); } }
    LDS_WAIT();
    if (!radix_pick(hist, krem, lane, d, kn, cnt)) return;
    prefix = (unsigned)d << 24; krem = kn;
    if (cnt <= IDX_LCAP) {
        int base = 0;
        { int njp = nj; asm volatile("" : "+s"(njp));
#pragma unroll
          for (int j = 0; j < NJ; ++j) { if (j < njp) { const bool m = (u[j] >> 24) == (unsigned)d; const unsigned long long bal = __ballot(m);
                if (bal != 0ull) { if (m) list[base + (int)__builtin_amdgcn_mbcnt_hi((unsigned)(bal >> 32), __builtin_amdgcn_mbcnt_lo((unsigned)bal, 0u))] = u[j]; base += __popcll(bal); } } } }
        LDS_WAIT();
#pragma unroll 1
        for (int pass = 1; pass < 4; ++pass) {
            const int shift = 24 - 8 * pass; const unsigned himask = 0xffffffffu << (shift + 8);
            hist[lane] = 0u; hist[lane + 64] = 0u; hist[lane + 128] = 0u; hist[lane + 192] = 0u;
            LDS_WAIT();
            for (int i0 = lane; i0 < base; i0 += 256) {
                unsigned v[4]; bool ok[4];
#pragma unroll
                for (int q4 = 0; q4 < 4; ++q4) { const int i = i0 + 64 * q4; ok[q4] = i < base; v[q4] = list[ok[q4] ? i : 0]; }
#pragma unroll
                for (int q4 = 0; q4 < 4; ++q4) { if (ok[q4] && ((v[q4] ^ prefix) & himask) == 0u) __hip_atomic_fetch_add(hist + ((v[q4] >> shift) & 255u), 1u, __ATOMIC_RELAXED, __HIP_MEMORY_SCOPE_WORKGROUP); }
            }
            LDS_WAIT();
            if (!radix_pick(hist, krem, lane, d, kn, cnt)) break;
            prefix |= (unsigned)d << shift; krem = kn;
        }
    } else {
#pragma unroll 1
        for (int pass = 1; pass < 4; ++pass) {
            const int shift = 24 - 8 * pass; const unsigned himask = 0xffffffffu << (shift + 8);
            int njp = nj; asm volatile("" : "+s"(njp));
            hist[lane] = 0u; hist[lane + 64] = 0u; hist[lane + 128] = 0u; hist[lane + 192] = 0u;
            LDS_WAIT();
#pragma unroll
            for (int j = 0; j < NJ; ++j) { if (j < njp) { if (((u[j] ^ prefix) & himask) == 0u) __hip_atomic_fetch_add(hist + ((u[j] >> shift) & 255u), 1u, __ATOMIC_RELAXED, __HIP_MEMORY_SCOPE_WORKGROUP); } }
            LDS_WAIT();
            if (!radix_pick(hist, krem, lane, d, kn, cnt)) break;
            prefix |= (unsigned)d << shift; krem = kn;
        }
    }
    const unsigned thr = prefix; unsigned wl0 = 0u, wh0 = 0u, wl1 = 0u, wh1 = 0u; int total = 0;
#pragma unroll
    for (int j = 0; j < NJ; ++j) {
        const unsigned long long word = __ballot(u[j] >= thr);
        total += __popcll(word);
        { const unsigned wlo_ = (unsigned)__builtin_amdgcn_readfirstlane((int)(unsigned)word), whi_ = (unsigned)__builtin_amdgcn_readfirstlane((int)(unsigned)(word >> 32));
          if (j < 64) { asm volatile("v_writelane_b32 %0, %1, %2" : "+v"(wl0) : "s"(wlo_), "n"(j & 63)); asm volatile("v_writelane_b32 %0, %1, %2" : "+v"(wh0) : "s"(whi_), "n"(j & 63)); }
          else { asm volatile("v_writelane_b32 %0, %1, %2" : "+v"(wl1) : "s"(wlo_), "n"(j & 63)); asm volatile("v_writelane_b32 %0, %1, %2" : "+v"(wh1) : "s"(whi_), "n"(j & 63)); } }
    }
    if (__builtin_amdgcn_readfirstlane(total) != 256) {
        int taken = 0;
#pragma unroll
        for (int j = 0; j < NJ; ++j) {
            unsigned long long word = __ballot(u[j] > thr);
            unsigned long long e = __ballot(u[j] == thr);
            if (e != 0ull) { const int need = krem - taken;
                if (need > 0) { int n = __popcll(e); unsigned long long sel = e;
                    if (n > need) { sel = 0ull; for (int t2 = 0; t2 < need; ++t2) { const unsigned long long b = e & (~e + 1ull); sel |= b; e ^= b; } n = need; }
                    word |= sel; taken += n; } }
            { const unsigned wlo_ = (unsigned)__builtin_amdgcn_readfirstlane((int)(unsigned)word), whi_ = (unsigned)__builtin_amdgcn_readfirstlane((int)(unsigned)(word >> 32));
              if (j < 64) { asm volatile("v_writelane_b32 %0, %1, %2" : "+v"(wl0) : "s"(wlo_), "n"(j & 63)); asm volatile("v_writelane_b32 %0, %1, %2" : "+v"(wh0) : "s"(whi_), "n"(j & 63)); }
              else { asm volatile("v_writelane_b32 %0, %1, %2" : "+v"(wl1) : "s"(wlo_), "n"(j & 63)); asm volatile("v_writelane_b32 %0, %1, %2" : "+v"(wh1) : "s"(whi_), "n"(j & 63)); } }
        }
    }
    if (lane < wend) mrow[lane] = ((unsigned long long)wh0 << 32) | wl0;
    if (NJ > 64) { if (lane + 64 < wend) mrow[lane + 64] = ((unsigned long long)wh1 << 32) | wl1; }
}

__device__ __forceinline__ float relu_i(float x) { const int b = __float_as_int(x); return __int_as_float(b > 0 ? b : 0); }
__device__ __forceinline__ f32x16_t idx_chain(const bf16x8_t (&Af)[4], const bf16x8_t (&B4)[4]) {
    f32x16_t acc = f32x16_t{};
#pragma unroll
    for (int s = 0; s < 4; ++s) acc = __builtin_amdgcn_mfma_f32_32x32x16_bf16(Af[s], B4[s], acc, 0, 0, 0);
    return acc;
}
__device__ __forceinline__ unsigned idx_score_key(const f32x16_t& acc, const f32x4_t (&wv)[4]) {
    float sc0 = 0.f, sc1 = 0.f;
#pragma unroll
    for (int i = 0; i < 16; i += 2) { sc0 += relu_i(acc[i]) * wv[i >> 2][i & 3]; sc1 += relu_i(acc[i + 1]) * wv[(i + 1) >> 2][(i + 1) & 3]; }
    const unsigned bts = __float_as_uint(sc0 + sc1);
    return bts ^ ((unsigned)((int)bts >> 31) | 0x80000000u);
}
template <bool FULL> __device__ __forceinline__ void idx_rt_block(const bf16x8_t (&Bf)[8][4], const bf16x8_t (&Af)[4], const f32x4_t (&wv)[4], unsigned* srow, int tile0, int ntile) {
    if (FULL) {
        f32x16_t accA = idx_chain(Af, Bf[0]), accB;
#pragma unroll
        for (int kt = 0; kt < 8; ++kt) {
            if (kt + 1 < 8) accB = idx_chain(Af, Bf[kt + 1]);
            srow[(tile0 + kt * 8) * 32] = idx_score_key(accA, wv);
            if (kt + 1 < 8) {
#pragma unroll
                for (int s = 0; s < 4; ++s) { __builtin_amdgcn_sched_group_barrier(0x008, 1, 0); __builtin_amdgcn_sched_group_barrier(0x002, 10, 0); }
            }
            accA = accB;
        }
    } else {
#pragma unroll
        for (int kt = 0; kt < 8; ++kt) { const int tile = tile0 + kt * 8;
            if (tile < ntile) { const f32x16_t acc = idx_chain(Af, Bf[kt]); srow[tile * 32] = idx_score_key(acc, wv); } }
    }
}
__device__ __forceinline__ void indexer_phase(const Params& P, LAS unsigned char* lds, int tid, int lane, int wave) {
    unsigned char* ws = P.ws;
    const bf16raw* proj = (const bf16raw*)(ws + WS_PROJ); const bf16raw* KI = (const bf16raw*)(ws + WS_KI); const float* WIf = (const float*)(ws + WS_WI);
    unsigned long long* MASK = (unsigned long long*)(ws + WS_MASK); unsigned* ctl = (unsigned*)(ws + WS_CTL);
    float* scratch = P.out + (size_t)blockIdx.x * (16 * 8192);
    LAS unsigned* list = (LAS unsigned*)(lds + 45056) + wave * IDX_LCAP;
    LAS float* WL = (LAS float*)(lds + 32768); LAS unsigned* hist = (LAS unsigned*)(lds + 33792) + wave * 256; volatile LAS int* itemw = (volatile LAS int*)(lds + 41984);
    const int r32 = lane & 31, hi = lane >> 5;
    if (blockIdx.x >= 256) return;
    for (;;) {
        if (tid == 0) *itemw = (int)atomicAdd(ctl + CW_IDXQ, 1u);
        __syncthreads();
        const int it = *itemw;
        __syncthreads();
        if (it >= 2048) break;
        const int qt = 511 - (it >> 2), b = it & 3, q0 = qt * 16, n_adm = ((q0 >> 6) + 1) * 64, wend = ((q0 >> 8) + 1) * 4, tok0 = b * SEQ + q0;
        if (n_adm <= 256) {
            if (tid < 64) { const int q = tid >> 2, j = tid & 3; MASK[(size_t)(tok0 + q) * 128 + j] = (j < (n_adm >> 6)) ? ~0ull : 0ull; }
            continue;
        }
        for (int c = tid; c < 2048; c += NTHR) { const int l = c & 63, s = (c >> 6) & 3, rt = c >> 8, rho = l & 31, hf = l >> 5, par = (rho >> 2) & 1, head = (rho & 3) + 4 * (rho >> 3);
            *(LAS u32x4_t*)(lds + c * 16) = *(const u32x4_t*)(proj + (size_t)(tok0 + 2 * rt + par) * PP + C_QI + head * 64 + 16 * s + 8 * hf); }
        if (tid < 256) WL[tid] = WIf[(size_t)tok0 * 16 + tid];
        __syncthreads();
        const int ntile = n_adm >> 5, npass = (ntile + 63) >> 6;
        for (int p = 0; p < npass; ++p) {
            bf16x8_t Bf[8][4];
#pragma unroll
            for (int kt = 0; kt < 8; ++kt) { const int tile = p * 64 + kt * 8 + wave;
                const int tcl = tile < ntile ? tile : ntile - 1;
                const bf16raw* kp = KI + ((size_t)((b * SEQ >> 5) + tcl) * 256 + lane) * 8;
#pragma unroll
                for (int s = 0; s < 4; ++s) Bf[kt][s] = *(const bf16x8_t*)(kp + 512 * s); }
            const int tile0 = p * 64 + wave; const bool full = tile0 + 56 < ntile;
#pragma unroll 1
            for (int rt = 0; rt < 8; ++rt) {
                bf16x8_t Af[4];
#pragma unroll
                for (int s = 0; s < 4; ++s) Af[s] = *(const LAS bf16x8_t*)(lds + ((rt * 4 + s) * 64 + lane) * 16);
                f32x4_t wv[4];
#pragma unroll
                for (int e = 0; e < 4; ++e) wv[e] = *(const LAS f32x4_t*)(WL + (2 * rt + hi) * 16 + 4 * e);
                unsigned* srow = (unsigned*)scratch + (2 * rt + hi) * 8192 + r32;
                if (full) idx_rt_block<true>(Bf, Af, wv, srow, tile0, ntile); else idx_rt_block<false>(Bf, Af, wv, srow, tile0, ntile);
            }
        }
        __syncthreads();
        const int nj = n_adm >> 6;
#pragma unroll 1
        for (int qq = 2 * wave; qq < 2 * wave + 2; ++qq) {
            const unsigned* sc = (const unsigned*)scratch + qq * 8192; unsigned long long* mrow = MASK + (size_t)(tok0 + qq) * 128;
            int njq = nj; asm volatile("" : "+s"(njq));
            if (njq <= 16) idx_select<16>(sc, njq, wend, mrow, hist, list, lane);
            else if (njq <= 32) idx_select<32>(sc, njq, wend, mrow, hist, list, lane);
            else if (njq <= 64) idx_select<64>(sc, njq, wend, mrow, hist, list, lane);
            else idx_select<128>(sc, njq, wend, mrow, hist, list, lane);
        }
        __syncthreads();
    }
}

__device__ __forceinline__ attn::BlockRef<attn::bf16, attn::bf16> att_ref(unsigned char* ws, int bi) {
    const int G_ = (int)gridDim.x, bx_ = (int)blockIdx.x, vg = (G_ % 8 == 0) ? (bx_ & 7) * (G_ >> 3) + (bx_ >> 3) : bx_;
    const int item = vg + (bi >> 1) * G_, bh = item >> 4, pr = item & 15, qb = (bi & 1) ? 31 - pr : pr, b = bh >> 3, h = bh & 7;
    attn::bf16* proj = (attn::bf16*)(ws + WS_PROJ); const size_t tokb = (size_t)b * SEQ;
    attn::BlockRef<attn::bf16, attn::bf16> r;
    r.Q = proj + (tokb + qb * 256) * PP + C_Q + h * 128; r.K = proj + tokb * PP + C_K + h * 128; r.V = proj + tokb * PP + C_V + h * 128;
    r.O = proj + (tokb + qb * 256) * PP + C_Q + h * 128; r.MK = (const unsigned long long*)(ws + WS_MASK) + (tokb + qb * 256) * 128; r.P0 = qb * 256;
    return r;
}
__device__ __forceinline__ void attn_phase(unsigned char* ws, char* lds) {
    const int nitems = (int)blockIdx.x < 512 ? (512 - (int)blockIdx.x + (int)gridDim.x - 1) / (int)gridDim.x : 0, nb = 2 * nitems;
    if (nb == 0) return;
    attn::Seam<attn::bf16> S;
    { const auto r0 = att_ref(ws, 0); attn::causal_swa_prime<attn::bf16, attn::bf16>(r0, SEQ, lds, S); }
    for (int bi = 0; bi < nb; ++bi) {
        const auto cur = att_ref(ws, bi); const auto nxt = att_ref(ws, bi + 1 < nb ? bi + 1 : bi);
        attn::causal_swa_block<attn::bf16, attn::bf16>(cur, nxt, SEQ, SEQ, lds, S);
    }
}

#define XB_TMO      128
#define XB_XCNT(j)  (256  + 64 * (j))
#define XB_XSUB(j)  (1280 + 64 * (j))
#define XB_XGEN(j)  (2304 + 64 * (j))
#define XB_TOP      3328
#define XB_TOPGEN   3392
#define XB_SPIN_CAP (1u << 18)

__device__ __forceinline__ unsigned xb_ld(unsigned* p)              { return __hip_atomic_load(p, __ATOMIC_RELAXED, __HIP_MEMORY_SCOPE_AGENT); }
__device__ __forceinline__ unsigned xb_add(unsigned* p, unsigned v) { return __hip_atomic_fetch_add(p, v, __ATOMIC_RELAXED, __HIP_MEMORY_SCOPE_AGENT); }
__device__ __forceinline__ unsigned xb_xcc_id() { return (unsigned)__builtin_amdgcn_s_getreg((3 << 11) | 20) & 0xFu; }
#define XB_SPIN(cond, bar) do { unsigned _sp = 0; while (cond) { __builtin_amdgcn_s_sleep(1); \
    if ((++_sp & 255u) == 0u) { if (xb_ld(&(bar)[XB_TMO])) break; if (_sp > XB_SPIN_CAP) { atomicAdd(&(bar)[XB_TMO], 1u); break; } } } } while (0)

struct XcdBarrier {
    unsigned* bar; unsigned x;
    volatile LAS unsigned* st;
};

__device__ __forceinline__ XcdBarrier xcd_barrier_post(unsigned* bar, volatile LAS unsigned* st) {
    XcdBarrier b; b.bar = bar; b.x = xb_xcc_id(); b.st = st;
    if (threadIdx.x == 0) (void)xb_add(&bar[XB_XCNT(b.x)], 1u);
    return b;
}
__device__ __forceinline__ void xcd_barrier_complete(unsigned* bar, unsigned x, unsigned& nloc, unsigned& nx) {
    const unsigned G = gridDim.x * gridDim.y * gridDim.z;
    unsigned sum, cnt, mine, sp = 0u;
    for (;;) {
        sum = 0u; cnt = 0u; mine = 0u;
#pragma unroll
        for (unsigned j = 0; j < 16; ++j) { const unsigned c = xb_ld(&bar[XB_XCNT(j)]); sum += c; cnt += (c > 0u) ? 1u : 0u; mine = (j == x) ? c : mine; }
        if (sum == G) break;
        __builtin_amdgcn_s_sleep(1);
        if ((++sp & 255u) == 0u) { if (xb_ld(&bar[XB_TMO])) break; if (sp > XB_SPIN_CAP) { atomicAdd(&bar[XB_TMO], 1u); break; } }
    }
    nloc = mine > 0u ? mine : 1u; nx = cnt > 0u ? cnt : 1u;
}

__device__ __forceinline__ void xcd_barrier(const XcdBarrier& b) {
    asm volatile("s_waitcnt vmcnt(0)" ::: "memory");
    __syncthreads();
    if (threadIdx.x == 0) {
        unsigned* bar = b.bar;
        __builtin_amdgcn_s_waitcnt(0);
        unsigned nloc = b.st[0], nx = b.st[1];
        if (nloc == 0u) { xcd_barrier_complete(bar, b.x, nloc, nx); b.st[0] = nloc; b.st[1] = nx; }
        const unsigned old = xb_add(&bar[XB_XSUB(b.x)], 1u);
        const unsigned gen = old / nloc;
        if (old + 1u == (gen + 1u) * nloc) {
            __builtin_amdgcn_fence(__ATOMIC_RELEASE, "agent");
            asm volatile("s_waitcnt vmcnt(0)" ::: "memory");
            const unsigned og = xb_add(&bar[XB_TOP], 1u);
            const unsigned tg = og / nx;
            if (og + 1u == (tg + 1u) * nx) xb_add(&bar[XB_TOPGEN], 1u);
            else XB_SPIN(xb_ld(&bar[XB_TOPGEN]) == tg, bar);
            __builtin_amdgcn_fence(__ATOMIC_ACQUIRE, "agent");
            xb_add(&bar[XB_XGEN(b.x)], 1u);
            asm volatile("s_waitcnt vmcnt(0)" ::: "memory");
        } else {
            XB_SPIN(xb_ld(&bar[XB_XGEN(b.x)]) == gen, bar);
            __builtin_amdgcn_fence(__ATOMIC_ACQUIRE, "agent");
            asm volatile("s_waitcnt vmcnt(0)" ::: "memory");
        }
    }
    __syncthreads();
}

__global__ void __launch_bounds__(NTHR, 2) fwd_kernel(Params P) {
    extern __shared__ __attribute__((aligned(16))) unsigned char lds_raw[];
    cg::grid_group grid = cg::this_grid();
    LAS unsigned char* lds = (LAS unsigned char*)lds_raw;
    const int tid = threadIdx.x, lane = tid & 63, wave = __builtin_amdgcn_readfirstlane(tid >> 6);
    const int gw = blockIdx.x * NWAVES + wave, ngw = gridDim.x * NWAVES;
    unsigned char* ws = P.ws;
    bf16raw* XN = (bf16raw*)(ws + WS_XN); bf16raw* PROJ = (bf16raw*)(ws + WS_PROJ); bf16raw* HB = PROJ;
    float* out = P.out; float* SS1 = (float*)(ws + WS_SS1); float* SS2 = SS1 + MTOK;

    volatile LAS unsigned* bst = (volatile LAS unsigned*)(lds + LDS_BYTES - 64);
    if (tid == 0) { bst[0] = 0u; bst[1] = 0u; }
    __syncthreads();
    p0_prologue(P, lds, tid, lane, wave);
    grid.sync();
    const XcdBarrier xbar = xcd_barrier_post((unsigned*)(ws + WS_CTL) + CW_BAR, bst);
#define GSYNC() xcd_barrier(xbar)
    { pg8::EpiSwiglu E{HB, DFF, nullptr}; run_gemm(lds, XN, DM, (const bf16raw*)(ws + WS_WGU1), DM, 2 * DFF, DM, E); }
    GSYNC();
    { pg8::EpiResid<false, false, true> E{P.in[0], nullptr, DM, 0.5f, XN, SS1}; run_gemm(lds, HB, DFF, (const bf16raw*)(ws + WS_WD1), DFF, DM, DFF, E); }
    GSYNC();
    { pg8::EpiStore E{PROJ, PP, SS1}; run_gemm(lds, XN, DM, (const bf16raw*)(ws + WS_WIN), DM, PP, DM, E); }
    GSYNC();
    if (gw < MTOK) { PrepRaw cur = prep_load(P, gw, lane);
#pragma unroll 1
      for (int m = gw; m < MTOK; m += ngw) { const int mn = m + ngw; const PrepRaw nxt = prep_load(P, mn < MTOK ? mn : m, lane); prep_token(P, m, cur, lane); cur = nxt; } }
    GSYNC();
    sgu_phase(P, lds, tid, lane, wave);
    indexer_phase(P, lds, tid, lane, wave);
    GSYNC();
    attn_phase(ws, (char*)lds_raw);
    GSYNC();
    { pg8::EpiGate<1> E{PROJ + C_GA, PROJ + C_GA, PP}; run_gemm(lds, PROJ + C_Q, PP, (const bf16raw*)(ws + WS_WUA), 1024, DM, 1024, E); }
    { pg8::EpiGate<2> E{PROJ + C_GB, PROJ + C_GA, PP}; run_gemm(lds, PROJ + C_U, PP, (const bf16raw*)(ws + WS_WUS), 1024, DM, 1024, E); }
    GSYNC();
    { pg8::EpiResid<true, false, true> E{XN, nullptr, DM, 1.0f, XN, SS2}; run_gemm(lds, PROJ + C_GA, PP, (const bf16raw*)(ws + WS_WOUT), DM, DM, DM, E); }
    GSYNC();
    { pg8::EpiSwiglu E{HB, DFF, SS2}; run_gemm(lds, XN, DM, (const bf16raw*)(ws + WS_WGU2), DM, 2 * DFF, DM, E); }
    GSYNC();
    { pg8::EpiResid<true, true, false> E{XN, out, DM, 0.5f, nullptr, nullptr}; run_gemm(lds, HB, DFF, (const bf16raw*)(ws + WS_WD2), DFF, DM, DFF, E); }
}

extern "C" void kernel_launch(void* const* d_in, const int* in_sizes, int n_in, void* d_out, int out_size, void* d_ws, size_t ws_size, hipStream_t stream) {
    static int grid = 0;
    if (grid == 0) {
        if (n_in != 21 || ws_size < WS_END) { fprintf(stderr, "kernel_launch: unexpected n_in %d / ws %zu\n", n_in, ws_size); grid = -1; return; }
        int dev = 0, cus = 0, per_cu = 0;
        (void)hipGetDevice(&dev); (void)hipDeviceGetAttribute(&cus, hipDeviceAttributeMultiprocessorCount, dev);
        if (hipFuncSetAttribute((const void*)fwd_kernel, hipFuncAttributeMaxDynamicSharedMemorySize, LDS_BYTES) != hipSuccess) fprintf(stderr, "kernel_launch: hipFuncSetAttribute failed\n");
        if (hipOccupancyMaxActiveBlocksPerMultiprocessor(&per_cu, (const void*)fwd_kernel, NTHR, LDS_BYTES) != hipSuccess || per_cu < 1) fprintf(stderr, "kernel_launch: occupancy query says %d\n", per_cu);
        (void)hipGetLastError();
        grid = cus > 256 ? 256 : cus; if (grid < 1) grid = 256;
    }
    if (grid < 0) return;
    Params p{};
    for (int i = 0; i < 21; ++i) p.in[i] = (const float*)d_in[i];
    p.out = (float*)d_out; p.ws = (unsigned char*)d_ws;
    void* args[] = {&p};
    const hipError_t e = hipLaunchCooperativeKernel((const void*)fwd_kernel, dim3(grid), dim3(NTHR), args, LDS_BYTES, stream);
    if (e != hipSuccess) fprintf(stderr, "cooperative launch failed: %s (grid %d)\n", hipGetErrorString(e), grid);
}
```
